# Optimizing an MI355X kernel written in HIP

```python
import math
import jax, jax.numpy as jnp
from jax import lax
import numpy as np

D_MODEL = 2048
BATCH = 1
SEQ = 8192
DEPTH = 2
DEC_BATCH = 16
DEC_SEQ = 64
PAST_LEN = 4096

CHUNK = 64
N_MIXERS = 2
N_HGRN_LAYERS = (DEPTH + 1) // 2
N_ATTN_LAYERS = DEPTH // 2
HGRN_HEADS = 16
HGRN_DK = D_MODEL // HGRN_HEADS
HGRN_DV = D_MODEL // HGRN_HEADS
HGRN_D_KEY = HGRN_HEADS * HGRN_DK
HGRN_BLOCK = 16
DIFF_HEADS = 8
DIFF_DH = D_MODEL // DIFF_HEADS // 2
Q_BLOCK = 128
D_FF = 5632
CONV_W = 3
EPS = 1e-6

kernel_name = "hgrn2_diffattn_convffn_stream_step"


def rms_norm(x, g):
    xf = x.astype(jnp.float32)
    y = xf * lax.rsqrt(jnp.mean(xf * xf, axis=-1, keepdims=True) + EPS)
    return (y * g.astype(jnp.float32)).astype(x.dtype)


def hgrn_block_step(S, blk):
    q, k, v, g = blk
    C = q.shape[1]
    b = jnp.cumsum(g, axis=1)
    causal = jnp.tril(jnp.ones((C, C), bool))[None, :, :, None, None]
    decay = jnp.exp(jnp.where(causal, b[:, :, None] - b[:, None, :], -jnp.inf))
    scores = jnp.einsum('bthd,btshd,bshd->bhts', q, decay, k)
    o = (jnp.einsum('bthd,bhde->bthe', q * jnp.exp(b), S)
         + jnp.einsum('bhts,bshe->bthe', scores, v))
    b_last = b[:, -1]
    S = (jnp.exp(b_last)[..., None] * S
         + jnp.einsum('bshd,bshe->bhde', k * jnp.exp(b_last[:, None] - b), v))
    return S, o


def hgrn_scan(q, k, v, logf, S0):
    B, L, H, _ = q.shape
    pad = (-L) % HGRN_BLOCK
    padding = ((0, 0), (0, pad), (0, 0), (0, 0))
    q, k, v, logf = [jnp.pad(t, padding) for t in (q, k, v, logf)]
    n = (L + pad) // HGRN_BLOCK

    def blocks(t):
        return t.reshape(B, n, HGRN_BLOCK, H, t.shape[-1]).transpose(1, 0, 2, 3, 4)

    S, o = lax.scan(hgrn_block_step, S0, (blocks(q), blocks(k), blocks(v), blocks(logf)))
    o = o.transpose(1, 0, 2, 3, 4).reshape(B, n * HGRN_BLOCK, H, HGRN_DV)[:, :L]
    return o, S


def hgrn_mixer(h, S0, lb, w_in, w_out, out_norm):
    B, L, _ = h.shape
    f32 = jnp.float32
    q, fz, i_in, gate = jnp.split(h @ w_in, 4, axis=-1)
    f = lb + (1.0 - lb) * jax.nn.sigmoid(fz.astype(f32))
    kshape = (B, L, HGRN_HEADS, HGRN_DK)
    o, S = hgrn_scan(q.astype(f32).reshape(kshape), (1.0 - f).reshape(kshape),
                     i_in.astype(f32).reshape(B, L, HGRN_HEADS, HGRN_DV),
                     jnp.log(f).reshape(kshape), S0.astype(f32))
    o = rms_norm(o, out_norm).reshape(B, L, HGRN_HEADS * HGRN_DV) * jax.nn.silu(gate.astype(f32))
    return o.astype(h.dtype) @ w_out, S.astype(S0.dtype)


def diff_project(h, w_in, q_g, k_g):
    B, L, _ = h.shape
    q, k, v = jnp.split(h @ w_in, 3, axis=-1)
    q = rms_norm(q.reshape(B, L, DIFF_HEADS, 2, DIFF_DH), q_g)
    k = rms_norm(k.reshape(B, L, DIFF_HEADS, 2, DIFF_DH), k_g)
    v = v.reshape(B, L, DIFF_HEADS, 2 * DIFF_DH)
    return q, k, v


def diff_attend(q, k, v, mask, lam):
    s = jnp.einsum('bqhcd,bkhcd->bhcqk', q, k).astype(jnp.float32) * (DIFF_DH ** -0.5)
    p = jax.nn.softmax(jnp.where(mask, s, -jnp.inf), axis=-1)
    a = p[:, :, 0] - lam * p[:, :, 1]
    return jnp.einsum('bhqk,bkhe->bqhe', a, v.astype(jnp.float32))


def diff_attn_prompt(q, k, v, lam):
    B, L = q.shape[:2]
    n = L // Q_BLOCK
    key_pos = jnp.arange(L)

    def one_block(i):
        qb = lax.dynamic_slice_in_dim(q, i * Q_BLOCK, Q_BLOCK, axis=1)
        q_pos = i * Q_BLOCK + jnp.arange(Q_BLOCK)
        mask = key_pos[None, :] < ((q_pos // CHUNK + 1) * CHUNK)[:, None]
        return diff_attend(qb, k, v, mask, lam)

    o = lax.map(one_block, jnp.arange(n))
    return o.transpose(1, 0, 2, 3, 4).reshape(B, L, DIFF_HEADS, 2 * DIFF_DH)


def diff_output(o, subln, lam_init, w_out, dtype):
    B, L = o.shape[:2]
    o = rms_norm(o, subln) * (1.0 - lam_init)
    return o.reshape(B, L, D_MODEL).astype(dtype) @ w_out


def conv_ffn(h, prev, w_up, conv_w, conv_b, w_down):
    L = h.shape[1]
    gate, up = jnp.split(h @ w_up, 2, axis=-1)
    gp = jnp.concatenate([prev.astype(gate.dtype), gate], axis=1)
    conv = conv_b + conv_w[CONV_W - 1] * gp[:, CONV_W - 1:]
    for j in range(CONV_W - 1):
        conv = conv + conv_w[j] * gp[:, j:j + L]
    y = (jax.nn.silu(conv) * up) @ w_down
    return y, gp[:, -(CONV_W - 1):]


def setup_inputs(seed: int = 0) -> dict:
    key = jax.random.key(seed)
    ks = jax.random.split(key, 26)
    f32 = jnp.float32

    def nrm(k, shape, scale):
        return jax.random.normal(k, shape, f32) * scale

    d = D_MODEL
    return {
        "x_prompt": nrm(ks[0], (BATCH, SEQ, d), 1.0),
        "x_sample": nrm(ks[1], (DEC_BATCH, DEC_SEQ, d), 1.0),
        "state_hgrn": nrm(ks[2], (N_HGRN_LAYERS, DEC_BATCH, HGRN_HEADS, HGRN_DK, HGRN_DV), 0.5),
        "cache_k": nrm(ks[3], (N_ATTN_LAYERS, DEC_BATCH, PAST_LEN, DIFF_HEADS, 2, DIFF_DH), 1.0),
        "cache_v": nrm(ks[4], (N_ATTN_LAYERS, DEC_BATCH, PAST_LEN, DIFF_HEADS, 2 * DIFF_DH), 1.0),
        "state_ffn_conv": nrm(ks[5], (DEPTH, DEC_BATCH, CONV_W - 1, D_FF), 1.0),
        "norm_mix": 1.0 + nrm(ks[6], (DEPTH, d), 0.02),
        "norm_ffn": 1.0 + nrm(ks[7], (DEPTH, d), 0.02),
        "hgrn_lower_bounds": nrm(ks[8], (DEPTH + 1, HGRN_D_KEY), 0.5),
        "w_hgrn_in": nrm(ks[9], (N_HGRN_LAYERS, d, 4 * HGRN_D_KEY), d ** -0.5),
        "w_hgrn_out": nrm(ks[10], (N_HGRN_LAYERS, HGRN_HEADS * HGRN_DV, d), (HGRN_HEADS * HGRN_DV) ** -0.5),
        "hgrn_out_norm": 1.0 + nrm(ks[11], (N_HGRN_LAYERS, HGRN_DV), 0.02),
        "w_diff_in": nrm(ks[12], (N_ATTN_LAYERS, d, 3 * d), d ** -0.5),
        "w_diff_out": nrm(ks[13], (N_ATTN_LAYERS, d, d), d ** -0.5),
        "diff_q_norm": 1.0 + nrm(ks[14], (N_ATTN_LAYERS, DIFF_DH), 0.02),
        "diff_k_norm": 1.0 + nrm(ks[15], (N_ATTN_LAYERS, DIFF_DH), 0.02),
        "diff_lambda_q1": nrm(ks[16], (N_ATTN_LAYERS, DIFF_DH), 0.1),
        "diff_lambda_k1": nrm(ks[17], (N_ATTN_LAYERS, DIFF_DH), 0.1),
        "diff_lambda_q2": nrm(ks[18], (N_ATTN_LAYERS, DIFF_DH), 0.1),
        "diff_lambda_k2": nrm(ks[19], (N_ATTN_LAYERS, DIFF_DH), 0.1),
        "diff_subln": 1.0 + nrm(ks[20], (N_ATTN_LAYERS, 2 * DIFF_DH), 0.02),
        "w_ffn_up": nrm(ks[21], (DEPTH, d, 2 * D_FF), d ** -0.5),
        "ffn_conv_w": nrm(ks[22], (DEPTH, CONV_W, D_FF), CONV_W ** -0.5),
        "ffn_conv_b": nrm(ks[23], (DEPTH, D_FF), 0.01),
        "w_ffn_down": nrm(ks[24], (DEPTH, D_FF, d), D_FF ** -0.5),
    }


def reference(x_prompt, x_sample, state_hgrn, cache_k, cache_v, state_ffn_conv,
              norm_mix, norm_ffn, hgrn_lower_bounds, w_hgrn_in, w_hgrn_out, hgrn_out_norm,
              w_diff_in, w_diff_out, diff_q_norm, diff_k_norm,
              diff_lambda_q1, diff_lambda_k1, diff_lambda_q2, diff_lambda_k2, diff_subln,
              w_ffn_up, ffn_conv_w, ffn_conv_b, w_ffn_down):
    f32 = jnp.float32
    lb_table = jnp.cumsum(jax.nn.softmax(hgrn_lower_bounds.astype(f32), axis=0), axis=0)
    xp, xs = x_prompt, x_sample
    bp = xp.shape[0]
    hgrn_p, hgrn_s = [], []
    kp_rows, vp_rows, ks_rows, vs_rows = [], [], [], []
    conv_p, conv_s = [], []
    for i in range(DEPTH):
        j = i // N_MIXERS
        hp = rms_norm(xp, norm_mix[i])
        hs = rms_norm(xs, norm_mix[i])
        if i % N_MIXERS == 0:
            lb = lb_table[i]
            s0 = jnp.zeros((bp, HGRN_HEADS, HGRN_DK, HGRN_DV), state_hgrn.dtype)
            yp, sp = hgrn_mixer(hp, s0, lb, w_hgrn_in[j], w_hgrn_out[j], hgrn_out_norm[j])
            ys, ss = hgrn_mixer(hs, state_hgrn[j], lb, w_hgrn_in[j], w_hgrn_out[j], hgrn_out_norm[j])
            hgrn_p.append(sp)
            hgrn_s.append(ss)
        else:
            lam_init = 0.8 - 0.6 * math.exp(-0.3 * i)
            lam = (jnp.exp(jnp.sum(diff_lambda_q1[j].astype(f32) * diff_lambda_k1[j].astype(f32)))
                   - jnp.exp(jnp.sum(diff_lambda_q2[j].astype(f32) * diff_lambda_k2[j].astype(f32)))
                   + lam_init)
            qp, kp, vp = diff_project(hp, w_diff_in[j], diff_q_norm[j], diff_k_norm[j])
            op = diff_attn_prompt(qp, kp, vp, lam)
            qs, kss, vss = diff_project(hs, w_diff_in[j], diff_q_norm[j], diff_k_norm[j])
            k_all = jnp.concatenate([cache_k[j].astype(kss.dtype), kss], axis=1)
            v_all = jnp.concatenate([cache_v[j].astype(vss.dtype), vss], axis=1)
            mask = jnp.ones((qs.shape[1], k_all.shape[1]), bool)
            os_ = diff_attend(qs, k_all, v_all, mask, lam)
            yp = diff_output(op, diff_subln[j], lam_init, w_diff_out[j], hp.dtype)
            ys = diff_output(os_, diff_subln[j], lam_init, w_diff_out[j], hs.dtype)
            kp_rows.append(kp)
            vp_rows.append(vp)
            ks_rows.append(kss)
            vs_rows.append(vss)
        xp = xp + yp
        xs = xs + ys
        fp, cp = conv_ffn(rms_norm(xp, norm_ffn[i]), jnp.zeros((bp, CONV_W - 1, D_FF), xp.dtype),
                          w_ffn_up[i], ffn_conv_w[i], ffn_conv_b[i], w_ffn_down[i])
        fs, cs = conv_ffn(rms_norm(xs, norm_ffn[i]), state_ffn_conv[i],
                          w_ffn_up[i], ffn_conv_w[i], ffn_conv_b[i], w_ffn_down[i])
        xp = xp + fp
        xs = xs + fs
        conv_p.append(cp)
        conv_s.append(cs)
    return (xp, xs, jnp.stack(hgrn_p), jnp.stack(hgrn_s),
            jnp.stack(kp_rows), jnp.stack(vp_rows), jnp.stack(ks_rows), jnp.stack(vs_rows),
            jnp.stack(conv_p), jnp.stack(conv_s))
```

```cpp
#include <hip/hip_runtime.h>
#include <hip/hip_bf16.h>
#include <cstdio>
#include <cstdint>
#include <cmath>

constexpr int DM = 2048;
constexpr int MP = 8192, MS = 1024;
constexpr int MR = MP + MS;
constexpr int DFF = 5632, NUP = 2 * DFF;
constexpr int NHG = 4 * DM;
constexpr int NDI = 3 * DM;
constexpr int NCH = MR / 64;
constexpr int NCHP = MP / 64;
constexpr int PAST = 4096;
constexpr float EPS = 1e-6f;
constexpr float LAM_INIT = 0.35550906759f;

constexpr size_t O_Y = 0;
constexpr size_t O_HP = (size_t)MR * DM;
constexpr size_t O_HS = O_HP + 16 * 128 * 128;
constexpr size_t O_KP = O_HS + (size_t)16 * 16 * 128 * 128;
constexpr size_t O_VP = O_KP + (size_t)MP * DM;
constexpr size_t O_KS = O_VP + (size_t)MP * DM;
constexpr size_t O_VS = O_KS + (size_t)MS * DM;
constexpr size_t O_CP = O_VS + (size_t)MS * DM;
constexpr size_t O_CS = O_CP + 2 * 2 * DFF;
constexpr size_t O_END = O_CS + (size_t)2 * 16 * 2 * DFF;
static_assert(O_END == 61462528, "output size");

constexpr size_t MiB = 1u << 20;
constexpr size_t WS_CTL = 0, CTL_ZERO_BYTES = 1 * MiB;
constexpr size_t WS_SMALL = 1 * MiB;
constexpr size_t WS_W_HIN = 2 * MiB, WS_W_HOUT = 34 * MiB, WS_W_UP0 = 42 * MiB, WS_W_DN0 = 86 * MiB, WS_W_DIN = 108 * MiB, WS_W_DOUT = 132 * MiB, WS_W_UP1 = 140 * MiB, WS_W_DN1 = 184 * MiB;
constexpr size_t WS_XB = 206 * MiB, WS_QH = 242 * MiB, WS_KH = 278 * MiB, WS_VH = 314 * MiB, WS_SG = 350 * MiB, WS_G = 386 * MiB;
constexpr size_t WS_LST = 458 * MiB, WS_DC = 602 * MiB, WS_SIN = 604 * MiB, WS_HA = 676 * MiB, WS_X1 = 712 * MiB, WS_GU = 784 * MiB, WS_ACT = 982 * MiB;
constexpr size_t WS_QKR = 1081 * MiB, WS_OA = 1153 * MiB, WS_END = 1297 * MiB;
constexpr int CW_TMO = 0;
constexpr int CW_BAR = 4096;
constexpr int CW_SS1 = 65536, CW_SS2 = 65536 + 16384, CW_SS3 = 65536 + 2 * 16384;
constexpr int SM_RINV0 = 0, SM_LB = 16384, SM_LAM = 16384 + 4096;

constexpr int RING_OFF = 0, RING_BYTES = 131072;
constexpr int SCR_OFF = RING_BYTES;
constexpr int LDSCTL_OFF = RING_BYTES + 8192, MISC_OFF = LDSCTL_OFF + 320;
constexpr int LDS_BYTES = 147456;
constexpr int NWAVES = 8;

#define GAS __attribute__((address_space(1)))
#define LAS __attribute__((address_space(3)))
typedef unsigned short bf16;
typedef unsigned v4u __attribute__((ext_vector_type(4)));
typedef unsigned v2u __attribute__((ext_vector_type(2)));
typedef float f32x4 __attribute__((ext_vector_type(4)));
typedef float f32x2 __attribute__((ext_vector_type(2)));
typedef float f32x16 __attribute__((ext_vector_type(16)));
typedef short bf16x8 __attribute__((ext_vector_type(8)));
typedef short s16x4 __attribute__((ext_vector_type(4)));
typedef GAS unsigned gu32;
#define RLX_AGENT __ATOMIC_RELAXED, __HIP_MEMORY_SCOPE_AGENT
#define LDS_WAIT() asm volatile("s_waitcnt lgkmcnt(0)" ::: "memory")
#define VM_WAIT() asm volatile("s_waitcnt vmcnt(0)" ::: "memory")
__device__ __forceinline__ unsigned f2bf(float f) { unsigned u = __builtin_bit_cast(unsigned, f); return (u + 0x7fffu + ((u >> 16) & 1u)) >> 16; }
__device__ __forceinline__ unsigned pk2(float lo, float hi) { return f2bf(lo) | (f2bf(hi) << 16); }
__device__ __forceinline__ unsigned cvtpk(float lo, float hi) { unsigned r; asm volatile("v_cvt_pk_bf16_f32 %0, %1, %2" : "=v"(r) : "v"(lo), "v"(hi)); return r; }
__device__ __forceinline__ float bflo(unsigned w) { return __uint_as_float(w << 16); }
__device__ __forceinline__ float bfhi(unsigned w) { return __uint_as_float(w & 0xffff0000u); }
__device__ __forceinline__ float wave_sum(float v) {
#pragma unroll
    for (int o = 1; o < 64; o <<= 1) v += __shfl_xor(v, o);
    return v;
}
__device__ __forceinline__ float sigmoidf_(float z) { return __builtin_amdgcn_rcpf(1.f + __expf(-z)); }
namespace pg8 {
#define PG8_LAS __attribute__((address_space(3)))
typedef unsigned short bf16_t;
typedef short bf16x8 __attribute__((ext_vector_type(8)));
typedef float f32x4 __attribute__((ext_vector_type(4)));
typedef unsigned u32x4 __attribute__((ext_vector_type(4)));
constexpr int BM = 256, BK = 64, HALF = 128, HTB = HALF * BK * 2  , STAGE_BYTES = 8 * HTB, NXCD = 8, WGM = 8;

__host__ __device__ __forceinline__ int lds_byte(int r, int c) { const int st = (r >> 4) * 2 + (c >> 5), rr = r & 15, cc = c & 31, ob = rr * 64 + cc * 2; return st * 1024 + (ob ^ (((ob >> 9) & 1) << 5)); }
__host__ __device__ __forceinline__ void stage_rc(int b, int& R, int& C) { const int st = b / 1024, sb = b % 1024, swz = sb ^ (((sb >> 9) & 1) << 5); R = (st >> 1) * 16 + swz / 64; C = (st & 1) * 32 + (swz % 64) / 2; }
__host__ __device__ __forceinline__ int perm32(int rho) { const int n = rho >> 4, i = rho & 15; return 8 * (i >> 2) + 4 * n + (i & 3); }

struct Unit { int pm, pn; };
struct Gemm { const bf16_t* A; const bf16_t* Bt; int M, N, K; };

struct StaticOrder {
    int nM, nN, nwg, G, c;
    __host__ __device__ void init(int M, int N, int G_, int c_) { nM = M / BM; nN = N / BM; nwg = nM * nN; G = G_; c = c_; }
    __host__ __device__ bool next(int i, Unit& u) const {
        const long L = (long)i * G + c; if (L >= nwg) return false;
        int wgid = (int)L; { const int q = nwg / NXCD, r = nwg % NXCD, xcd = wgid % NXCD, off = wgid / NXCD; wgid = (xcd < r ? xcd * (q + 1) : r * (q + 1) + (xcd - r) * q) + off; }
        const int nig = WGM * nN, gid = wgid / nig, fm = gid * WGM, gsz = (nM - fm) < WGM ? (nM - fm) : WGM;
        u.pm = fm + ((wgid % nig) % gsz); u.pn = (wgid % nig) / gsz; return true;
    }
    __device__ __forceinline__ void a_ready(const Unit&) const {}
    __device__ __forceinline__ void done(const Unit&) const {}
};

__device__ __forceinline__ unsigned cvt_pk_bf16(float lo, float hi) { unsigned r; asm volatile("v_cvt_pk_bf16_f32 %0, %1, %2" : "=v"(r) : "v"(lo), "v"(hi)); return r; }
typedef float f32x2 __attribute__((ext_vector_type(2)));
template <class Epi, class Sched, bool ALIGN_EPI = false, bool SP2 = false>
__device__ __forceinline__ void gemm_phase(PG8_LAS unsigned char* lds, const Gemm g, const Sched& S, const Epi& E) {
    const int tid = threadIdx.x, wid = __builtin_amdgcn_readfirstlane(tid >> 6), lane = tid & 63, wr = wid >> 2, wc = wid & 3, fr = lane & 15, fq = lane >> 4;
    const int K = g.K, nt = K / BK;
    unsigned voffA[2], voffB[2];
#pragma unroll
    for (int i = 0; i < 2; ++i) { int R, C; stage_rc(tid * 16 + i * 8192, R, C); const int Rb = Epi::PERM ? ((R & ~31) + perm32(R & 31)) : R;
        voffA[i] = (unsigned)(R * K + C) * 2u; voffB[i] = (unsigned)(Rb * K + C) * 2u; }
    const size_t kstep = (size_t)(BK * 2);
    const size_t hstep = (size_t)HALF * K * 2;
    const size_t tstep = 2 * hstep;
    const unsigned ldsw = (unsigned)wid * 1024u;
    const int aoff = lds_byte(wr * 64 + fr, fq * 8), boff = lds_byte(wc * 32 + fr, fq * 8);
#define PG8_SA(b, h) (((b) * 2 + (h)) * HTB)
#define PG8_SB(b, h) ((4 + (b) * 2 + (h)) * HTB)
#define PG8_STAGE(bufoff, gbase, voff) do { _Pragma("unroll") for (int _i = 0; _i < 2; ++_i) \
        __builtin_amdgcn_global_load_lds((const unsigned*)((const char*)(gbase) + (voff)[_i]), (PG8_LAS unsigned*)(lds + (bufoff) + ldsw + _i * 8192), 16, 0, 0); } while (0)
#define PG8_LDA(dst, b, h) do { _Pragma("unroll") for (int m = 0; m < 4; ++m) _Pragma("unroll") for (int k = 0; k < 2; ++k) dst[m][k] = *(const PG8_LAS bf16x8*)(lds + PG8_SA(b, h) + aoff + m * 2048 + k * 1024); } while (0)
#define PG8_LDB(dst, b, h) do { _Pragma("unroll") for (int n = 0; n < 2; ++n) _Pragma("unroll") for (int k = 0; k < 2; ++k) dst[n][k] = *(const PG8_LAS bf16x8*)(lds + PG8_SB(b, h) + boff + n * 2048 + k * 1024); } while (0)
#define PG8_MMA(ai, bj, At, Bt) do { __builtin_amdgcn_s_setprio(1); _Pragma("unroll") for (int m = 0; m < 4; ++m) _Pragma("unroll") for (int n = 0; n < 2; ++n) _Pragma("unroll") for (int k = 0; k < 2; ++k) \
        acc[ai][bj][m][n] = __builtin_amdgcn_mfma_f32_16x16x32_bf16(Bt[n][k], At[m][k], acc[ai][bj][m][n], 0, 0, 0); __builtin_amdgcn_s_setprio(0); } while (0)
#define PG8_WAIT_V(n) asm volatile("s_waitcnt vmcnt(" #n ")" ::: "memory")
#define PG8_WAIT_L(n) asm volatile("s_waitcnt lgkmcnt(" #n ")" ::: "memory")
#define PG8_BAR __builtin_amdgcn_s_barrier()
#define PG8_SCHED __builtin_amdgcn_sched_barrier(0)
    Unit cur, nxt; int ui = 0;
    if (!S.next(0, cur)) return;
    f32x4 acc[2][2][4][2];
#pragma unroll
    for (int a = 0; a < 2; ++a)
#pragma unroll
        for (int b = 0; b < 2; ++b)
#pragma unroll
            for (int m = 0; m < 4; ++m)
#pragma unroll
                for (int n = 0; n < 2; ++n) acc[a][b][m][n] = (f32x4){0.f, 0.f, 0.f, 0.f};
    bf16x8 At[4][2], B0[2][2], B1[2][2];
    const char* cA = (const char*)g.A + (size_t)cur.pm * tstep; const char* cB = (const char*)g.Bt + (size_t)cur.pn * tstep;
    S.a_ready(cur);
    if constexpr (SP2) {
        PG8_STAGE(PG8_SB(0, 0), cB, voffB); PG8_STAGE(PG8_SB(0, 1), cB + hstep, voffB); PG8_STAGE(PG8_SA(0, 0), cA, voffA); PG8_STAGE(PG8_SA(0, 1), cA + hstep, voffA);
        if (wr == 1) PG8_BAR;
        PG8_WAIT_V(2); PG8_BAR;
        PG8_STAGE(PG8_SB(1, 0), cB + kstep, voffB); PG8_STAGE(PG8_SA(1, 0), cA + kstep, voffA); PG8_STAGE(PG8_SB(1, 1), cB + hstep + kstep, voffB);
        PG8_WAIT_V(6); PG8_BAR;
    } else {
        PG8_STAGE(PG8_SB(0, 0), cB, voffB); PG8_STAGE(PG8_SA(0, 0), cA, voffA); PG8_STAGE(PG8_SB(0, 1), cB + hstep, voffB); PG8_STAGE(PG8_SA(0, 1), cA + hstep, voffA);
        if (wr == 1) PG8_BAR;
        PG8_WAIT_V(4); PG8_BAR;
        PG8_STAGE(PG8_SB(1, 0), cB + kstep, voffB); PG8_STAGE(PG8_SA(1, 0), cA + kstep, voffA); PG8_STAGE(PG8_SB(1, 1), cB + hstep + kstep, voffB);
        PG8_WAIT_V(6); PG8_BAR;
    }
    for (;;) {
        const bool has_next = S.next(ui + 1, nxt);
        const char* nA = has_next ? (const char*)g.A + (size_t)nxt.pm * tstep : cA; const char* nB = has_next ? (const char*)g.Bt + (size_t)nxt.pn * tstep : cB;
        for (int t = 0; t < nt; t += 2) {
            const bool last = (t == nt - 2);
            const char* a1 = cA + (size_t)(t + 1) * kstep;
            const char* a2 = last ? nA : cA + (size_t)(t + 2) * kstep; const char* b2 = last ? nB : cB + (size_t)(t + 2) * kstep;
            const char* a3 = a2 + kstep; const char* b3 = b2 + kstep;
            if (last && has_next) S.a_ready(nxt);
            if constexpr (SP2) {
            PG8_LDB(B0, 0, 0); PG8_LDB(B1, 0, 1); PG8_SCHED; PG8_LDA(At, 0, 0); PG8_STAGE(PG8_SA(1, 1), a1 + hstep, voffA);
            PG8_WAIT_V(8); PG8_WAIT_L(0); PG8_BAR; PG8_MMA(0, 0, At, B0); PG8_MMA(0, 1, At, B1); PG8_BAR; PG8_SCHED;
            PG8_LDA(At, 0, 1); PG8_STAGE(PG8_SB(0, 0), b2, voffB); PG8_STAGE(PG8_SB(0, 1), b2 + hstep, voffB); PG8_STAGE(PG8_SA(0, 0), a2, voffA);
            PG8_WAIT_V(8); PG8_WAIT_L(0); PG8_BAR; PG8_MMA(1, 0, At, B0); PG8_MMA(1, 1, At, B1); PG8_BAR; PG8_SCHED;
            PG8_LDB(B0, 1, 0); PG8_LDB(B1, 1, 1); PG8_SCHED; PG8_LDA(At, 1, 0); PG8_STAGE(PG8_SA(0, 1), a2 + hstep, voffA);
            PG8_WAIT_V(8); PG8_WAIT_L(0); PG8_BAR; PG8_MMA(0, 0, At, B0); PG8_MMA(0, 1, At, B1); PG8_BAR; PG8_SCHED;
            PG8_LDA(At, 1, 1); PG8_STAGE(PG8_SB(1, 0), b3, voffB); PG8_STAGE(PG8_SB(1, 1), b3 + hstep, voffB); PG8_STAGE(PG8_SA(1, 0), a3, voffA);
            PG8_WAIT_V(8); PG8_WAIT_L(0); PG8_BAR; PG8_MMA(1, 0, At, B0); PG8_MMA(1, 1, At, B1); PG8_BAR; PG8_SCHED;
            } else {
            PG8_LDB(B0, 0, 0); PG8_SCHED; PG8_LDA(At, 0, 0); PG8_STAGE(PG8_SA(1, 1), a1 + hstep, voffA);
            PG8_WAIT_L(8); PG8_BAR; PG8_WAIT_L(0); PG8_MMA(0, 0, At, B0); PG8_BAR; PG8_SCHED;
            PG8_LDB(B1, 0, 1); PG8_STAGE(PG8_SB(0, 0), b2, voffB);
            PG8_BAR; PG8_WAIT_L(0); PG8_MMA(0, 1, At, B1); PG8_BAR;
            PG8_LDA(At, 0, 1); PG8_STAGE(PG8_SA(0, 0), a2, voffA);
            PG8_BAR; PG8_WAIT_L(0); PG8_MMA(1, 0, At, B0); PG8_BAR; PG8_SCHED;
            PG8_STAGE(PG8_SB(0, 1), b2 + hstep, voffB);
            PG8_WAIT_V(6); PG8_BAR; PG8_MMA(1, 1, At, B1); PG8_BAR;
            PG8_LDB(B0, 1, 0); PG8_SCHED; PG8_LDA(At, 1, 0); PG8_STAGE(PG8_SA(0, 1), a2 + hstep, voffA);
            PG8_WAIT_L(8); PG8_BAR; PG8_WAIT_L(0); PG8_MMA(0, 0, At, B0); PG8_BAR; PG8_SCHED;
            PG8_LDB(B1, 1, 1); PG8_STAGE(PG8_SB(1, 0), b3, voffB);
            PG8_BAR; PG8_WAIT_L(0); PG8_MMA(0, 1, At, B1); PG8_BAR;
            PG8_LDA(At, 1, 1); PG8_STAGE(PG8_SA(1, 0), a3, voffA);
            PG8_BAR; PG8_WAIT_L(0); PG8_MMA(1, 0, At, B0); PG8_BAR; PG8_SCHED;
            PG8_STAGE(PG8_SB(1, 1), b3 + hstep, voffB);
            PG8_WAIT_V(6); PG8_BAR; PG8_MMA(1, 1, At, B1); PG8_BAR;
            }
        }
        if constexpr (ALIGN_EPI) { if (wr == 0) PG8_BAR; }
        if constexpr (!Epi::AFTER_DRAIN) { E(acc, cur, wr, wc, fr, fq); S.done(cur); }
        if (!has_next) break;
#pragma unroll
        for (int a = 0; a < 2; ++a)
#pragma unroll
            for (int b = 0; b < 2; ++b)
#pragma unroll
                for (int m = 0; m < 4; ++m)
#pragma unroll
                    for (int n = 0; n < 2; ++n) acc[a][b][m][n] = (f32x4){0.f, 0.f, 0.f, 0.f};
        cur = nxt; cA = nA; cB = nB; ++ui;
        if constexpr (ALIGN_EPI) { if (wr == 1) PG8_BAR; }
    }
    PG8_WAIT_V(0);
    if constexpr (!ALIGN_EPI) { if (wr == 0) PG8_BAR; }
    PG8_BAR;
    if constexpr (Epi::AFTER_DRAIN) { E.fused(acc, cur, wr, wc, fr, fq, lds, wid, lane); S.done(cur); }
#undef PG8_SA
#undef PG8_SB
#undef PG8_STAGE
#undef PG8_LDA
#undef PG8_LDB
#undef PG8_MMA
#undef PG8_WAIT_V
#undef PG8_WAIT_L
#undef PG8_BAR
#undef PG8_SCHED
}
}

#define EPI_ARGS const pg8::f32x4 (&acc)[2][2][4][2], const pg8::Unit& u, int wr, int wc, int fr, int fq
__device__ __forceinline__ void st8bf(bf16* p, f32x4 a, f32x4 b) {
    v4u w; w.x = cvtpk(a[0], a[1]); w.y = cvtpk(a[2], a[3]); w.z = cvtpk(b[0], b[1]); w.w = cvtpk(b[2], b[3]); *(v4u*)p = w;
}
__device__ __forceinline__ void st8f(float* p, f32x4 a, f32x4 b) { *(f32x4*)p = a; *(f32x4*)(p + 4) = b; }

struct EpiHgrnIn {
    static constexpr bool PERM = true, AFTER_DRAIN = false;
    bf16 *Q, *K, *V, *SG; float* G; const float* rinv; const float* lb;
    __device__ __forceinline__ void operator()(EPI_ARGS) const {
        const int sec = u.pn >> 3, cl0 = (u.pn & 7) * 256 + wc * 32 + 8 * fq;
#pragma unroll
        for (int ai = 0; ai < 2; ++ai)
#pragma unroll
            for (int m = 0; m < 4; ++m) {
                const int row = u.pm * 256 + ai * 128 + wr * 64 + m * 16 + fr; const float r = rinv[row];
#pragma unroll
                for (int bj = 0; bj < 2; ++bj) {
                    const int lc = cl0 + bj * 128; const size_t off = (size_t)row * DM + lc;
                    f32x4 a = acc[ai][bj][m][0] * r, b = acc[ai][bj][m][1] * r;
                    if (sec == 0) st8bf(Q + off, a, b);
                    else if (sec == 2) st8bf(V + off, a, b);
                    else if (sec == 3) {
#pragma unroll
                        for (int i = 0; i < 4; ++i) { a[i] = a[i] * sigmoidf_(a[i]); b[i] = b[i] * sigmoidf_(b[i]); }
                        st8bf(SG + off, a, b);
                    } else {
                        const f32x4 l0 = *(const f32x4*)(lb + lc), l1 = *(const f32x4*)(lb + lc + 4);
                        f32x4 ka, kb, ga, gb;
#pragma unroll
                        for (int i = 0; i < 4; ++i) {
                            const float f0 = l0[i] + (1.f - l0[i]) * sigmoidf_(a[i]), f1 = l1[i] + (1.f - l1[i]) * sigmoidf_(b[i]);
                            ka[i] = 1.f - f0; kb[i] = 1.f - f1; ga[i] = __logf(f0); gb[i] = __logf(f1);
                        }
                        st8bf(K + off, ka, kb); st8f(G + off, ga, gb);
                    }
                }
            }
    }
};

template <bool NEXT> struct EpiResid {
    static constexpr bool PERM = true, AFTER_DRAIN = false;
    const float* xin_p; const float* xin_s;
    float* Xout; bf16* XB; float* ss;
    __device__ __forceinline__ void operator()(EPI_ARGS) const {
        const float* xin = (u.pm < 32) ? xin_p : xin_s;
        const int c0 = u.pn * 256 + wc * 32 + 8 * fq;
#pragma unroll
        for (int ai = 0; ai < 2; ++ai)
#pragma unroll
            for (int m = 0; m < 4; ++m) {
                const int row = u.pm * 256 + ai * 128 + wr * 64 + m * 16 + fr; float s = 0.f;
#pragma unroll
                for (int bj = 0; bj < 2; ++bj) {
                    const size_t off = (size_t)row * DM + c0 + bj * 128;
                    const f32x4 a = acc[ai][bj][m][0] + *(const f32x4*)(xin + off), b = acc[ai][bj][m][1] + *(const f32x4*)(xin + off + 4);
                    st8f(Xout + off, a, b);
                    if (NEXT) { st8bf(XB + off, a, b); s += (a[0] * a[0] + a[1] * a[1]) + (a[2] * a[2] + a[3] * a[3]) + (b[0] * b[0] + b[1] * b[1]) + (b[2] * b[2] + b[3] * b[3]); }
                }
                if (NEXT) { s += __shfl_xor(s, 16); s += __shfl_xor(s, 32); if (fq == 0) atomicAdd(ss + row, s); }
            }
    }
};

struct EpiUp {
    static constexpr bool PERM = true, AFTER_DRAIN = false;
    bf16* GU; const float* ss; float* conv_p; float* conv_s;
    __device__ __forceinline__ void operator()(EPI_ARGS) const {
        const int c0 = u.pn * 256 + wc * 32 + 8 * fq;
#pragma unroll
        for (int ai = 0; ai < 2; ++ai)
#pragma unroll
            for (int m = 0; m < 4; ++m) {
                const int row = u.pm * 256 + ai * 128 + wr * 64 + m * 16 + fr; const float r = __builtin_amdgcn_rsqf(ss[row] * (1.f / DM) + EPS);
#pragma unroll
                for (int bj = 0; bj < 2; ++bj) {
                    const int col = c0 + bj * 128;
                    const f32x4 a = acc[ai][bj][m][0] * r, b = acc[ai][bj][m][1] * r;
                    st8bf(GU + (size_t)row * NUP + col, a, b);
                    if (m == 3 && u.pn < 22 && fr >= 14) {
                        if (row >= MP) { const int sb = (row - MP) >> 6; st8f(conv_s + ((size_t)sb * 2 + (fr - 14)) * DFF + col, a, b); }
                        else if (row >= MP - 2) st8f(conv_p + (size_t)(row - (MP - 2)) * DFF + col, a, b);
                    }
                }
            }
    }
};

struct EpiDiffIn {
    static constexpr bool PERM = true, AFTER_DRAIN = false;
    bf16* QKR; bf16* VB; const float* ss; float* vout_p; float* vout_s;
    __device__ __forceinline__ void operator()(EPI_ARGS) const {
        const int c0 = u.pn * 256 + wc * 32 + 8 * fq;
        float* vout = (u.pm < 32) ? vout_p : vout_s;
#pragma unroll
        for (int ai = 0; ai < 2; ++ai)
#pragma unroll
            for (int m = 0; m < 4; ++m) {
                const int row = u.pm * 256 + ai * 128 + wr * 64 + m * 16 + fr; const float r = __builtin_amdgcn_rsqf(ss[row] * (1.f / DM) + EPS);
#pragma unroll
                for (int bj = 0; bj < 2; ++bj) {
                    const int col = c0 + bj * 128;
                    const f32x4 a = acc[ai][bj][m][0] * r, b = acc[ai][bj][m][1] * r;
                    if (u.pn < 16) st8bf(QKR + (size_t)row * 4096 + col, a, b);
                    else { const size_t off = (size_t)row * DM + (col - 4096); st8bf(VB + off, a, b); st8f(vout + off, a, b); }
                }
            }
    }
};
#define XB_TMO      128
#define XB_XCNT(j)  (256  + 64 * (j))
#define XB_XSUB(j)  (1280 + 64 * (j))
#define XB_XGEN(j)  (2304 + 64 * (j))
#define XB_TOP      3328
#define XB_TOPGEN   3392
#define XCD_BAR_WORDS 3456
#define XB_SPIN_CAP (1u << 18)

__device__ __forceinline__ unsigned xb_ld(unsigned* p)              { return __hip_atomic_load(p, __ATOMIC_RELAXED, __HIP_MEMORY_SCOPE_AGENT); }
__device__ __forceinline__ unsigned xb_add(unsigned* p, unsigned v) { return __hip_atomic_fetch_add(p, v, __ATOMIC_RELAXED, __HIP_MEMORY_SCOPE_AGENT); }
__device__ __forceinline__ unsigned xb_xcc_id() { return (unsigned)__builtin_amdgcn_s_getreg((3 << 11) | 20) & 0xFu; }
#define XB_SPIN(cond, bar) do { unsigned _sp = 0; while (cond) { __builtin_amdgcn_s_sleep(1); \
    if ((++_sp & 255u) == 0u) { if (xb_ld(&(bar)[XB_TMO])) break; if (_sp > XB_SPIN_CAP) { atomicAdd(&(bar)[XB_TMO], 1u); break; } } } } while (0)

struct XcdBarrier {
    unsigned* bar; unsigned x;
    volatile LAS unsigned* st;
};

__device__ __forceinline__ XcdBarrier xcd_barrier_post(unsigned* bar, volatile LAS unsigned* st) {
    XcdBarrier b; b.bar = bar; b.x = xb_xcc_id(); b.st = st;
    if (threadIdx.x == 0) (void)xb_add(&bar[XB_XCNT(b.x)], 1u);
    return b;
}
__device__ __forceinline__ void xcd_barrier_complete(unsigned* bar, unsigned x, unsigned& nloc, unsigned& nx) {
    const unsigned G = gridDim.x * gridDim.y * gridDim.z;
    unsigned sum, cnt, mine, sp = 0u;
    for (;;) {
        sum = 0u; cnt = 0u; mine = 0u;
#pragma unroll
        for (unsigned j = 0; j < 16; ++j) { const unsigned c = xb_ld(&bar[XB_XCNT(j)]); sum += c; cnt += (c > 0u) ? 1u : 0u; mine = (j == x) ? c : mine; }
        if (sum == G) break;
        __builtin_amdgcn_s_sleep(1);
        if ((++sp & 255u) == 0u) { if (xb_ld(&bar[XB_TMO])) break; if (sp > XB_SPIN_CAP) { atomicAdd(&bar[XB_TMO], 1u); break; } }
    }
    nloc = mine > 0u ? mine : 1u; nx = cnt > 0u ? cnt : 1u;
}

__device__ __forceinline__ void xcd_barrier(const XcdBarrier& b) {
    asm volatile("s_waitcnt vmcnt(0)" ::: "memory");
    __syncthreads();
    if (threadIdx.x == 0) {
        unsigned* bar = b.bar;
        __builtin_amdgcn_s_waitcnt(0);
        unsigned nloc = b.st[0], nx = b.st[1];
        if (nloc == 0u) { xcd_barrier_complete(bar, b.x, nloc, nx); b.st[0] = nloc; b.st[1] = nx; }
        const unsigned old = xb_add(&bar[XB_XSUB(b.x)], 1u);
        const unsigned gen = old / nloc;
        if (old + 1u == (gen + 1u) * nloc) {
            __builtin_amdgcn_fence(__ATOMIC_RELEASE, "agent");
            asm volatile("s_waitcnt vmcnt(0)" ::: "memory");
            const unsigned og = xb_add(&bar[XB_TOP], 1u);
            const unsigned tg = og / nx;
            if (og + 1u == (tg + 1u) * nx) xb_add(&bar[XB_TOPGEN], 1u);
            else XB_SPIN(xb_ld(&bar[XB_TOPGEN]) == tg, bar);
            __builtin_amdgcn_fence(__ATOMIC_ACQUIRE, "agent");
            xb_add(&bar[XB_XGEN(b.x)], 1u);
            asm volatile("s_waitcnt vmcnt(0)" ::: "memory");
        } else {
            XB_SPIN(xb_ld(&bar[XB_XGEN(b.x)]) == gen, bar);
            __builtin_amdgcn_fence(__ATOMIC_ACQUIRE, "agent");
            asm volatile("s_waitcnt vmcnt(0)" ::: "memory");
        }
    }
    __syncthreads();
}

namespace att {
using bf16 = __hip_bfloat16;
constexpr int   D = 128, NW = 8, QBLK = 32, KVBLK = 64;
constexpr float SCALE = 0.088388347648318440f;
constexpr float THR = 8.f;
constexpr int SDEPTH = 2;
constexpr int LDQ = 2048, LDK = 2048, LDO = 2048;
constexpr size_t SHM_V = KVBLK * D * 2, SHM_K = KVBLK * D * 2;
#define MASKALL(P0, P1) do { _Pragma("unroll") for (int r_ = 0; r_ < 16; ++r_) { P0[r_] = -INFINITY; P1[r_] = -INFINITY; } } while (0)
using bf16x8 = __attribute__((ext_vector_type(8))) short;
using s16x4  = __attribute__((ext_vector_type(4))) short;
using f32x16 = __attribute__((ext_vector_type(16))) float;
using f32x8  = __attribute__((ext_vector_type(8))) float;
using u32x4  = __attribute__((ext_vector_type(4))) unsigned;
#define KSWZ(row, colB) ((row) * 256 + ((colB) ^ (((row) & 7) << 4)))
#define SBAR() __builtin_amdgcn_sched_barrier(0)
__device__ __forceinline__ int crow(int r, int hi) { return (r & 3) + 8 * (r >> 2) + 4 * hi; }
__device__ __forceinline__ unsigned cvtpk(float lo, float hi) {
  unsigned r; asm volatile("v_cvt_pk_bf16_f32 %0, %1, %2" : "=v"(r) : "v"(lo), "v"(hi)); return r;
}
template <typename TIn> struct Stage;
template <> struct Stage<bf16>  { using T = bf16x8;
  __device__ static __forceinline__ T ld8(const bf16* p) { return *reinterpret_cast<const bf16x8*>(p); }
  __device__ static __forceinline__ bf16x8 tobf(T x) { return x; } };
template <> struct Stage<float> { using T = f32x8;
  __device__ static __forceinline__ T ld8(const float* p) { return *reinterpret_cast<const f32x8*>(p); }
  __device__ static __forceinline__ bf16x8 tobf(T x) {
    u32x4 w = {cvtpk(x[0], x[1]), cvtpk(x[2], x[3]), cvtpk(x[4], x[5]), cvtpk(x[6], x[7])}; return *reinterpret_cast<bf16x8*>(&w); } };

__device__ __forceinline__ void partialSM(f32x16& p0, f32x16& p1, float& m_reg, float& mn, float& alpha) {
  constexpr float C = SCALE * 1.4426950408889634f;
  float pmax = p0[0]; for (int r = 1; r < 16; ++r) pmax = fmaxf(pmax, p0[r]); for (int r = 0; r < 16; ++r) pmax = fmaxf(pmax, p1[r]);
  { auto rr = __builtin_amdgcn_permlane32_swap(__float_as_uint(pmax), __float_as_uint(pmax), false, false);
    pmax = fmaxf(__uint_as_float(rr[0]), __uint_as_float(rr[1])); }
  if (__builtin_expect(__all(pmax - m_reg <= THR / SCALE), 1)) { mn = m_reg; alpha = 1.f; }
  else { mn = fmaxf(m_reg, pmax); alpha = __builtin_amdgcn_exp2f((m_reg - mn) * C); m_reg = mn; }
  float mnC = -mn * C;
  for (int r = 0; r < 16; ++r) p0[r] = fmaf(p0[r], C, mnC); for (int r = 0; r < 16; ++r) p1[r] = fmaf(p1[r], C, mnC);
  for (int r = 0; r < 16; ++r) p0[r] = __builtin_amdgcn_exp2f(p0[r]);
}
__device__ __forceinline__ void finishSM(f32x16& p0, f32x16& p1, float alpha, float& l_reg, bf16x8& pa0, bf16x8& pa1, bf16x8& pa2, bf16x8& pa3) {
  for (int r = 0; r < 16; ++r) p1[r] = __builtin_amdgcn_exp2f(p1[r]);
  float ps = 0; for (int r = 0; r < 16; ++r) ps += p0[r]; for (int r = 0; r < 16; ++r) ps += p1[r];
  { auto rr = __builtin_amdgcn_permlane32_swap(__float_as_uint(ps), __float_as_uint(ps), false, false);
    ps = __uint_as_float(rr[0]) + __uint_as_float(rr[1]); }
  l_reg = l_reg * alpha + ps;
#define PK4(P, BASE, OUT) do { unsigned a0 = cvtpk(P[BASE + 0], P[BASE + 1]), a1 = cvtpk(P[BASE + 2], P[BASE + 3]);   \
    unsigned b0 = cvtpk(P[BASE + 4], P[BASE + 5]), b1 = cvtpk(P[BASE + 6], P[BASE + 7]);                              \
    auto r0 = __builtin_amdgcn_permlane32_swap(a0, b0, false, false); auto r1 = __builtin_amdgcn_permlane32_swap(a1, b1, false, false); \
    u32x4 w = {r0[0], r1[0], r0[1], r1[1]}; OUT = *reinterpret_cast<bf16x8*>(&w); } while (0)
  PK4(p0, 0, pa0); PK4(p0, 8, pa1); PK4(p1, 0, pa2); PK4(p1, 8, pa3);
#undef PK4
}
__device__ __forceinline__ void qkt(f32x16& p0, f32x16& p1, const bf16* Ks, const bf16x8* qr, int r32, int hi) {
  p0 = f32x16{}; p1 = f32x16{};
  for (int d0 = 0; d0 < 8; ++d0) { int cb = (d0 * 16 + hi * 8) * 2;
    bf16x8 b0 = *reinterpret_cast<const bf16x8*>((const char*)Ks + KSWZ(r32, cb));
    bf16x8 b1 = *reinterpret_cast<const bf16x8*>((const char*)Ks + KSWZ(32 + r32, cb));
    p0 = __builtin_amdgcn_mfma_f32_32x32x16_bf16(b0, qr[d0], p0, 0, 0, 0);
    p1 = __builtin_amdgcn_mfma_f32_32x32x16_bf16(b1, qr[d0], p1, 0, 0, 0); }
}
__device__ __forceinline__ int v_st(int k, int c) { const int kk = (k & ~0xC) | ((k & 4) << 1) | ((k & 8) >> 1); return ((kk >> 3) * 4 + (c >> 5)) * 512 + ((kk & 7) * 32 + (c & 31)) * 2; }
__device__ __forceinline__ int v_rd_base(int lane) { return ((lane & 3) << 3) | (((lane >> 2) & 3) << 6) | (((lane >> 4) & 1) << 5) | (((lane >> 5) & 1) << 8); }
constexpr int v_rd_off(int d0, int ks, int half) { return d0 * 512 + ks * 4096 + half * 2048; }
template <int OFF> __device__ __forceinline__ s16x4 tr_read(int vb) {
  s16x4 r; asm volatile("ds_read_b64_tr_b16 %0, %1 offset:%2" : "=&v"(r) : "v"(vb), "i"(OFF) : "memory"); return r;
}
template <int D0> __device__ __forceinline__ void pv_one(f32x16& od, int vb, bf16x8 pa0, bf16x8 pa1, bf16x8 pa2, bf16x8 pa3) {
  const s16x4 l0 = tr_read<v_rd_off(D0, 0, 0)>(vb), h0 = tr_read<v_rd_off(D0, 0, 1)>(vb), l1 = tr_read<v_rd_off(D0, 1, 0)>(vb), h1 = tr_read<v_rd_off(D0, 1, 1)>(vb);
  const s16x4 l2 = tr_read<v_rd_off(D0, 2, 0)>(vb), h2 = tr_read<v_rd_off(D0, 2, 1)>(vb), l3 = tr_read<v_rd_off(D0, 3, 0)>(vb), h3 = tr_read<v_rd_off(D0, 3, 1)>(vb);
  asm volatile("s_waitcnt lgkmcnt(0)" ::: "memory"); SBAR();
#define PK(L, H) (bf16x8){L[0], L[1], L[2], L[3], H[0], H[1], H[2], H[3]}
  od = __builtin_amdgcn_mfma_f32_32x32x16_bf16(pa0, PK(l0, h0), od, 0, 0, 0);
  od = __builtin_amdgcn_mfma_f32_32x32x16_bf16(pa1, PK(l1, h1), od, 0, 0, 0);
  od = __builtin_amdgcn_mfma_f32_32x32x16_bf16(pa2, PK(l2, h2), od, 0, 0, 0);
  od = __builtin_amdgcn_mfma_f32_32x32x16_bf16(pa3, PK(l3, h3), od, 0, 0, 0);
#undef PK
}
__device__ __forceinline__ void pv_d0(f32x16* o, int vb, bf16x8 pa0, bf16x8 pa1, bf16x8 pa2, bf16x8 pa3) {
  pv_one<0>(o[0], vb, pa0, pa1, pa2, pa3); pv_one<1>(o[1], vb, pa0, pa1, pa2, pa3); pv_one<2>(o[2], vb, pa0, pa1, pa2, pa3); pv_one<3>(o[3], vb, pa0, pa1, pa2, pa3);
}

template <typename TQ>
__device__ __forceinline__ void attn_dense_body(const TQ* __restrict__ Qb, const bf16* __restrict__ Kh, const bf16* __restrict__ Vh,
                                                float* __restrict__ Ob, const int NT, const int wlast, char* lds) {
  using St = Stage<bf16>; using SQ = Stage<TQ>;
  int tid_ = threadIdx.x; asm volatile("" : "+v"(tid_));
  const int tid = tid_, wid = tid >> 6, lane = tid & 63, r32 = lane & 31, hi = lane >> 5;
  bf16* V_lds = (bf16*)lds; bf16* K_lds = (bf16*)(lds + 2 * SHM_V);
  float* ws = (float*)(lds + 2 * SHM_V + 2 * SHM_K) + wid * 64; float* li_l = ws; float* al_l = ws + 32;
  float m_reg = -1e30f, l_reg = 0; f32x16 o[4] = {}; bf16x8 qr[8];
  const TQ* Qw = Qb + (long)(wid * QBLK + r32) * LDQ + hi * 8;
#pragma unroll
  for (int d0 = 0; d0 < 8; ++d0) qr[d0] = SQ::tobf(SQ::ld8(Qw + d0 * 16));
  const int sr = tid >> 4, sc = (tid & 15) * 8, vst0 = v_st(sr, sc), vst1 = v_st(32 + sr, sc);
  const int vb0 = (int)(uintptr_t)V_lds + v_rd_base(lane);
  struct { typename St::T vs0, vs1, ks0, ks1; } sr_[SDEPTH];
#define SLOAD(i, k0) do { sr_[i].vs0 = St::ld8(&Vh[(long)((k0) + sr) * LDK + sc]); sr_[i].vs1 = St::ld8(&Vh[(long)((k0) + 32 + sr) * LDK + sc]); \
    sr_[i].ks0 = St::ld8(&Kh[(long)((k0) + sr) * LDK + sc]); sr_[i].ks1 = St::ld8(&Kh[(long)((k0) + 32 + sr) * LDK + sc]); } while (0)
#define SWRITE(b, i) do { *(bf16x8*)((char*)V_lds + (b) * SHM_V + vst0) = St::tobf(sr_[i].vs0);          \
    *(bf16x8*)((char*)V_lds + (b) * SHM_V + vst1) = St::tobf(sr_[i].vs1); int kc = sc * 2;               \
    *(bf16x8*)((char*)K_lds + (b) * SHM_K + KSWZ(sr, kc)) = St::tobf(sr_[i].ks0);                       \
    *(bf16x8*)((char*)K_lds + (b) * SHM_K + KSWZ(32 + sr, kc)) = St::tobf(sr_[i].ks1); } while (0)
#define SWAIT() do { if constexpr (SDEPTH == 2) asm volatile("s_waitcnt vmcnt(4)" ::: "memory"); else asm volatile("s_waitcnt vmcnt(0)" ::: "memory"); } while (0)
#define RESC(a) do { if (__any((a) < 1.f)) { if (hi == 0) al_l[r32] = (a); asm volatile("s_waitcnt lgkmcnt(0)" ::: "memory"); \
    for (int d = 0; d < 4; ++d) for (int r = 0; r < 16; ++r) o[d][r] *= al_l[crow(r, hi)]; } } while (0)
  f32x16 pA0, pA1, pB0, pB1; float mnA, mnB, alA, alB; bf16x8 pa0, pa1, pa2, pa3;
  constexpr int SE = 0, SO = SDEPTH - 1;
  SLOAD(SE, 0); asm volatile("s_waitcnt vmcnt(0)" ::: "memory"); SWRITE(0, SE); __syncthreads();
  qkt(pA0, pA1, K_lds, qr, r32, hi); partialSM(pA0, pA1, m_reg, mnA, alA);
  SLOAD(SO, KVBLK); if constexpr (SDEPTH == 2) { if (2 < NT) SLOAD(SE, 2 * KVBLK); }
  SWAIT(); SWRITE(1, SO); __syncthreads();
  for (int j = 1; j + 1 < NT; j += 2) {
    SBAR(); qkt(pB0, pB1, (bf16*)((char*)K_lds + SHM_K), qr, r32, hi); if (j > wlast) MASKALL(pB0, pB1);
    finishSM(pA0, pA1, alA, l_reg, pa0, pa1, pa2, pa3); SBAR();
    SLOAD(SO, (j + SDEPTH) * KVBLK); SBAR();
    pv_d0(o, vb0, pa0, pa1, pa2, pa3); partialSM(pB0, pB1, m_reg, mnB, alB);
    __syncthreads(); SWAIT(); SWRITE(0, SE);
    RESC(alB); __syncthreads();
    SBAR(); qkt(pA0, pA1, K_lds, qr, r32, hi); if (j + 1 > wlast) MASKALL(pA0, pA1);
    finishSM(pB0, pB1, alB, l_reg, pa0, pa1, pa2, pa3); SBAR();
    if (SDEPTH == 1 || j + 3 < NT) SLOAD(SE, (j + 1 + SDEPTH) * KVBLK); SBAR();
    pv_d0(o, vb0 + (int)SHM_V, pa0, pa1, pa2, pa3); partialSM(pA0, pA1, m_reg, mnA, alA);
    __syncthreads(); SWAIT(); SWRITE(1, SO);
    RESC(alA); __syncthreads();
  }
  SBAR(); qkt(pB0, pB1, (bf16*)((char*)K_lds + SHM_K), qr, r32, hi); if (NT - 1 > wlast) MASKALL(pB0, pB1);
  finishSM(pA0, pA1, alA, l_reg, pa0, pa1, pa2, pa3); SBAR();
  pv_d0(o, vb0, pa0, pa1, pa2, pa3); partialSM(pB0, pB1, m_reg, mnB, alB);
  __syncthreads(); RESC(alB);
  finishSM(pB0, pB1, alB, l_reg, pa0, pa1, pa2, pa3); SBAR();
  pv_d0(o, vb0 + (int)SHM_V, pa0, pa1, pa2, pa3);
  if (hi == 0) li_l[r32] = l_reg; asm volatile("s_waitcnt lgkmcnt(0)" ::: "memory");
  float rli[16];
#pragma unroll
  for (int r = 0; r < 16; ++r) rli[r] = __builtin_amdgcn_rcpf(li_l[crow(r, hi)]);
  float* Ow = Ob + (long)(wid * QBLK) * LDO;
#pragma unroll
  for (int r = 0; r < 16; ++r) { int orow = crow(r, hi);
    for (int d0 = 0; d0 < 4; ++d0) Ow[(long)orow * LDO + d0 * 32 + r32] = o[d0][r] * rli[r]; }
#undef SLOAD
#undef SWRITE
#undef SWAIT
#undef RESC
}

constexpr size_t SBUF = 65536;
__device__ __forceinline__ void attn_sample_unit(const bf16* __restrict__ QN, const bf16* __restrict__ KN, const bf16* __restrict__ VBn,
                                                 const float* __restrict__ ck, const float* __restrict__ cv, float* __restrict__ OA0, float* __restrict__ OA1,
                                                 const int b, const int h, char* lds) {
  int tid_ = threadIdx.x; asm volatile("" : "+v"(tid_));
  const int tid = tid_, wid = tid >> 6, lane = tid & 63, r32 = lane & 31, hi = lane >> 5;
  const int c = wid & 1, e = (wid >> 1) & 1, th = wid >> 2;
  float* wsf = (float*)(lds + 2 * SBUF) + wid * 64; float* li_l = wsf; float* al_l = wsf + 32;
  float m_reg = -1e30f, l_reg = 0; f32x16 o[4] = {};
  const long qrow = (long)MP + 64 * b + 32 * th + r32;
  const bf16* Qw = QN + qrow * 2048 + h * 256 + c * 128 + hi * 8;
  char* qlds = lds + SBUF + wid * 8192 + lane * 16;
#pragma unroll
  for (int d0 = 0; d0 < 8; ++d0) *reinterpret_cast<bf16x8*>(qlds + d0 * 1024) = *reinterpret_cast<const bf16x8*>(Qw + d0 * 16);
  const int vb0 = (int)(uintptr_t)lds + 2 * 16384 + e * 16384 + v_rd_base(lane);
  f32x8 sk[4], sv[4];
  const float* ckb = ck + ((long)b * PAST * 8 + h) * 256;
  const float* cvb = cv + ((long)b * PAST * 8 + h) * 256;
#define SS_LOAD(k0) do { _Pragma("unroll") for (int i = 0; i < 4; ++i) { const int n = tid + 512 * i; \
      sk[i] = *reinterpret_cast<const f32x8*>(ckb + (long)((k0) + ((n >> 4) & 63)) * 2048 + (n >> 10) * 128 + (n & 15) * 8); \
      sv[i] = *reinterpret_cast<const f32x8*>(cvb + (long)((k0) + (n >> 5)) * 2048 + (n & 31) * 8); } } while (0)
#define SS_WRITE(bufp) do { _Pragma("unroll") for (int i = 0; i < 4; ++i) { const int n = tid + 512 * i; \
      *(bf16x8*)((bufp) + (n >> 10) * 16384 + KSWZ((n >> 4) & 63, (n & 15) * 16)) = Stage<float>::tobf(sk[i]); \
      *(bf16x8*)((bufp) + 32768 + ((n & 31) >> 4) * 16384 + v_st(n >> 5, (n & 15) * 8)) = Stage<float>::tobf(sv[i]); } } while (0)
#define SS_RESC(a) do { if (__any((a) < 1.f)) { if (hi == 0) al_l[r32] = (a); asm volatile("s_waitcnt lgkmcnt(0)" ::: "memory"); \
    for (int d = 0; d < 4; ++d) for (int r = 0; r < 16; ++r) o[d][r] *= al_l[crow(r, hi)]; } } while (0)
#define SS_COMPUTE(bufp, vbase) do { f32x16 p0 = {}, p1 = {}; float mn, al; bf16x8 pa0, pa1, pa2, pa3; \
      { const char* Ks_ = (bufp) + c * 16384; _Pragma("unroll") for (int d0 = 0; d0 < 8; ++d0) { const int cb = (d0 * 16 + hi * 8) * 2; \
          const bf16x8 q_ = *reinterpret_cast<const bf16x8*>(qlds + d0 * 1024); \
          const bf16x8 b0 = *reinterpret_cast<const bf16x8*>(Ks_ + KSWZ(r32, cb)), b1 = *reinterpret_cast<const bf16x8*>(Ks_ + KSWZ(32 + r32, cb)); \
          p0 = __builtin_amdgcn_mfma_f32_32x32x16_bf16(b0, q_, p0, 0, 0, 0); p1 = __builtin_amdgcn_mfma_f32_32x32x16_bf16(b1, q_, p1, 0, 0, 0); } } \
      partialSM(p0, p1, m_reg, mn, al); SS_RESC(al); \
      finishSM(p0, p1, al, l_reg, pa0, pa1, pa2, pa3); SBAR(); pv_d0(o, (vbase), pa0, pa1, pa2, pa3); } while (0)
  constexpr int NTC = PAST / 64;
  SS_LOAD(0);
  for (int j = 0; j < NTC; ++j) {
    asm volatile("s_waitcnt vmcnt(0)" ::: "memory"); __syncthreads();
    SS_WRITE(lds); __syncthreads();
    if (j + 1 < NTC) SS_LOAD((j + 1) * 64);
    SS_COMPUTE(lds, vb0);
  }
  {
    bf16x8 nk[4], nv[4];
    const long nrow0 = (long)MP + 64 * b;
#pragma unroll
    for (int i = 0; i < 4; ++i) { const int n = tid + 512 * i;
      nk[i] = *reinterpret_cast<const bf16x8*>(KN + (nrow0 + ((n >> 4) & 63)) * 2048 + h * 256 + (n >> 10) * 128 + (n & 15) * 8);
      nv[i] = *reinterpret_cast<const bf16x8*>(VBn + (nrow0 + (n >> 5)) * 2048 + h * 256 + (n & 31) * 8); }
    __syncthreads();
#pragma unroll
    for (int i = 0; i < 4; ++i) { const int n = tid + 512 * i;
      *(bf16x8*)(lds + (n >> 10) * 16384 + KSWZ((n >> 4) & 63, (n & 15) * 16)) = nk[i];
      *(bf16x8*)(lds + 32768 + ((n & 31) >> 4) * 16384 + v_st(n >> 5, (n & 15) * 8)) = nv[i]; }
    __syncthreads();
    SS_COMPUTE(lds, vb0);
  }
  if (hi == 0) li_l[r32] = l_reg; asm volatile("s_waitcnt lgkmcnt(0)" ::: "memory");
  float rli[16];
#pragma unroll
  for (int r = 0; r < 16; ++r) rli[r] = __builtin_amdgcn_rcpf(li_l[crow(r, hi)]);
  float* Ow = (c ? OA1 : OA0) + ((long)MP + 64 * b + 32 * th) * 2048 + h * 256 + e * 128;
#pragma unroll
  for (int r = 0; r < 16; ++r) { const int orow = crow(r, hi);
    for (int d0 = 0; d0 < 4; ++d0) Ow[(long)orow * 2048 + d0 * 32 + r32] = o[d0][r] * rli[r]; }
  __syncthreads();
#undef SS_LOAD
#undef SS_WRITE
#undef SS_RESC
#undef SS_COMPUTE
}
}

struct Args { const float* in[25]; float* out; unsigned char* ws; int ph_lo, ph_hi; };

__device__ __forceinline__ void p0_transpose_item(const float* W, int K, int N, bf16* WT, const float* gain, int gmask, float gscale, LAS float* scr, int item, int lane) {
    const int nblk = N / 32, kb = item / nblk, nb = item % nblk, k0 = 64 * kb, n0 = 32 * nb;
#pragma unroll 8
    for (int i = 0; i < 32; ++i) { const int kk = 2 * i + (lane >> 5); const float gk = gain ? gain[(k0 + kk) & gmask] * gscale : 1.f;
        scr[kk * 33 + (lane & 31)] = W[(size_t)(k0 + kk) * N + n0 + (lane & 31)] * gk; }
    LDS_WAIT(); asm volatile("" ::: "memory");
    const int c = lane & 7;
#pragma unroll
    for (int j = 0; j < 4; ++j) { const int n = (lane >> 3) + 8 * j; const LAS float* s = scr + (8 * c) * 33 + n;
        v4u o; o.x = pk2(s[0 * 33], s[1 * 33]); o.y = pk2(s[2 * 33], s[3 * 33]); o.z = pk2(s[4 * 33], s[5 * 33]); o.w = pk2(s[6 * 33], s[7 * 33]);
        *(GAS v4u*)(WT + (size_t)(n0 + n) * K + k0 + 8 * c) = o; }
    LDS_WAIT(); asm volatile("" ::: "memory");
}
__device__ __forceinline__ void p0_prologue(const Args& a, LAS unsigned char* lds, int vcu, int G, int wave, int lane) {
    LAS float* scr = (LAS float*)(lds + RING_OFF + wave * 16384);
    const int gw = vcu * NWAVES + wave, NGW = G * NWAVES;
    unsigned char* ws = a.ws;
    constexpr int I_HIN = (DM / 64) * (NHG / 32), I_SQ = (DM / 64) * (DM / 32), I_UP = (DM / 64) * (NUP / 32), I_DN = (DFF / 64) * (DM / 32), I_DIN = (DM / 64) * (NDI / 32);
    constexpr int NITEMS = I_HIN + 2 * I_SQ + 2 * I_UP + 2 * I_DN + I_DIN;
    for (int it = gw; it < NITEMS; it += NGW) {
        int r = it;
        if (r < I_HIN) { p0_transpose_item(a.in[9], DM, NHG, (bf16*)(ws + WS_W_HIN), a.in[6], DM - 1, 1.f, scr, r, lane); continue; } r -= I_HIN;
        if (r < I_UP) { p0_transpose_item(a.in[21], DM, NUP, (bf16*)(ws + WS_W_UP0), a.in[7], DM - 1, 1.f, scr, r, lane); continue; } r -= I_UP;
        if (r < I_SQ) { p0_transpose_item(a.in[10], DM, DM, (bf16*)(ws + WS_W_HOUT), a.in[11], 127, 1.f, scr, r, lane); continue; } r -= I_SQ;
        if (r < I_DN) { p0_transpose_item(a.in[24], DFF, DM, (bf16*)(ws + WS_W_DN0), nullptr, 0, 1.f, scr, r, lane); continue; } r -= I_DN;
        if (r < I_DIN) { p0_transpose_item(a.in[12], DM, NDI, (bf16*)(ws + WS_W_DIN), a.in[6] + DM, DM - 1, 1.f, scr, r, lane); continue; } r -= I_DIN;
        if (r < I_SQ) { p0_transpose_item(a.in[13], DM, DM, (bf16*)(ws + WS_W_DOUT), a.in[20], 255, 1.f - LAM_INIT, scr, r, lane); continue; } r -= I_SQ;
        if (r < I_UP) { p0_transpose_item(a.in[21] + (size_t)DM * NUP, DM, NUP, (bf16*)(ws + WS_W_UP1), a.in[7] + DM, DM - 1, 1.f, scr, r, lane); continue; } r -= I_UP;
        p0_transpose_item(a.in[24] + (size_t)DFF * DM, DFF, DM, (bf16*)(ws + WS_W_DN1), nullptr, 0, 1.f, scr, r, lane);
    }
    float* sm = (float*)(ws + WS_SMALL); bf16* XB = (bf16*)(ws + WS_XB);
    for (int m = gw; m < MR; m += NGW) {
        const float* xrow = (m < MP) ? a.in[0] + (size_t)m * DM : a.in[1] + (size_t)(m - MP) * DM;
        const GAS f32x4* xr = (const GAS f32x4*)xrow + lane;
        f32x4 v[8]; float s = 0.f;
#pragma unroll
        for (int j = 0; j < 8; ++j) { v[j] = xr[64 * j]; s += (v[j].x * v[j].x + v[j].y * v[j].y) + (v[j].z * v[j].z + v[j].w * v[j].w); }
        s = wave_sum(s);
        GAS v2u* o8 = (GAS v2u*)(XB + (size_t)m * DM) + lane;
#pragma unroll
        for (int j = 0; j < 8; ++j) { v2u w; w.x = pk2(v[j].x, v[j].y); w.y = pk2(v[j].z, v[j].w); o8[64 * j] = w; }
        if (lane == 0) sm[SM_RINV0 + m] = 1.f / sqrtf(s * (1.f / DM) + EPS);
    }
    for (int i = gw * 64 + lane; i < DM; i += NGW * 64) {
        const float z0 = a.in[8][i], z1 = a.in[8][DM + i], z2 = a.in[8][2 * DM + i], mx = fmaxf(z0, fmaxf(z1, z2));
        const float e0 = expf(z0 - mx), e1 = expf(z1 - mx), e2 = expf(z2 - mx);
        sm[SM_LB + i] = e0 / (e0 + e1 + e2);
    }
    if (gw == 0) {
        const float s1 = wave_sum(a.in[16][lane] * a.in[17][lane] + a.in[16][lane + 64] * a.in[17][lane + 64]);
        const float s2 = wave_sum(a.in[18][lane] * a.in[19][lane] + a.in[18][lane + 64] * a.in[19][lane + 64]);
        if (lane == 0) sm[SM_LAM] = expf(s1) - expf(s2) + LAM_INIT;
    }
}

__device__ __forceinline__ unsigned img_off(unsigned row, unsigned ch) { return 256u * row + 16u * (ch ^ (((row & 3u) << 2) | ((row >> 2) & 3u))); }
__device__ __forceinline__ bf16x8 img_rowread(const LAS unsigned char* img, int rowbase, int ks, int lane) {
    return *(const LAS bf16x8*)(img + img_off(rowbase + (lane & 31), 2 * ks + (lane >> 5)));
}
__device__ __forceinline__ s16x4 vtr(const LAS unsigned char* p) { typedef short v4i16_t __attribute__((ext_vector_type(4)));
    return __builtin_bit_cast(s16x4, __builtin_amdgcn_ds_read_tr16_b64_v4i16((LAS v4i16_t*)p)); }
__device__ __forceinline__ bf16x8 img_trread_nat(const LAS unsigned char* img, int R0, int c, int lane) {
    const unsigned h = lane >> 5, blk = (lane >> 4) & 1, q = (lane & 15) >> 2, p = lane & 3;
    const s16x4 lo = vtr(img + img_off(R0 + 8 * h + q, 4 * c + 2 * blk + (p >> 1)) + 8 * (p & 1));
    const s16x4 hi = vtr(img + img_off(R0 + 8 * h + 4 + q, 4 * c + 2 * blk + (p >> 1)) + 8 * (p & 1));
    return (bf16x8){lo[0], lo[1], lo[2], lo[3], hi[0], hi[1], hi[2], hi[3]};
}
__device__ __forceinline__ bf16x8 img_trread_acc(const LAS unsigned char* img, int R0, int c, int lane) {
    const unsigned h = lane >> 5, blk = (lane >> 4) & 1, q = (lane & 15) >> 2, p = lane & 3;
    const s16x4 lo = vtr(img + img_off(R0 + 4 * h + q, 4 * c + 2 * blk + (p >> 1)) + 8 * (p & 1));
    const s16x4 hi = vtr(img + img_off(R0 + 8 + 4 * h + q, 4 * c + 2 * blk + (p >> 1)) + 8 * (p & 1));
    return (bf16x8){lo[0], lo[1], lo[2], lo[3], hi[0], hi[1], hi[2], hi[3]};
}
__device__ __forceinline__ int crow_(int r, int hi) { return (r & 3) + 8 * (r >> 2) + 4 * hi; }
#define MFMA32(a, b, c) __builtin_amdgcn_mfma_f32_32x32x16_bf16((a), (b), (c), 0, 0, 0)

constexpr int SC_QT = 0, SC_KT = 16384, SC_QH = 32768, SC_VI = 49152, SC_SI = 65536, SC_PART = 98304, SC_RED = 102400;

__device__ __forceinline__ void scan_local_phase(const Args& a, LAS unsigned char* lds, int vcu, int G, int tid, int wave, int lane) {
    unsigned char* ws = a.ws;
    const bf16* KH = (const bf16*)(ws + WS_KH); const bf16* VH = (const bf16*)(ws + WS_VH); const float* GG = (const float*)(ws + WS_G);
    float* LST = (float*)(ws + WS_LST); float* DC = (float*)(ws + WS_DC);
    LAS float* part = (LAS float*)(lds + SC_PART);
    for (int u = vcu; u < NCH * 16; u += G) {
        const int c = u >> 4, hh = u & 15; const size_t rb = (size_t)c * 64;
        f32x2 g[8]; unsigned kv[8]; v4u vch[2];
#pragma unroll
        for (int i = 0; i < 8; ++i) { const size_t off = (rb + wave * 8 + i) * DM + hh * 128 + 2 * lane; g[i] = *(const f32x2*)(GG + off); kv[i] = *(const unsigned*)(KH + off); }
#pragma unroll
        for (int j = 0; j < 2; ++j) { const int n = tid + 512 * j; vch[j] = *(const v4u*)(VH + (rb + (n >> 4)) * DM + hh * 128 + (n & 15) * 8); }
#pragma unroll
        for (int i = 1; i < 8; ++i) g[i] += g[i - 1];
        *(LAS f32x2*)(part + wave * 128 + 2 * lane) = g[7];
        __syncthreads();
        f32x2 offv = {0.f, 0.f}, blast = {0.f, 0.f};
#pragma unroll
        for (int s = 0; s < 8; ++s) { const f32x2 p = *(const LAS f32x2*)(part + s * 128 + 2 * lane); if (s < wave) offv += p; blast += p; }
#pragma unroll
        for (int i = 0; i < 8; ++i) { const f32x2 b = offv + g[i];
            const float k0 = bflo(kv[i]) * __expf(blast.x - b.x), k1 = bfhi(kv[i]) * __expf(blast.y - b.y);
            *(LAS unsigned*)(lds + SC_KT + img_off(wave * 8 + i, lane >> 2) + (lane & 3) * 4) = cvtpk(k0, k1); }
#pragma unroll
        for (int j = 0; j < 2; ++j) { const int n = tid + 512 * j; *(LAS v4u*)(lds + SC_VI + img_off(n >> 4, n & 15)) = vch[j]; }
        if (wave == 0) *(f32x2*)(DC + (size_t)u * 128 + 2 * lane) = (f32x2){__expf(blast.x), __expf(blast.y)};
        __syncthreads();
        const int db = wave & 3, eb0 = 2 * (wave >> 2);
        f32x16 acc0 = {}, acc1 = {};
#pragma unroll
        for (int ks = 0; ks < 4; ++ks) {
            const bf16x8 A = img_trread_nat(lds + SC_KT, 16 * ks, db, lane);
            const bf16x8 B0 = img_trread_nat(lds + SC_VI, 16 * ks, eb0, lane), B1 = img_trread_nat(lds + SC_VI, 16 * ks, eb0 + 1, lane);
            acc0 = MFMA32(A, B0, acc0); acc1 = MFMA32(A, B1, acc1);
        }
        float* Lu = LST + (size_t)u * 16384;
#pragma unroll
        for (int r = 0; r < 16; ++r) { const int d = 32 * db + crow_(r, lane >> 5);
            Lu[d * 128 + 32 * eb0 + (lane & 31)] = acc0[r]; Lu[d * 128 + 32 * (eb0 + 1) + (lane & 31)] = acc1[r]; }
    }
    __syncthreads();
}

__device__ __forceinline__ void scan_carry_phase(const Args& a, int vcu, int G, int tid) {
    unsigned char* ws = a.ws;
    const float* LST = (const float*)(ws + WS_LST); const float* DC = (const float*)(ws + WS_DC); bf16* SIN = (bf16*)(ws + WS_SIN);
    for (int p = vcu * 512 + tid; p < 131072; p += G * 512) {
        const int idx = 2 * p, hd = idx >> 7;
        const int hh = hd >> 7, d = hd & 127;
        f32x2 S = {0.f, 0.f};
#pragma unroll 8
        for (int c = 0; c < NCHP; ++c) {
            const size_t u = (size_t)c * 16 + hh;
            const f32x2 L = *(const f32x2*)(LST + u * 16384 + (size_t)d * 128 + (idx & 127)); const float dc = DC[u * 128 + d];
            *(unsigned*)(SIN + u * 16384 + (size_t)d * 128 + (idx & 127)) = cvtpk(S.x, S.y);
            S = S * dc + L;
        }
        *(f32x2*)(a.out + O_HP + idx) = S;
#pragma unroll 4
        for (int b = 0; b < 16; ++b) {
            const size_t u = (size_t)(NCHP + b) * 16 + hh;
            const f32x2 S0 = *(const f32x2*)(a.in[2] + (size_t)b * 262144 + idx);
            const f32x2 L = *(const f32x2*)(LST + u * 16384 + (size_t)d * 128 + (idx & 127)); const float dc = DC[u * 128 + d];
            *(unsigned*)(SIN + u * 16384 + (size_t)d * 128 + (idx & 127)) = cvtpk(S0.x, S0.y);
            *(f32x2*)(a.out + O_HS + (size_t)b * 262144 + idx) = S0 * dc + L;
        }
    }
}

__device__ __forceinline__ void scan_out_phase(const Args& a, LAS unsigned char* lds, int vcu, int G, int tid, int wave, int lane) {
    unsigned char* ws = a.ws;
    const bf16* QH = (const bf16*)(ws + WS_QH); const bf16* KH = (const bf16*)(ws + WS_KH); const bf16* VH = (const bf16*)(ws + WS_VH); const bf16* SG = (const bf16*)(ws + WS_SG);
    const float* GG = (const float*)(ws + WS_G); const bf16* SIN = (const bf16*)(ws + WS_SIN); bf16* HA = (bf16*)(ws + WS_HA);
    LAS float* part = (LAS float*)(lds + SC_PART); LAS float* red = (LAS float*)(lds + SC_RED);
    const int hi = lane >> 5, r32 = lane & 31;
    for (int u = vcu; u < NCH * 16; u += G) {
        const int c = u >> 4, hh = u & 15; const size_t rb = (size_t)c * 64;
        f32x2 g[8]; unsigned qv[8], kv[8]; v4u vch[2], sch[4];
#pragma unroll
        for (int i = 0; i < 8; ++i) { const size_t off = (rb + wave * 8 + i) * DM + hh * 128 + 2 * lane; g[i] = *(const f32x2*)(GG + off); qv[i] = *(const unsigned*)(QH + off); kv[i] = *(const unsigned*)(KH + off); }
#pragma unroll
        for (int j = 0; j < 2; ++j) { const int n = tid + 512 * j; vch[j] = *(const v4u*)(VH + (rb + (n >> 4)) * DM + hh * 128 + (n & 15) * 8); }
#pragma unroll
        for (int j = 0; j < 4; ++j) { const int n = tid + 512 * j; sch[j] = *(const v4u*)(SIN + (size_t)u * 16384 + (size_t)(n >> 4) * 128 + (n & 15) * 8); }
#pragma unroll
        for (int i = 1; i < 8; ++i) g[i] += g[i - 1];
        *(LAS f32x2*)(part + wave * 128 + 2 * lane) = g[7];
        __syncthreads();
        f32x2 offv = {0.f, 0.f}, bmid = {0.f, 0.f};
#pragma unroll
        for (int s = 0; s < 8; ++s) { const f32x2 p = *(const LAS f32x2*)(part + s * 128 + 2 * lane); if (s < wave) offv += p; if (s < 4) bmid += p; }
#pragma unroll
        for (int i = 0; i < 8; ++i) { const f32x2 b = offv + g[i];
            const float q0 = bflo(qv[i]), q1 = bfhi(qv[i]), k0 = bflo(kv[i]), k1 = bfhi(kv[i]);
            const unsigned o = img_off(wave * 8 + i, lane >> 2) + (lane & 3) * 4;
            *(LAS unsigned*)(lds + SC_QH + o) = cvtpk(q0 * __expf(b.x), q1 * __expf(b.y));
            *(LAS unsigned*)(lds + SC_QT + o) = cvtpk(q0 * __expf(fminf(b.x - bmid.x, 80.f)), q1 * __expf(fminf(b.y - bmid.y, 80.f)));
            *(LAS unsigned*)(lds + SC_KT + o) = cvtpk(k0 * __expf(fminf(bmid.x - b.x, 80.f)), k1 * __expf(fminf(bmid.y - b.y, 80.f))); }
#pragma unroll
        for (int j = 0; j < 2; ++j) { const int n = tid + 512 * j; *(LAS v4u*)(lds + SC_VI + img_off(n >> 4, n & 15)) = vch[j]; }
#pragma unroll
        for (int j = 0; j < 4; ++j) { const int n = tid + 512 * j; *(LAS v4u*)(lds + SC_SI + img_off(n >> 4, n & 15)) = sch[j]; }
        __syncthreads();
        const int eb = wave & 3, tb = wave >> 2;
        f32x16 o = {};
        {
            f32x16 X = {};
#pragma unroll
            for (int ks = 0; ks < 8; ++ks) X = MFMA32(img_rowread(lds + SC_KT, 0, ks, lane), img_rowread(lds + SC_QT, 32 * tb, ks, lane), X);
            if (tb == 0) {
#pragma unroll
                for (int r = 0; r < 16; ++r) if (crow_(r, hi) > r32) X[r] = 0.f;
            }
#pragma unroll
            for (int s2 = 0; s2 < 2; ++s2) {
                v4u w; w.x = cvtpk(X[8 * s2 + 0], X[8 * s2 + 1]); w.y = cvtpk(X[8 * s2 + 2], X[8 * s2 + 3]); w.z = cvtpk(X[8 * s2 + 4], X[8 * s2 + 5]); w.w = cvtpk(X[8 * s2 + 6], X[8 * s2 + 7]);
                o = MFMA32(img_trread_acc(lds + SC_VI, 16 * s2, eb, lane), __builtin_bit_cast(bf16x8, w), o);
            }
        }
        if (tb == 1) {
            f32x16 X = {};
#pragma unroll
            for (int ks = 0; ks < 8; ++ks) X = MFMA32(img_rowread(lds + SC_KT, 32, ks, lane), img_rowread(lds + SC_QT, 32, ks, lane), X);
#pragma unroll
            for (int r = 0; r < 16; ++r) if (crow_(r, hi) > r32) X[r] = 0.f;
#pragma unroll
            for (int s2 = 0; s2 < 2; ++s2) {
                v4u w; w.x = cvtpk(X[8 * s2 + 0], X[8 * s2 + 1]); w.y = cvtpk(X[8 * s2 + 2], X[8 * s2 + 3]); w.z = cvtpk(X[8 * s2 + 4], X[8 * s2 + 5]); w.w = cvtpk(X[8 * s2 + 6], X[8 * s2 + 7]);
                o = MFMA32(img_trread_acc(lds + SC_VI, 32 + 16 * s2, eb, lane), __builtin_bit_cast(bf16x8, w), o);
            }
        }
#pragma unroll
        for (int ks = 0; ks < 8; ++ks) o = MFMA32(img_trread_nat(lds + SC_SI, 16 * ks, eb, lane), img_rowread(lds + SC_QH, 32 * tb, ks, lane), o);
        float ss = 0.f;
#pragma unroll
        for (int r = 0; r < 16; ++r) ss += o[r] * o[r];
        ss += __shfl_xor(ss, 32);
        if (lane < 32) red[(tb * 4 + eb) * 32 + lane] = ss;
        __syncthreads();
        const float tot = (red[(tb * 4 + 0) * 32 + r32] + red[(tb * 4 + 1) * 32 + r32]) + (red[(tb * 4 + 2) * 32 + r32] + red[(tb * 4 + 3) * 32 + r32]);
        const float rn = __builtin_amdgcn_rsqf(tot * (1.f / 128.f) + EPS);
        const size_t orow = (rb + 32 * tb + r32) * DM + hh * 128 + 32 * eb + 4 * hi;
#pragma unroll
        for (int g4 = 0; g4 < 4; ++g4) {
            const v2u sg = *(const v2u*)(SG + orow + 8 * g4);
            v2u w; w.x = cvtpk(o[4 * g4 + 0] * rn * bflo(sg.x), o[4 * g4 + 1] * rn * bfhi(sg.x)); w.y = cvtpk(o[4 * g4 + 2] * rn * bflo(sg.y), o[4 * g4 + 3] * rn * bfhi(sg.y));
            *(v2u*)(HA + orow + 8 * g4) = w;
        }
    }
    __syncthreads();
}

__device__ __forceinline__ void conv_act_phase(const Args& a, int layer, int vcu, int G, int tid) {
    unsigned char* ws = a.ws;
    const bf16* GU = (const bf16*)(ws + WS_GU); bf16* ACT = (bf16*)(ws + WS_ACT);
    const float* cw = a.in[22] + (size_t)layer * 3 * DFF; const float* cb = a.in[23] + (size_t)layer * DFF; const float* st = a.in[5] + (size_t)layer * 16 * 2 * DFF;
    constexpr int NCC = DFF / 8, NRUN = MR / 16;
    for (int it = vcu * 512 + tid; it < NCC * NRUN; it += G * 512) {
        const int cc = it % NCC, run = it / NCC, c0 = cc * 8, t0 = run * 16;
        float w0[8], w1[8], w2[8], bb[8], g1[8], g2[8];
#pragma unroll
        for (int j = 0; j < 8; ++j) { w0[j] = cw[c0 + j]; w1[j] = cw[DFF + c0 + j]; w2[j] = cw[2 * DFF + c0 + j]; bb[j] = cb[c0 + j]; }
        const bool sstart = (t0 >= MP) && ((t0 & 63) == 0);
        if (t0 == 0) {
#pragma unroll
            for (int j = 0; j < 8; ++j) { g1[j] = 0.f; g2[j] = 0.f; }
        } else if (sstart) {
            const float* sp = st + (size_t)((t0 - MP) >> 6) * 2 * DFF + c0;
#pragma unroll
            for (int j = 0; j < 8; ++j) { g2[j] = sp[j]; g1[j] = sp[DFF + j]; }
        } else {
            const v4u p2 = *(const v4u*)(GU + (size_t)(t0 - 2) * NUP + c0), p1 = *(const v4u*)(GU + (size_t)(t0 - 1) * NUP + c0);
            g2[0] = bflo(p2.x); g2[1] = bfhi(p2.x); g2[2] = bflo(p2.y); g2[3] = bfhi(p2.y); g2[4] = bflo(p2.z); g2[5] = bfhi(p2.z); g2[6] = bflo(p2.w); g2[7] = bfhi(p2.w);
            g1[0] = bflo(p1.x); g1[1] = bfhi(p1.x); g1[2] = bflo(p1.y); g1[3] = bfhi(p1.y); g1[4] = bflo(p1.z); g1[5] = bfhi(p1.z); g1[6] = bflo(p1.w); g1[7] = bfhi(p1.w);
        }
#pragma unroll 4
        for (int t = t0; t < t0 + 16; ++t) {
            const v4u pg = *(const v4u*)(GU + (size_t)t * NUP + c0), pu = *(const v4u*)(GU + (size_t)t * NUP + DFF + c0);
            float g0[8], up[8], r[8];
            g0[0] = bflo(pg.x); g0[1] = bfhi(pg.x); g0[2] = bflo(pg.y); g0[3] = bfhi(pg.y); g0[4] = bflo(pg.z); g0[5] = bfhi(pg.z); g0[6] = bflo(pg.w); g0[7] = bfhi(pg.w);
            up[0] = bflo(pu.x); up[1] = bfhi(pu.x); up[2] = bflo(pu.y); up[3] = bfhi(pu.y); up[4] = bflo(pu.z); up[5] = bfhi(pu.z); up[6] = bflo(pu.w); up[7] = bfhi(pu.w);
#pragma unroll
            for (int j = 0; j < 8; ++j) { const float cv = bb[j] + w2[j] * g0[j] + w1[j] * g1[j] + w0[j] * g2[j]; r[j] = cv * sigmoidf_(cv) * up[j]; g2[j] = g1[j]; g1[j] = g0[j]; }
            v4u w; w.x = cvtpk(r[0], r[1]); w.y = cvtpk(r[2], r[3]); w.z = cvtpk(r[4], r[5]); w.w = cvtpk(r[6], r[7]);
            *(v4u*)(ACT + (size_t)t * DFF + c0) = w;
        }
    }
}

__device__ __forceinline__ void qknorm_phase(const Args& a, int vcu, int G, int wave, int lane) {
    unsigned char* ws = a.ws;
    const bf16* QKR = (const bf16*)(ws + WS_QKR); bf16* QN = (bf16*)(ws + WS_QH); bf16* KN = (bf16*)(ws + WS_KH);
    const int gw = vcu * NWAVES + wave, NGW = G * NWAVES;
    for (int it = gw; it < 2 * MR; it += NGW) {
        const int row = it >> 1, isk = it & 1;
        const bf16* src = QKR + (size_t)row * 4096 + isk * 2048;
        const float* gn = a.in[isk ? 15 : 14];
        bf16* dst = (isk ? KN : QN) + (size_t)row * DM;
        float* fo = isk ? ((row < MP) ? a.out + O_KP + (size_t)row * DM : a.out + O_KS + (size_t)(row - MP) * DM) : nullptr;
#pragma unroll
        for (int j = 0; j < 4; ++j) {
            const int e0 = j * 512 + lane * 8;
            const v4u p = *(const v4u*)(src + e0);
            float v[8]; v[0] = bflo(p.x); v[1] = bfhi(p.x); v[2] = bflo(p.y); v[3] = bfhi(p.y); v[4] = bflo(p.z); v[5] = bfhi(p.z); v[6] = bflo(p.w); v[7] = bfhi(p.w);
            float s = 0.f;
#pragma unroll
            for (int i = 0; i < 8; ++i) s += v[i] * v[i];
            s += __shfl_xor(s, 1); s += __shfl_xor(s, 2); s += __shfl_xor(s, 4); s += __shfl_xor(s, 8);
            const float rn = __builtin_amdgcn_rsqf(s * (1.f / 128.f) + EPS);
            const f32x4 ga = *(const f32x4*)(gn + (e0 & 127)), gb = *(const f32x4*)(gn + (e0 & 127) + 4);
            f32x4 oa, ob;
#pragma unroll
            for (int i = 0; i < 4; ++i) { oa[i] = v[i] * rn * ga[i]; ob[i] = v[4 + i] * rn * gb[i]; }
            v4u w; w.x = cvtpk(oa[0], oa[1]); w.y = cvtpk(oa[2], oa[3]); w.z = cvtpk(ob[0], ob[1]); w.w = cvtpk(ob[2], ob[3]);
            *(v4u*)(dst + e0) = w;
            if (isk) { *(f32x4*)(fo + e0) = oa; *(f32x4*)(fo + e0 + 4) = ob; }
        }
    }
}

__device__ __forceinline__ void diff_combine_phase(const Args& a, int vcu, int G, int wave, int lane) {
    unsigned char* ws = a.ws;
    const float* OA0 = (const float*)(ws + WS_OA); const float* OA1 = OA0 + (size_t)MR * DM; bf16* HA = (bf16*)(ws + WS_HA);
    const float lam = ((const float*)(ws + WS_SMALL))[SM_LAM];
    const int gw = vcu * NWAVES + wave, NGW = G * NWAVES;
    for (int it = gw; it < MR * 8; it += NGW) {
        const size_t off = (size_t)it * 256 + lane * 4;
        const f32x4 x0 = *(const f32x4*)(OA0 + off), x1 = *(const f32x4*)(OA1 + off);
        const f32x4 o = x0 - x1 * lam;
        const float s = wave_sum((o.x * o.x + o.y * o.y) + (o.z * o.z + o.w * o.w));
        const float rn = __builtin_amdgcn_rsqf(s * (1.f / 256.f) + EPS);
        v2u w; w.x = cvtpk(o.x * rn, o.y * rn); w.y = cvtpk(o.z * rn, o.w * rn);
        *(v2u*)(HA + off) = w;
    }
}

__device__ __forceinline__ void attention_phase(const Args& a, char* lds, int vcu, int G) {
    unsigned char* ws = a.ws;
    const att::bf16* QN = (const att::bf16*)(ws + WS_QH); const att::bf16* KN = (const att::bf16*)(ws + WS_KH); const att::bf16* VBn = (const att::bf16*)(ws + WS_VH);
    float* OA0 = (float*)(ws + WS_OA); float* OA1 = OA0 + (size_t)MR * DM;
    const int wid = threadIdx.x >> 6;
#ifndef NO_SAMPLE
    for (int u = vcu; u < 16 * 8; u += G) att::attn_sample_unit(QN, KN, VBn, a.in[3], a.in[4], OA0, OA1, u >> 3, u & 7, lds);
#endif
#ifndef NO_PROMPT
    for (int p = vcu; p < 32 * 16; p += G) {
        const int hc = p >> 4, pr = p & 15, h = hc >> 2, c = (hc >> 1) & 1, e = hc & 1;
        float* OA = c ? OA1 : OA0;
#pragma unroll 1
        for (int half = 0; half < 2; ++half) {
            const int qb = half ? 31 - pr : pr;
            const size_t qoff = (size_t)qb * 256 * DM + h * 256;
            att::attn_dense_body<att::bf16>(QN + qoff + c * 128, KN + h * 256 + c * 128, VBn + h * 256 + e * 128, OA + qoff + e * 128, 4 * qb + 4, 4 * qb + (wid >> 1), lds);
            __syncthreads();
        }
    }
#endif
}

constexpr int NPH = 17;
__global__ void __launch_bounds__(NWAVES * 64, 2) fwd_kernel(Args args) {
    extern __shared__ __attribute__((aligned(16))) unsigned char lds[];
    LAS unsigned char* L = (LAS unsigned char*)lds;
    volatile LAS unsigned* MISC = (volatile LAS unsigned*)(L + MISC_OFF);
    const int tid = threadIdx.x, lane = tid & 63, wave = __builtin_amdgcn_readfirstlane(tid >> 6);
    const int G = gridDim.x; const int bx = blockIdx.x; const int vcu = (G % 8 == 0) ? (bx % 8) * (G / 8) + bx / 8 : bx;
    unsigned char* ws = args.ws;
    gu32* ctl = (gu32*)(ws + WS_CTL);
    for (int u = tid; u < (LDS_BYTES - LDSCTL_OFF) / 4; u += NWAVES * 64) ((LAS unsigned*)(L + LDSCTL_OFF))[u] = 0u;
    __syncthreads();
    const int lo = args.ph_lo, hi = args.ph_hi;
    XcdBarrier bar; bar.bar = (unsigned*)(ctl + CW_BAR); bar.x = 0; bar.st = nullptr;
    if (hi - lo > 1) bar = xcd_barrier_post((unsigned*)(ctl + CW_BAR), MISC + 8);
#ifndef PHMASK
#define PHMASK 0x1ffff
#endif
#define IN(k) ((((PHMASK) >> (k)) & 1) && lo <= (k) && (k) < hi)
#define SEAM(k) do { if (IN(k) && IN((k) + 1)) xcd_barrier(bar); } while (0)
    float* sm = (float*)(ws + WS_SMALL);
    float* ss1 = (float*)(ctl + CW_SS1); float* ss2 = (float*)(ctl + CW_SS2); float* ss3 = (float*)(ctl + CW_SS3);
    bf16* XB = (bf16*)(ws + WS_XB); bf16* HA = (bf16*)(ws + WS_HA); float* X1 = (float*)(ws + WS_X1); bf16* GU = (bf16*)(ws + WS_GU); bf16* ACT = (bf16*)(ws + WS_ACT);
    float* out = args.out;

    if (IN(0)) { p0_prologue(args, L, vcu, G, wave, lane); }
    SEAM(0);
    if (IN(1)) {
        pg8::Gemm g{XB, (const bf16*)(ws + WS_W_HIN), MR, NHG, DM}; pg8::StaticOrder S; S.init(MR, NHG, G, bx);
        EpiHgrnIn E{(bf16*)(ws + WS_QH), (bf16*)(ws + WS_KH), (bf16*)(ws + WS_VH), (bf16*)(ws + WS_SG), (float*)(ws + WS_G), sm + SM_RINV0, sm + SM_LB};
        pg8::gemm_phase<EpiHgrnIn, pg8::StaticOrder, true, true>(L + RING_OFF, g, S, E);
    }
    SEAM(1);
    if (IN(2)) scan_local_phase(args, L, vcu, G, tid, wave, lane);
    SEAM(2);
    if (IN(3)) scan_carry_phase(args, vcu, G, tid);
    SEAM(3);
    if (IN(4)) scan_out_phase(args, L, vcu, G, tid, wave, lane);
    SEAM(4);
    if (IN(5)) {
        pg8::Gemm g{HA, (const bf16*)(ws + WS_W_HOUT), MR, DM, DM}; pg8::StaticOrder S; S.init(MR, DM, G, bx);
        EpiResid<true> E{args.in[0], args.in[1] - (size_t)MP * DM, X1, XB, ss1};
        pg8::gemm_phase<EpiResid<true>, pg8::StaticOrder, true, true>(L + RING_OFF, g, S, E);
    }
    SEAM(5);
    if (IN(6)) {
        pg8::Gemm g{XB, (const bf16*)(ws + WS_W_UP0), MR, NUP, DM}; pg8::StaticOrder S; S.init(MR, NUP, G, bx);
        EpiUp E{GU, ss1, out + O_CP, out + O_CS};
        pg8::gemm_phase<EpiUp, pg8::StaticOrder, true, true>(L + RING_OFF, g, S, E);
    }
    SEAM(6);
    if (IN(7)) conv_act_phase(args, 0, vcu, G, tid);
    SEAM(7);
    if (IN(8)) {
        pg8::Gemm g{ACT, (const bf16*)(ws + WS_W_DN0), MR, DM, DFF}; pg8::StaticOrder S; S.init(MR, DM, G, bx);
        EpiResid<true> E{X1, X1, X1, XB, ss2};
        pg8::gemm_phase<EpiResid<true>, pg8::StaticOrder, true, true>(L + RING_OFF, g, S, E);
    }
    SEAM(8);
    if (IN(9)) {
        pg8::Gemm g{XB, (const bf16*)(ws + WS_W_DIN), MR, NDI, DM}; pg8::StaticOrder S; S.init(MR, NDI, G, bx);
        EpiDiffIn E{(bf16*)(ws + WS_QKR), (bf16*)(ws + WS_VH), ss2, out + O_VP, out + O_VS - (size_t)MP * DM};
        pg8::gemm_phase<EpiDiffIn, pg8::StaticOrder, true, true>(L + RING_OFF, g, S, E);
    }
    SEAM(9);
    if (IN(10)) qknorm_phase(args, vcu, G, wave, lane);
    SEAM(10);
    if (IN(11)) attention_phase(args, (char*)lds, vcu, G);
    SEAM(11);
    if (IN(12)) diff_combine_phase(args, vcu, G, wave, lane);
    SEAM(12);
    if (IN(13)) {
        pg8::Gemm g{HA, (const bf16*)(ws + WS_W_DOUT), MR, DM, DM}; pg8::StaticOrder S; S.init(MR, DM, G, bx);
        EpiResid<true> E{X1, X1, X1, XB, ss3};
        pg8::gemm_phase<EpiResid<true>, pg8::StaticOrder, true, true>(L + RING_OFF, g, S, E);
    }
    SEAM(13);
    if (IN(14)) {
        pg8::Gemm g{XB, (const bf16*)(ws + WS_W_UP1), MR, NUP, DM}; pg8::StaticOrder S; S.init(MR, NUP, G, bx);
        EpiUp E{GU, ss3, out + O_CP + 2 * DFF, out + O_CS + (size_t)16 * 2 * DFF};
        pg8::gemm_phase<EpiUp, pg8::StaticOrder, true, true>(L + RING_OFF, g, S, E);
    }
    SEAM(14);
    if (IN(15)) conv_act_phase(args, 1, vcu, G, tid);
    SEAM(15);
    if (IN(16)) {
        pg8::Gemm g{ACT, (const bf16*)(ws + WS_W_DN1), MR, DM, DFF}; pg8::StaticOrder S; S.init(MR, DM, G, bx);
        EpiResid<false> E{X1, X1, out + O_Y, nullptr, nullptr};
        pg8::gemm_phase<EpiResid<false>, pg8::StaticOrder, true, true>(L + RING_OFF, g, S, E);
    }
#undef IN
#undef SEAM
}

#ifndef MK_PER_PHASE
#define MK_PER_PHASE 0
#endif
extern "C" void kernel_launch(void* const* d_in, const int* in_sizes, int n_in, void* d_out, int out_size, void* d_ws, size_t ws_size, hipStream_t stream) {
    static int grid = 0;
    if (grid == 0) {
        if (n_in != 25 || out_size != (int)O_END || ws_size < WS_END) { fprintf(stderr, "kernel_launch: built for 25 inputs, %zu outputs, >= %zu bytes of workspace; got n_in %d, out %d, ws %zu; nothing launched\n", (size_t)O_END, (size_t)WS_END, n_in, out_size, ws_size); grid = -1; return; }
        int dev = 0, cus = 0, per_cu = 0;
        if (hipGetDevice(&dev) != hipSuccess || hipDeviceGetAttribute(&cus, hipDeviceAttributeMultiprocessorCount, dev) != hipSuccess) { fprintf(stderr, "kernel_launch: device query failed\n"); grid = -1; return; }
        if (hipFuncSetAttribute((const void*)fwd_kernel, hipFuncAttributeMaxDynamicSharedMemorySize, LDS_BYTES) != hipSuccess) { fprintf(stderr, "kernel_launch: hipFuncSetAttribute failed\n"); grid = -1; return; }
        if (hipOccupancyMaxActiveBlocksPerMultiprocessor(&per_cu, (const void*)fwd_kernel, NWAVES * 64, LDS_BYTES) != hipSuccess || per_cu < 1)
            fprintf(stderr, "kernel_launch: note: occupancy query reports %d workgroups per CU\n", per_cu);
        (void)hipGetLastError();
        grid = cus;
    }
    if (grid < 0) return;
    if (hipMemsetAsync((char*)d_ws + WS_CTL, 0, CTL_ZERO_BYTES, stream) != hipSuccess) { fprintf(stderr, "kernel_launch: memset failed\n"); return; }
    Args a{};
    for (int i = 0; i < 25; ++i) a.in[i] = (const float*)d_in[i];
    a.out = (float*)d_out; a.ws = (unsigned char*)d_ws;
#if MK_PER_PHASE
    for (int ph = 0; ph < NPH; ++ph) { a.ph_lo = ph; a.ph_hi = ph + 1; hipLaunchKernelGGL(fwd_kernel, dim3(grid), dim3(NWAVES * 64), LDS_BYTES, stream, a); }
#else
    a.ph_lo = 0; a.ph_hi = NPH; hipLaunchKernelGGL(fwd_kernel, dim3(grid), dim3(NWAVES * 64), LDS_BYTES, stream, a);
#endif
    const hipError_t le = hipPeekAtLastError();
    if (le != hipSuccess) fprintf(stderr, "kernel_launch: launch failed: %s\n", hipGetErrorName(le));
}
```

```cpp
#include <hip/hip_runtime.h>
#include <hip/hip_bf16.h>
#include <cstdio>
#include <cstdint>
#include <cmath>

constexpr int DM = 2048;
constexpr int MP = 8192, MS = 1024;
constexpr int MR = MP + MS;
constexpr int DFF = 5632, NUP = 2 * DFF;
constexpr int NHG = 4 * DM;
constexpr int NDI = 3 * DM;
constexpr int NCH = MR / 64;
constexpr int NCHP = MP / 64;
constexpr int PAST = 4096;
constexpr float EPS = 1e-6f;
constexpr float LAM_INIT = 0.35550906759f;

constexpr size_t O_Y = 0;
constexpr size_t O_HP = (size_t)MR * DM;
constexpr size_t O_HS = O_HP + 16 * 128 * 128;
constexpr size_t O_KP = O_HS + (size_t)16 * 16 * 128 * 128;
constexpr size_t O_VP = O_KP + (size_t)MP * DM;
constexpr size_t O_KS = O_VP + (size_t)MP * DM;
constexpr size_t O_VS = O_KS + (size_t)MS * DM;
constexpr size_t O_CP = O_VS + (size_t)MS * DM;
constexpr size_t O_CS = O_CP + 2 * 2 * DFF;
constexpr size_t O_END = O_CS + (size_t)2 * 16 * 2 * DFF;
static_assert(O_END == 61462528, "output size");

constexpr size_t MiB = 1u << 20;
constexpr size_t WS_CTL = 0, CTL_ZERO_BYTES = 1 * MiB;
constexpr size_t WS_SMALL = 1 * MiB;
constexpr size_t WS_W_HIN = 2 * MiB, WS_W_HOUT = 34 * MiB, WS_W_UP0 = 42 * MiB, WS_W_DN0 = 86 * MiB, WS_W_DIN = 108 * MiB, WS_W_DOUT = 132 * MiB, WS_W_UP1 = 140 * MiB, WS_W_DN1 = 184 * MiB;
constexpr size_t WS_XB = 206 * MiB, WS_QH = 242 * MiB, WS_KH = 278 * MiB, WS_VH = 314 * MiB, WS_SG = 350 * MiB, WS_G = 386 * MiB;
constexpr size_t WS_LST = 458 * MiB, WS_DC = 602 * MiB, WS_SIN = 604 * MiB, WS_HA = 676 * MiB, WS_X1 = 712 * MiB, WS_GU = 784 * MiB, WS_ACT = 982 * MiB;
constexpr size_t WS_QKR = 1081 * MiB, WS_OA = 1153 * MiB, WS_SLAB = 1297 * MiB, WS_END = 1329 * MiB;
constexpr int CW_TMO = 0;
constexpr int CW_ATTQ = 2048;
constexpr int CW_BAR = 4096;
constexpr int CW_SKF = 131072;
constexpr int CW_SS1 = 65536, CW_SS2 = 65536 + 16384, CW_SS3 = 65536 + 2 * 16384;
constexpr int SM_RINV0 = 0, SM_LB = 16384, SM_LAM = 16384 + 4096;

constexpr int RING_OFF = 0, RING_BYTES = 131072;
constexpr int SCR_OFF = RING_BYTES;
constexpr int LDSCTL_OFF = RING_BYTES + 8192, MISC_OFF = LDSCTL_OFF + 320;
constexpr int LDS_BYTES = 147456;
constexpr int NWAVES = 8;

#define GAS __attribute__((address_space(1)))
#define LAS __attribute__((address_space(3)))
typedef unsigned short bf16;
typedef unsigned v4u __attribute__((ext_vector_type(4)));
typedef unsigned v2u __attribute__((ext_vector_type(2)));
typedef float f32x4 __attribute__((ext_vector_type(4)));
typedef float f32x2 __attribute__((ext_vector_type(2)));
typedef float f32x16 __attribute__((ext_vector_type(16)));
typedef short bf16x8 __attribute__((ext_vector_type(8)));
typedef short s16x4 __attribute__((ext_vector_type(4)));
typedef GAS unsigned gu32;
#define RLX_AGENT __ATOMIC_RELAXED, __HIP_MEMORY_SCOPE_AGENT
#define LDS_WAIT() asm volatile("s_waitcnt lgkmcnt(0)" ::: "memory")
#define VM_WAIT() asm volatile("s_waitcnt vmcnt(0)" ::: "memory")
__device__ __forceinline__ unsigned f2bf(float f) { unsigned u = __builtin_bit_cast(unsigned, f); return (u + 0x7fffu + ((u >> 16) & 1u)) >> 16; }
__device__ __forceinline__ unsigned pk2(float lo, float hi) { return f2bf(lo) | (f2bf(hi) << 16); }
__device__ __forceinline__ unsigned cvtpk(float lo, float hi) { unsigned r; asm volatile("v_cvt_pk_bf16_f32 %0, %1, %2" : "=v"(r) : "v"(lo), "v"(hi)); return r; }
__device__ __forceinline__ float bflo(unsigned w) { return __uint_as_float(w << 16); }
__device__ __forceinline__ float bfhi(unsigned w) { return __uint_as_float(w & 0xffff0000u); }
__device__ __forceinline__ float wave_sum(float v) {
#pragma unroll
    for (int o = 1; o < 64; o <<= 1) v += __shfl_xor(v, o);
    return v;
}
__device__ __forceinline__ int lane_id() { int r; asm volatile("v_mbcnt_lo_u32_b32 %0, -1, 0\n\tv_mbcnt_hi_u32_b32 %0, -1, %0" : "=v"(r)); return r; }
__device__ __forceinline__ float sigmoidf_(float z) { return __builtin_amdgcn_rcpf(1.f + __expf(-z)); }
namespace pg8 {
#define PG8_LAS __attribute__((address_space(3)))
typedef unsigned short bf16_t;
typedef short bf16x8 __attribute__((ext_vector_type(8)));
typedef float f32x4 __attribute__((ext_vector_type(4)));
typedef unsigned u32x4 __attribute__((ext_vector_type(4)));
constexpr int BM = 256, BK = 64, HALF = 128, HTB = HALF * BK * 2  , STAGE_BYTES = 8 * HTB, NXCD = 8, WGM = 8;

__host__ __device__ __forceinline__ int lds_byte(int r, int c) { const int st = (r >> 4) * 2 + (c >> 5), rr = r & 15, cc = c & 31, ob = rr * 64 + cc * 2; return st * 1024 + (ob ^ (((ob >> 9) & 1) << 5)); }
__host__ __device__ __forceinline__ void stage_rc(int b, int& R, int& C) { const int st = b / 1024, sb = b % 1024, swz = sb ^ (((sb >> 9) & 1) << 5); R = (st >> 1) * 16 + swz / 64; C = (st & 1) * 32 + (swz % 64) / 2; }
__host__ __device__ __forceinline__ int perm32(int rho) { const int n = rho >> 4, i = rho & 15; return 8 * (i >> 2) + 4 * n + (i & 3); }

struct Unit { int pm, pn; int k0, nk, mode, tt, sj, ss; };
struct Gemm { const bf16_t* A; const bf16_t* Bt; int M, N, K; };

struct StaticOrder {
    int nM, nN, nwg, G, c;
    __host__ __device__ void init(int M, int N, int G_, int c_) { nM = M / BM; nN = N / BM; nwg = nM * nN; G = G_; c = c_; }
    __host__ __device__ bool next(int i, Unit& u) const {
        const long L = (long)i * G + c; if (L >= nwg) return false;
        int wgid = (int)L; { const int q = nwg / NXCD, r = nwg % NXCD, xcd = wgid % NXCD, off = wgid / NXCD; wgid = (xcd < r ? xcd * (q + 1) : r * (q + 1) + (xcd - r) * q) + off; }
        const int nig = WGM * nN, gid = wgid / nig, fm = gid * WGM, gsz = (nM - fm) < WGM ? (nM - fm) : WGM;
        u.pm = fm + ((wgid % nig) % gsz); u.pn = (wgid % nig) / gsz; return true;
    }
    __device__ __forceinline__ void a_ready(const Unit&) const {}
    __device__ __forceinline__ void done(const Unit&) const {}
};

__device__ __forceinline__ unsigned cvt_pk_bf16(float lo, float hi) { unsigned r; asm volatile("v_cvt_pk_bf16_f32 %0, %1, %2" : "=v"(r) : "v"(lo), "v"(hi)); return r; }
typedef float f32x2 __attribute__((ext_vector_type(2)));
template <int nN1>
struct SplitOrderT {
    int nM, nN, nwg, G, c, vc, R, r, s, npairs, wv; float* slab; unsigned* flags;
    __device__ __forceinline__ void init(int M, int N, int K, int G_, int c_, int vc_, float* slab_, unsigned* flags_, int smax, int wv_) { wv = wv_;
        nM = M / BM; nN = N / BM; nwg = nM * nN; G = __builtin_amdgcn_readfirstlane(G_); c = __builtin_amdgcn_readfirstlane(c_); vc = __builtin_amdgcn_readfirstlane(vc_); R = nwg / G;
        r = nwg - R * G; s = r ? G / r : 1; if (s > smax) s = smax; npairs = K / (2 * BK); slab = slab_; flags = flags_; }
    __device__ __forceinline__ void tile(int L, Unit& u) const {
        int nNg = nN, nwgg = nwg, pn0 = 0;
        if (nN1 > 0) { if (L >= nM * nN1) { L -= nM * nN1; nNg = nN - nN1; pn0 = nN1; } else nNg = nN1; nwgg = nM * nNg; }
        int wgid = L; { const int q = nwgg / NXCD, rr = nwgg % NXCD, xcd = wgid % NXCD, off = wgid / NXCD; wgid = (xcd < rr ? xcd * (q + 1) : rr * (q + 1) + (xcd - rr) * q) + off; }
        const int nig = WGM * nNg, gid = wgid / nig, fm = gid * WGM, gsz = (nM - fm) < WGM ? (nM - fm) : WGM;
        u.pm = fm + ((wgid % nig) % gsz); u.pn = pn0 + (wgid % nig) / gsz; }
    __device__ __forceinline__ bool has_slice() const { return s > 0 && vc < r * s; }
    __device__ __forceinline__ void slice(Unit& u) const {
        const int tt = vc / s, j = vc - tt * s; tile(R * G + tt, u);
        const int p0 = (j * npairs) / s, p1 = ((j + 1) * npairs) / s; u.k0 = 2 * p0; u.nk = 2 * (p1 - p0); u.mode = 3; u.tt = tt; u.sj = j; u.ss = s; }
    __device__ __forceinline__ bool next(int i_, Unit& u) const {
        int i = __builtin_amdgcn_readfirstlane(i_);
        if (has_slice()) { if (i == 0) { slice(u); return true; } --i; }
        if (i < R) { tile(i * G + c, u); u.k0 = 0; u.nk = 2 * npairs; u.mode = 0; u.tt = 0; u.sj = 0; u.ss = 1; return true; }
        if (i > R || s > 0 || c >= r) return false;
        tile(R * G + c, u); u.k0 = 0; u.nk = 2 * npairs; u.mode = 0; u.tt = 0; u.sj = 0; u.ss = 1; return true;
    }
    __device__ __forceinline__ void a_ready(const Unit&) const {}
    __device__ __forceinline__ void done(const Unit&) const {}
    template <class Epi>
    __device__ __forceinline__ bool pre(f32x4 (&acc)[2][2][4][2], const Unit& u, int wid, int lane, const Epi& E) const {
        if (u.mode == 0) return true;
        const __amdgpu_buffer_rsrc_t rs = __builtin_amdgcn_make_buffer_rsrc((void*)slab, (short)0, 256 * 131072, 0x00020000);
        {
            unsigned off = (unsigned)vc * 131072u + (unsigned)wid * 16384u + (unsigned)lane * 16u;
#pragma unroll
            for (int ai = 0; ai < 2; ++ai)
#pragma unroll
                for (int m = 0; m < 4; ++m)
#pragma unroll
                    for (int bj = 0; bj < 2; ++bj) { const f32x4 a = acc[ai][bj][m][0], b = acc[ai][bj][m][1];
                        u32x4 w; w.x = cvt_pk_bf16(a[0], a[1]); w.y = cvt_pk_bf16(a[2], a[3]); w.z = cvt_pk_bf16(b[0], b[1]); w.w = cvt_pk_bf16(b[2], b[3]);
                        __builtin_amdgcn_raw_buffer_store_b128(w, rs, off + (unsigned)(((ai * 4 + m) * 2 + bj) * 1024), 0, 16); }
            asm volatile("s_waitcnt vmcnt(0)" ::: "memory");
        }
        __builtin_amdgcn_s_barrier();
        if (wid == 0 && lane == 0) __hip_atomic_fetch_add(flags + 32 * u.tt, 1u, __ATOMIC_RELAXED, __HIP_MEMORY_SCOPE_AGENT);
        return false;
    }
    template <class Epi>
    __device__ __forceinline__ void post(const Epi& E, int wid, int lane) const {
        if (!has_slice()) return;
        Unit u; slice(u);
        const __amdgpu_buffer_rsrc_t rs = __builtin_amdgcn_make_buffer_rsrc((void*)slab, (short)0, 256 * 131072, 0x00020000);
        if (wid == 0) {
            const unsigned* fl = flags + 32 * u.tt; const unsigned want = (unsigned)u.ss; unsigned spins = 0;
            while ((unsigned)__builtin_amdgcn_readfirstlane(__hip_atomic_load(fl, __ATOMIC_RELAXED, __HIP_MEMORY_SCOPE_AGENT)) < want) { __builtin_amdgcn_s_sleep(16); if (++spins > (1u << 20)) break; }
        }
        __builtin_amdgcn_s_barrier();
        asm volatile("" ::: "memory");
        const int fr = lane & 15, fq = lane >> 4;
        for (int p = u.sj; p < 8; p += u.ss) {
            f32x4 vv[2][2];
#pragma unroll
            for (int gg = 0; gg < 2; ++gg) {
                const int g = 2 * wid + gg;
                const unsigned off = (unsigned)(u.tt * u.ss) * 131072u + (unsigned)p * 16384u + (unsigned)g * 1024u + (unsigned)lane * 16u;
                u32x4 t[8];
#pragma unroll
                for (int jp = 0; jp < 8; ++jp) if (jp < u.ss) t[jp] = __builtin_amdgcn_raw_buffer_load_b128(rs, off + (unsigned)jp * 131072u, 0, 16);
                f32x4 v0 = {0.f, 0.f, 0.f, 0.f}, v1 = {0.f, 0.f, 0.f, 0.f};
#pragma unroll
                for (int jp = 0; jp < 8; ++jp) if (jp < u.ss) {
                    v0 += (f32x4){__uint_as_float(t[jp].x << 16), __uint_as_float(t[jp].x & 0xffff0000u), __uint_as_float(t[jp].y << 16), __uint_as_float(t[jp].y & 0xffff0000u)};
                    v1 += (f32x4){__uint_as_float(t[jp].z << 16), __uint_as_float(t[jp].z & 0xffff0000u), __uint_as_float(t[jp].w << 16), __uint_as_float(t[jp].w & 0xffff0000u)}; }
                vv[gg][0] = v0; vv[gg][1] = v1;
                if constexpr (!Epi::PAIR) E.group(u, p >> 2, p & 3, fr, fq, g >> 3, (g >> 1) & 3, g & 1, v0, v1);
            }
            if constexpr (Epi::PAIR) E.group2(u, p >> 2, p & 3, fr, fq, wid >> 2, wid & 3, vv[0][0], vv[0][1], vv[1][0], vv[1][1]);
        }
    }
};
typedef SplitOrderT<0> SplitOrder;
template <class Epi, class Sched, bool ALIGN_EPI = false, bool SP2 = false>
__device__ __forceinline__ void gemm_phase(PG8_LAS unsigned char* lds, const Gemm g, const Sched& S, const Epi& E) {
    const int wid = S.wv, lane = lane_id(), tid = wid * 64 + lane, wr = wid >> 2, wc = wid & 3, fr = lane & 15, fq = lane >> 4;
    const int K = g.K;
    unsigned voffA[2], voffB[2];
#pragma unroll
    for (int i = 0; i < 2; ++i) { int R, C; stage_rc(tid * 16 + i * 8192, R, C); const int Rb = Epi::PERM ? ((R & ~31) + perm32(R & 31)) : R;
        voffA[i] = (unsigned)(R * K + C) * 2u; voffB[i] = (unsigned)(Rb * K + C) * 2u; }
    const size_t kstep = (size_t)(BK * 2);
    const size_t hstep = (size_t)HALF * K * 2;
    const size_t tstep = 2 * hstep;
    const unsigned ldsw = (unsigned)wid * 1024u;
    const int aoff = lds_byte(wr * 64 + fr, fq * 8), boff = lds_byte(wc * 32 + fr, fq * 8);
#define PG8_SA(b, h) (((b) * 2 + (h)) * HTB)
#define PG8_SB(b, h) ((4 + (b) * 2 + (h)) * HTB)
#define PG8_STAGE(bufoff, gbase, voff) do { _Pragma("unroll") for (int _i = 0; _i < 2; ++_i) \
        __builtin_amdgcn_global_load_lds((const unsigned*)((const char*)(gbase) + (voff)[_i]), (PG8_LAS unsigned*)(lds + (bufoff) + ldsw + _i * 8192), 16, 0, 0); } while (0)
#define PG8_LDA(dst, b, h) do { _Pragma("unroll") for (int m = 0; m < 4; ++m) _Pragma("unroll") for (int k = 0; k < 2; ++k) dst[m][k] = *(const PG8_LAS bf16x8*)(lds + PG8_SA(b, h) + aoff + m * 2048 + k * 1024); } while (0)
#define PG8_LDB(dst, b, h) do { _Pragma("unroll") for (int n = 0; n < 2; ++n) _Pragma("unroll") for (int k = 0; k < 2; ++k) dst[n][k] = *(const PG8_LAS bf16x8*)(lds + PG8_SB(b, h) + boff + n * 2048 + k * 1024); } while (0)
#define PG8_MMA(ai, bj, At, Bt) do { __builtin_amdgcn_s_setprio(1); _Pragma("unroll") for (int m = 0; m < 4; ++m) _Pragma("unroll") for (int n = 0; n < 2; ++n) _Pragma("unroll") for (int k = 0; k < 2; ++k) \
        acc[ai][bj][m][n] = __builtin_amdgcn_mfma_f32_16x16x32_bf16(Bt[n][k], At[m][k], acc[ai][bj][m][n], 0, 0, 0); __builtin_amdgcn_s_setprio(0); } while (0)
#define PG8_WAIT_V(n) asm volatile("s_waitcnt vmcnt(" #n ")" ::: "memory")
#define PG8_WAIT_L(n) asm volatile("s_waitcnt lgkmcnt(" #n ")" ::: "memory")
#define PG8_BAR __builtin_amdgcn_s_barrier()
#define PG8_SCHED __builtin_amdgcn_sched_barrier(0)
    Unit cur, nxt; int ui = 0;
    if (!S.next(0, cur)) return;
    f32x4 acc[2][2][4][2];
#pragma unroll
    for (int a = 0; a < 2; ++a)
#pragma unroll
        for (int b = 0; b < 2; ++b)
#pragma unroll
            for (int m = 0; m < 4; ++m)
#pragma unroll
                for (int n = 0; n < 2; ++n) acc[a][b][m][n] = (f32x4){0.f, 0.f, 0.f, 0.f};
    bf16x8 At[4][2], B0[2][2], B1[2][2];
    const char* cA = (const char*)g.A + (size_t)cur.pm * tstep + (size_t)cur.k0 * kstep; const char* cB = (const char*)g.Bt + (size_t)cur.pn * tstep + (size_t)cur.k0 * kstep;
    S.a_ready(cur);
    if constexpr (SP2) {
        PG8_STAGE(PG8_SB(0, 0), cB, voffB); PG8_STAGE(PG8_SB(0, 1), cB + hstep, voffB); PG8_STAGE(PG8_SA(0, 0), cA, voffA); PG8_STAGE(PG8_SA(0, 1), cA + hstep, voffA);
        if (wr == 1) PG8_BAR;
        PG8_WAIT_V(2); PG8_BAR;
        PG8_STAGE(PG8_SB(1, 0), cB + kstep, voffB); PG8_STAGE(PG8_SA(1, 0), cA + kstep, voffA); PG8_STAGE(PG8_SB(1, 1), cB + hstep + kstep, voffB);
        PG8_WAIT_V(6); PG8_BAR;
    } else {
        PG8_STAGE(PG8_SB(0, 0), cB, voffB); PG8_STAGE(PG8_SA(0, 0), cA, voffA); PG8_STAGE(PG8_SB(0, 1), cB + hstep, voffB); PG8_STAGE(PG8_SA(0, 1), cA + hstep, voffA);
        if (wr == 1) PG8_BAR;
        PG8_WAIT_V(4); PG8_BAR;
        PG8_STAGE(PG8_SB(1, 0), cB + kstep, voffB); PG8_STAGE(PG8_SA(1, 0), cA + kstep, voffA); PG8_STAGE(PG8_SB(1, 1), cB + hstep + kstep, voffB);
        PG8_WAIT_V(6); PG8_BAR;
    }
    for (;;) {
        const bool has_next = S.next(ui + 1, nxt);
        const char* nA = has_next ? (const char*)g.A + (size_t)nxt.pm * tstep + (size_t)nxt.k0 * kstep : cA; const char* nB = has_next ? (const char*)g.Bt + (size_t)nxt.pn * tstep + (size_t)nxt.k0 * kstep : cB;
        const int nt = cur.nk;
        for (int t = 0; t < nt; t += 2) {
            const bool last = (t == nt - 2);
            const char* a1 = cA + (size_t)(t + 1) * kstep;
            const char* a2 = last ? nA : cA + (size_t)(t + 2) * kstep; const char* b2 = last ? nB : cB + (size_t)(t + 2) * kstep;
            const char* a3 = a2 + kstep; const char* b3 = b2 + kstep;
            if (last && has_next) S.a_ready(nxt);
            if constexpr (SP2) {
            PG8_LDB(B0, 0, 0); PG8_LDB(B1, 0, 1); PG8_SCHED; PG8_LDA(At, 0, 0); PG8_STAGE(PG8_SA(1, 1), a1 + hstep, voffA);
            PG8_WAIT_V(8); PG8_WAIT_L(0); PG8_BAR; PG8_MMA(0, 0, At, B0); PG8_MMA(0, 1, At, B1); PG8_BAR; PG8_SCHED;
            PG8_LDA(At, 0, 1); PG8_STAGE(PG8_SB(0, 0), b2, voffB); PG8_STAGE(PG8_SB(0, 1), b2 + hstep, voffB); PG8_STAGE(PG8_SA(0, 0), a2, voffA);
            PG8_WAIT_V(8); PG8_WAIT_L(0); PG8_BAR; PG8_MMA(1, 0, At, B0); PG8_MMA(1, 1, At, B1); PG8_BAR; PG8_SCHED;
            PG8_LDB(B0, 1, 0); PG8_LDB(B1, 1, 1); PG8_SCHED; PG8_LDA(At, 1, 0); PG8_STAGE(PG8_SA(0, 1), a2 + hstep, voffA);
            PG8_WAIT_V(8); PG8_WAIT_L(0); PG8_BAR; PG8_MMA(0, 0, At, B0); PG8_MMA(0, 1, At, B1); PG8_BAR; PG8_SCHED;
            PG8_LDA(At, 1, 1); PG8_STAGE(PG8_SB(1, 0), b3, voffB); PG8_STAGE(PG8_SB(1, 1), b3 + hstep, voffB); PG8_STAGE(PG8_SA(1, 0), a3, voffA);
            PG8_WAIT_V(8); PG8_WAIT_L(0); PG8_BAR; PG8_MMA(1, 0, At, B0); PG8_MMA(1, 1, At, B1); PG8_BAR; PG8_SCHED;
            } else {
            PG8_LDB(B0, 0, 0); PG8_SCHED; PG8_LDA(At, 0, 0); PG8_STAGE(PG8_SA(1, 1), a1 + hstep, voffA);
            PG8_WAIT_L(8); PG8_BAR; PG8_WAIT_L(0); PG8_MMA(0, 0, At, B0); PG8_BAR; PG8_SCHED;
            PG8_LDB(B1, 0, 1); PG8_STAGE(PG8_SB(0, 0), b2, voffB);
            PG8_BAR; PG8_WAIT_L(0); PG8_MMA(0, 1, At, B1); PG8_BAR;
            PG8_LDA(At, 0, 1); PG8_STAGE(PG8_SA(0, 0), a2, voffA);
            PG8_BAR; PG8_WAIT_L(0); PG8_MMA(1, 0, At, B0); PG8_BAR; PG8_SCHED;
            PG8_STAGE(PG8_SB(0, 1), b2 + hstep, voffB);
            PG8_WAIT_V(6); PG8_BAR; PG8_MMA(1, 1, At, B1); PG8_BAR;
            PG8_LDB(B0, 1, 0); PG8_SCHED; PG8_LDA(At, 1, 0); PG8_STAGE(PG8_SA(0, 1), a2 + hstep, voffA);
            PG8_WAIT_L(8); PG8_BAR; PG8_WAIT_L(0); PG8_MMA(0, 0, At, B0); PG8_BAR; PG8_SCHED;
            PG8_LDB(B1, 1, 1); PG8_STAGE(PG8_SB(1, 0), b3, voffB);
            PG8_BAR; PG8_WAIT_L(0); PG8_MMA(0, 1, At, B1); PG8_BAR;
            PG8_LDA(At, 1, 1); PG8_STAGE(PG8_SA(1, 0), a3, voffA);
            PG8_BAR; PG8_WAIT_L(0); PG8_MMA(1, 0, At, B0); PG8_BAR; PG8_SCHED;
            PG8_STAGE(PG8_SB(1, 1), b3 + hstep, voffB);
            PG8_WAIT_V(6); PG8_BAR; PG8_MMA(1, 1, At, B1); PG8_BAR;
            }
        }
        if constexpr (ALIGN_EPI) { if (wr == 0) PG8_BAR; }
        if constexpr (!Epi::AFTER_DRAIN) { if (S.pre(acc, cur, wid, lane, E)) E(acc, cur, wr, wc, fr, fq); S.done(cur); }
        if (!has_next) break;
#pragma unroll
        for (int a = 0; a < 2; ++a)
#pragma unroll
            for (int b = 0; b < 2; ++b)
#pragma unroll
                for (int m = 0; m < 4; ++m)
#pragma unroll
                    for (int n = 0; n < 2; ++n) acc[a][b][m][n] = (f32x4){0.f, 0.f, 0.f, 0.f};
        cur = nxt; cA = nA; cB = nB; ++ui;
        if constexpr (ALIGN_EPI) { if (wr == 1) PG8_BAR; }
    }
    PG8_WAIT_V(0);
    if constexpr (!ALIGN_EPI) { if (wr == 0) PG8_BAR; }
    PG8_BAR;
    S.post(E, wid, lane);
    if constexpr (Epi::AFTER_DRAIN) { E.fused(acc, cur, wr, wc, fr, fq, lds, wid, lane); S.done(cur); }
#undef PG8_SA
#undef PG8_SB
#undef PG8_STAGE
#undef PG8_LDA
#undef PG8_LDB
#undef PG8_MMA
#undef PG8_WAIT_V
#undef PG8_WAIT_L
#undef PG8_BAR
#undef PG8_SCHED
}
}

#define EPI_ARGS const pg8::f32x4 (&acc)[2][2][4][2], const pg8::Unit& u, int wr, int wc, int fr, int fq
#define EPI_GARGS const pg8::Unit& u, int wr, int wc, int fr, int fq, int ai, int m, int bj, f32x4 v0, f32x4 v1
#define EPI_WALK _Pragma("unroll") for (int ai = 0; ai < 2; ++ai) _Pragma("unroll") for (int m = 0; m < 4; ++m) _Pragma("unroll") for (int bj = 0; bj < 2; ++bj) group(u, wr, wc, fr, fq, ai, m, bj, acc[ai][bj][m][0], acc[ai][bj][m][1]);
__device__ __forceinline__ void st8bf(bf16* p, f32x4 a, f32x4 b) {
    v4u w; w.x = cvtpk(a[0], a[1]); w.y = cvtpk(a[2], a[3]); w.z = cvtpk(b[0], b[1]); w.w = cvtpk(b[2], b[3]); *(v4u*)p = w;
}
__device__ __forceinline__ void st8f(float* p, f32x4 a, f32x4 b) { *(f32x4*)p = a; *(f32x4*)(p + 4) = b; }

struct EpiHgrnIn {
    static constexpr bool PERM = true, AFTER_DRAIN = false, PAIR = false;
    unsigned char* ws;
    __device__ __forceinline__ void group(EPI_GARGS) const {
        bf16* Q = (bf16*)(ws + WS_QH); bf16* V = (bf16*)(ws + WS_VH); bf16* SG = (bf16*)(ws + WS_SG); float* G = (float*)(ws + WS_G);
        const float* rinv = (const float*)(ws + WS_SMALL) + SM_RINV0; const float* lb = (const float*)(ws + WS_SMALL) + SM_LB;
        const int sec = u.pn >> 3, lc = (u.pn & 7) * 256 + bj * 128 + wc * 32 + 8 * fq;
        const int row = u.pm * 256 + ai * 128 + wr * 64 + m * 16 + fr; const float r = rinv[row];
        const size_t off = (size_t)row * DM + lc;
        f32x4 a = v0 * r, b = v1 * r;
        if (sec == 0) st8bf(Q + off, a, b);
        else if (sec == 2) st8bf(V + off, a, b);
        else if (sec == 3) {
#pragma unroll
            for (int i = 0; i < 4; ++i) { a[i] = a[i] * sigmoidf_(a[i]); b[i] = b[i] * sigmoidf_(b[i]); }
            st8bf(SG + off, a, b);
        } else {
            const f32x4 l0 = *(const f32x4*)(lb + lc), l1 = *(const f32x4*)(lb + lc + 4);
            f32x4 ga, gb;
#pragma unroll
            for (int i = 0; i < 4; ++i) {
                const float f0 = l0[i] + (1.f - l0[i]) * sigmoidf_(a[i]), f1 = l1[i] + (1.f - l1[i]) * sigmoidf_(b[i]);
                ga[i] = __logf(f0); gb[i] = __logf(f1);
            }
            st8f(G + off, ga, gb);
        }
    }
    __device__ __forceinline__ void operator()(EPI_ARGS) const { EPI_WALK }
};

template <bool NEXT> struct EpiResid {
    static constexpr bool PERM = true, AFTER_DRAIN = false, PAIR = false;
    const float* xin_p; const float* xin_s;
    float* Xout; bf16* XB; float* ss;
    __device__ __forceinline__ void group(EPI_GARGS) const {
        const float* xin = (u.pm < 32) ? xin_p : xin_s;
        const int row = u.pm * 256 + ai * 128 + wr * 64 + m * 16 + fr;
        const size_t off = (size_t)row * DM + u.pn * 256 + bj * 128 + wc * 32 + 8 * fq;
        const f32x4 a = v0 + *(const f32x4*)(xin + off), b = v1 + *(const f32x4*)(xin + off + 4);
        st8f(Xout + off, a, b);
        if (NEXT) { st8bf(XB + off, a, b);
            float s = (a[0] * a[0] + a[1] * a[1]) + (a[2] * a[2] + a[3] * a[3]) + (b[0] * b[0] + b[1] * b[1]) + (b[2] * b[2] + b[3] * b[3]);
            s += __shfl_xor(s, 16); s += __shfl_xor(s, 32); if (fq == 0) atomicAdd(ss + row, s); }
    }
    __device__ __forceinline__ void operator()(EPI_ARGS) const { EPI_WALK }
};

__device__ __forceinline__ float dpp_shr1(float v) { return __int_as_float(__builtin_amdgcn_update_dpp(0, __float_as_int(v), 0x111, 0xf, 0xf, true)); }
__device__ __forceinline__ float dpp_shr2(float v) { return __int_as_float(__builtin_amdgcn_update_dpp(0, __float_as_int(v), 0x112, 0xf, 0xf, true)); }
struct EpiUp {
    static constexpr bool PERM = true, AFTER_DRAIN = false, PAIR = true;
    unsigned char* ws; const float* ss; float* conv_p; float* conv_s; const float* cw; const float* cb;
    __device__ __forceinline__ void group(EPI_GARGS) const {}
    __device__ __forceinline__ void group2(const pg8::Unit& u, int wr, int wc, int fr, int fq, int ai, int m, f32x4 ga, f32x4 gb, f32x4 ua, f32x4 ub) const {
        bf16* ACT = (bf16*)(ws + WS_ACT); bf16* SGF = (bf16*)(ws + WS_GU); bf16* SGL = SGF + (size_t)(MR / 16) * 4 * DFF;
        int row = u.pm * 256 + ai * 128 + wr * 64 + m * 16 + fr; asm volatile("" : "+v"(row)); const float r = __builtin_amdgcn_rsqf(ss[row] * (1.f / DM) + EPS);
        const int col = u.pn * 128 + wc * 32 + 8 * fq;
        ga = ga * r; gb = gb * r; ua = ua * r; ub = ub * r;
        if (m == 3 && fr >= 14) {
            if (row >= MP) { const int sb = (row - MP) >> 6; st8f(conv_s + ((size_t)sb * 2 + (fr - 14)) * DFF + col, ga, gb); }
            else if (row >= MP - 2) st8f(conv_p + (size_t)(row - (MP - 2)) * DFF + col, ga, gb);
        }
        const int grp = row >> 4;
#define UP_HALF(g_, u_, cofs) do { f32x4 p1_, p2_; _Pragma("unroll") for (int i = 0; i < 4; ++i) { p1_[i] = dpp_shr1(g_[i]); p2_[i] = dpp_shr2(g_[i]); } \
        if (fr >= 2) { const float* wp_ = cw + col + (cofs); asm volatile("" : "+v"(wp_)); \
            f32x4 x_ = *(const f32x4*)(cb + col + (cofs)) + *(const f32x4*)(wp_ + 2 * DFF) * g_ + *(const f32x4*)(wp_ + DFF) * p1_ + *(const f32x4*)(wp_) * p2_; \
            _Pragma("unroll") for (int i = 0; i < 4; ++i) x_[i] = x_[i] * sigmoidf_(x_[i]) * u_[i]; g_##x = x_; } } while (0)
        f32x4 gax = ga, gbx = gb;
        UP_HALF(ga, ua, 0); UP_HALF(gb, ub, 4);
        if (fr >= 2) {
            st8bf(ACT + (size_t)row * DFF + col, gax, gbx);
            if (fr >= 14) st8bf(SGL + ((size_t)grp * 2 + (fr - 14)) * DFF + col, ga, gb);
        } else {
            st8bf(SGF + (((size_t)grp * 2 + fr) * 2 + 0) * DFF + col, ga, gb); st8bf(SGF + (((size_t)grp * 2 + fr) * 2 + 1) * DFF + col, ua, ub);
        }
#undef UP_HALF
    }
    __device__ __forceinline__ void operator()(EPI_ARGS) const {
#pragma unroll
        for (int ai = 0; ai < 2; ++ai)
#pragma unroll
            for (int m = 0; m < 4; ++m) group2(u, wr, wc, fr, fq, ai, m, acc[ai][0][m][0], acc[ai][0][m][1], acc[ai][1][m][0], acc[ai][1][m][1]);
    }
};

struct EpiDiffIn {
    static constexpr bool PERM = true, AFTER_DRAIN = false, PAIR = false;
    unsigned char* ws; float* out; const float* gq; const float* gk; LAS float* P;
    __device__ __forceinline__ void group(EPI_GARGS) const {
        bf16* VB = (bf16*)(ws + WS_VH); const float* ss = (const float*)(ws + WS_CTL) + CW_SS2;
        float* vout = (u.pm < 32) ? out + O_VP : out + O_VS - (size_t)MP * DM;
        int row = u.pm * 256 + ai * 128 + wr * 64 + m * 16 + fr; asm volatile("" : "+v"(row));
        const size_t off = (size_t)row * DM + (u.pn * 256 + wc * 32 + 8 * fq + bj * 128 - 4096);
        const float r_ = __builtin_amdgcn_rsqf(ss[row] * (1.f / DM) + EPS); const f32x4 a = v0 * r_, b = v1 * r_; st8bf(VB + off, a, b); st8f(vout + off, a, b);
    }
    __device__ __forceinline__ void operator()(const pg8::f32x4 (&acc)[2][2][4][2], const pg8::Unit& u, int wr, int wc, int fr_, int fq_) const {
        int t_ = lane_id(); asm volatile("" : "+v"(t_)); const int fr = t_ & 15, fq = (t_ >> 4) & 3; (void)fr_; (void)fq_;
        bf16* QN = (bf16*)(ws + WS_QH); bf16* KN = (bf16*)(ws + WS_KH); bf16* VB = (bf16*)(ws + WS_VH); const float* ss = (const float*)(ws + WS_CTL) + CW_SS2;
        float* vout_p = out + O_VP; float* vout_s = out + O_VS - (size_t)MP * DM; float* kout_p = out + O_KP; float* kout_s = out + O_KS - (size_t)MP * DM;
        const int c0 = u.pn * 256 + wc * 32 + 8 * fq;
#define RS_(ai, m) __builtin_amdgcn_rsqf(ss[u.pm * 256 + (ai) * 128 + wr * 64 + (m) * 16 + fr] * (1.f / DM) + EPS)
        if (u.pn >= 16) {
            float* vout = (u.pm < 32) ? vout_p : vout_s;
#pragma unroll
            for (int ai = 0; ai < 2; ++ai)
#pragma unroll
                for (int m = 0; m < 4; ++m)
#pragma unroll
                    for (int bj = 0; bj < 2; ++bj) { int row = u.pm * 256 + ai * 128 + wr * 64 + m * 16 + fr; asm volatile("" : "+v"(row)); const size_t off = (size_t)row * DM + (c0 + bj * 128 - 4096);
                        const float r_ = __builtin_amdgcn_rsqf(ss[row] * (1.f / DM) + EPS); const f32x4 a = acc[ai][bj][m][0] * r_, b = acc[ai][bj][m][1] * r_; st8bf(VB + off, a, b); st8f(vout + off, a, b); }
            return;
        }
#pragma unroll
        for (int ai = 0; ai < 2; ++ai)
#pragma unroll
            for (int m = 0; m < 4; ++m)
#pragma unroll
                for (int bj = 0; bj < 2; ++bj) { int rl = ai * 128 + wr * 64 + m * 16 + fr; asm volatile("" : "+v"(rl));
                    const float r_ = __builtin_amdgcn_rsqf(ss[u.pm * 256 + rl] * (1.f / DM) + EPS); const f32x4 a = acc[ai][bj][m][0], b = acc[ai][bj][m][1];
                    float q = ((a[0] * a[0] + a[1] * a[1]) + (a[2] * a[2] + a[3] * a[3]) + (b[0] * b[0] + b[1] * b[1]) + (b[2] * b[2] + b[3] * b[3])) * (r_ * r_);
                    q += __shfl_xor(q, 16); q += __shfl_xor(q, 32);
                    if (fq == 0) P[(rl * 2 + bj) * 4 + wc] = q; }
        asm volatile("s_waitcnt lgkmcnt(0)" ::: "memory"); __builtin_amdgcn_s_barrier(); asm volatile("" ::: "memory");
        const bool isk = u.pn >= 8; const float* gn = isk ? gk : gq; bf16* dst = isk ? KN : QN;
        float* kout = (u.pm < 32) ? kout_p : kout_s;
#pragma unroll
        for (int ai = 0; ai < 2; ++ai)
#pragma unroll
            for (int m = 0; m < 4; ++m)
#pragma unroll
                for (int bj = 0; bj < 2; ++bj) { int rl = ai * 128 + wr * 64 + m * 16 + fr; asm volatile("" : "+v"(rl)); const f32x4 pq = *(const LAS f32x4*)(P + (rl * 2 + bj) * 4);
                    const float rn = __builtin_amdgcn_rsqf(((pq[0] + pq[1]) + (pq[2] + pq[3])) * (1.f / 128.f) + EPS) * __builtin_amdgcn_rsqf(ss[u.pm * 256 + rl] * (1.f / DM) + EPS);
                    const float* gp = gn + wc * 32 + 8 * fq; asm volatile("" : "+v"(gp));
                    const f32x4 g0 = *(const f32x4*)gp, g1 = *(const f32x4*)(gp + 4);
                    const f32x4 a = acc[ai][bj][m][0] * rn * g0, b = acc[ai][bj][m][1] * rn * g1;
                    const size_t off = (size_t)(u.pm * 256 + rl) * DM + ((c0 + bj * 128) & 2047);
                    st8bf(dst + off, a, b); if (isk) st8f(kout + off, a, b); }
        asm volatile("s_waitcnt lgkmcnt(0)" ::: "memory"); __builtin_amdgcn_s_barrier(); asm volatile("" ::: "memory");
#undef RS_
    }
};
#define XB_TMO      128
#define XB_XCNT(j)  (256  + 64 * (j))
#define XB_XSUB(j)  (1280 + 64 * (j))
#define XB_XGEN(j)  (2304 + 64 * (j))
#define XB_TOP      3328
#define XB_TOPGEN   3392
#define XCD_BAR_WORDS 3456
#define XB_SPIN_CAP (1u << 18)

__device__ __forceinline__ unsigned xb_ld(unsigned* p)              { return __hip_atomic_load(p, __ATOMIC_RELAXED, __HIP_MEMORY_SCOPE_AGENT); }
__device__ __forceinline__ unsigned xb_add(unsigned* p, unsigned v) { return __hip_atomic_fetch_add(p, v, __ATOMIC_RELAXED, __HIP_MEMORY_SCOPE_AGENT); }
__device__ __forceinline__ unsigned xb_xcc_id() { return (unsigned)__builtin_amdgcn_s_getreg((3 << 11) | 20) & 0xFu; }
#define XB_SPIN(cond, bar) do { unsigned _sp = 0; while (cond) { __builtin_amdgcn_s_sleep(1); \
    if ((++_sp & 255u) == 0u) { if (xb_ld(&(bar)[XB_TMO])) break; if (_sp > XB_SPIN_CAP) { atomicAdd(&(bar)[XB_TMO], 1u); break; } } } } while (0)

#define XB_T0(b) ((b).wv == 0 && lane_id() == 0)
struct XcdBarrier {
    int wv;
    unsigned* bar; unsigned x;
    volatile LAS unsigned* st;
};

__device__ __forceinline__ XcdBarrier xcd_barrier_post(unsigned* bar, volatile LAS unsigned* st, int wv) {
    XcdBarrier b; b.wv = wv; b.bar = bar; b.x = xb_xcc_id(); b.st = st;
    if (XB_T0(b)) (void)xb_add(&bar[XB_XCNT(b.x)], 1u);
    return b;
}
__device__ __forceinline__ void xcd_barrier_complete(unsigned* bar, unsigned x, unsigned& nloc, unsigned& nx) {
    const unsigned G = gridDim.x * gridDim.y * gridDim.z;
    unsigned sum, cnt, mine, sp = 0u;
    for (;;) {
        sum = 0u; cnt = 0u; mine = 0u;
#pragma unroll
        for (unsigned j = 0; j < 16; ++j) { const unsigned c = xb_ld(&bar[XB_XCNT(j)]); sum += c; cnt += (c > 0u) ? 1u : 0u; mine = (j == x) ? c : mine; }
        if (sum == G) break;
        __builtin_amdgcn_s_sleep(1);
        if ((++sp & 255u) == 0u) { if (xb_ld(&bar[XB_TMO])) break; if (sp > XB_SPIN_CAP) { atomicAdd(&bar[XB_TMO], 1u); break; } }
    }
    nloc = mine > 0u ? mine : 1u; nx = cnt > 0u ? cnt : 1u;
}

__device__ __forceinline__ void xcd_barrier(const XcdBarrier& b) {
    asm volatile("s_waitcnt vmcnt(0)" ::: "memory");
    __syncthreads();
    if (XB_T0(b)) {
        unsigned* bar = b.bar;
        __builtin_amdgcn_s_waitcnt(0);
        unsigned nloc = b.st[0], nx = b.st[1];
        if (nloc == 0u) { xcd_barrier_complete(bar, b.x, nloc, nx); b.st[0] = nloc; b.st[1] = nx; }
        const unsigned old = xb_add(&bar[XB_XSUB(b.x)], 1u);
        const unsigned gen = old / nloc;
        if (old + 1u == (gen + 1u) * nloc) {
            __builtin_amdgcn_fence(__ATOMIC_RELEASE, "agent");
            asm volatile("s_waitcnt vmcnt(0)" ::: "memory");
            const unsigned og = xb_add(&bar[XB_TOP], 1u);
            const unsigned tg = og / nx;
            if (og + 1u == (tg + 1u) * nx) xb_add(&bar[XB_TOPGEN], 1u);
            else XB_SPIN(xb_ld(&bar[XB_TOPGEN]) == tg, bar);
            __builtin_amdgcn_fence(__ATOMIC_ACQUIRE, "agent");
            xb_add(&bar[XB_XGEN(b.x)], 1u);
            asm volatile("s_waitcnt vmcnt(0)" ::: "memory");
        } else {
            XB_SPIN(xb_ld(&bar[XB_XGEN(b.x)]) == gen, bar);
            __builtin_amdgcn_fence(__ATOMIC_ACQUIRE, "agent");
            asm volatile("s_waitcnt vmcnt(0)" ::: "memory");
        }
    }
    __syncthreads();
}

namespace att {
using bf16 = __hip_bfloat16;
constexpr int   D = 128, NW = 8, QBLK = 32, KVBLK = 64;
constexpr float SCALE = 0.088388347648318440f;
constexpr float THR = 8.f;
constexpr int SDEPTH = 2;
constexpr int LDQ = 2048, LDK = 2048, LDO = 2048;
constexpr size_t SHM_V = KVBLK * D * 2, SHM_K = KVBLK * D * 2;
#define MASKALL(P0, P1) do { _Pragma("unroll") for (int r_ = 0; r_ < 16; ++r_) { P0[r_] = -INFINITY; P1[r_] = -INFINITY; } } while (0)
using bf16x8 = __attribute__((ext_vector_type(8))) short;
using s16x4  = __attribute__((ext_vector_type(4))) short;
using f32x16 = __attribute__((ext_vector_type(16))) float;
using f32x8  = __attribute__((ext_vector_type(8))) float;
using u32x4  = __attribute__((ext_vector_type(4))) unsigned;
#define KSWZ(row, colB) ((row) * 256 + ((colB) ^ (((row) & 7) << 4)))
#define SBAR() __builtin_amdgcn_sched_barrier(0)
__device__ __forceinline__ int crow(int r, int hi) { return (r & 3) + 8 * (r >> 2) + 4 * hi; }
__device__ __forceinline__ unsigned cvtpk(float lo, float hi) {
  unsigned r; asm volatile("v_cvt_pk_bf16_f32 %0, %1, %2" : "=v"(r) : "v"(lo), "v"(hi)); return r;
}
template <typename TIn> struct Stage;
template <> struct Stage<bf16>  { using T = bf16x8;
  __device__ static __forceinline__ T ld8(const bf16* p) { return *reinterpret_cast<const bf16x8*>(p); }
  __device__ static __forceinline__ bf16x8 tobf(T x) { return x; } };
template <> struct Stage<float> { using T = f32x8;
  __device__ static __forceinline__ T ld8(const float* p) { return *reinterpret_cast<const f32x8*>(p); }
  __device__ static __forceinline__ bf16x8 tobf(T x) {
    u32x4 w = {cvtpk(x[0], x[1]), cvtpk(x[2], x[3]), cvtpk(x[4], x[5]), cvtpk(x[6], x[7])}; return *reinterpret_cast<bf16x8*>(&w); } };

__device__ __forceinline__ void partialSM(f32x16& p0, f32x16& p1, float& m_reg, float& mn, float& alpha) {
  constexpr float C = SCALE * 1.4426950408889634f;
  float pmax = p0[0]; for (int r = 1; r < 16; ++r) pmax = fmaxf(pmax, p0[r]); for (int r = 0; r < 16; ++r) pmax = fmaxf(pmax, p1[r]);
  { auto rr = __builtin_amdgcn_permlane32_swap(__float_as_uint(pmax), __float_as_uint(pmax), false, false);
    pmax = fmaxf(__uint_as_float(rr[0]), __uint_as_float(rr[1])); }
  if (__builtin_expect(__all(pmax - m_reg <= THR / SCALE), 1)) { mn = m_reg; alpha = 1.f; }
  else { mn = fmaxf(m_reg, pmax); alpha = __builtin_amdgcn_exp2f((m_reg - mn) * C); m_reg = mn; }
  float mnC = -mn * C;
  for (int r = 0; r < 16; ++r) p0[r] = fmaf(p0[r], C, mnC); for (int r = 0; r < 16; ++r) p1[r] = fmaf(p1[r], C, mnC);
  for (int r = 0; r < 16; ++r) p0[r] = __builtin_amdgcn_exp2f(p0[r]);
}
__device__ __forceinline__ void finishSM(f32x16& p0, f32x16& p1, float alpha, float& l_reg, bf16x8& pa0, bf16x8& pa1, bf16x8& pa2, bf16x8& pa3) {
  for (int r = 0; r < 16; ++r) p1[r] = __builtin_amdgcn_exp2f(p1[r]);
  float ps = 0; for (int r = 0; r < 16; ++r) ps += p0[r]; for (int r = 0; r < 16; ++r) ps += p1[r];
  { auto rr = __builtin_amdgcn_permlane32_swap(__float_as_uint(ps), __float_as_uint(ps), false, false);
    ps = __uint_as_float(rr[0]) + __uint_as_float(rr[1]); }
  l_reg = l_reg * alpha + ps;
#define PK4(P, BASE, OUT) do { unsigned a0 = cvtpk(P[BASE + 0], P[BASE + 1]), a1 = cvtpk(P[BASE + 2], P[BASE + 3]);   \
    unsigned b0 = cvtpk(P[BASE + 4], P[BASE + 5]), b1 = cvtpk(P[BASE + 6], P[BASE + 7]);                              \
    auto r0 = __builtin_amdgcn_permlane32_swap(a0, b0, false, false); auto r1 = __builtin_amdgcn_permlane32_swap(a1, b1, false, false); \
    u32x4 w = {r0[0], r1[0], r0[1], r1[1]}; OUT = *reinterpret_cast<bf16x8*>(&w); } while (0)
  PK4(p0, 0, pa0); PK4(p0, 8, pa1); PK4(p1, 0, pa2); PK4(p1, 8, pa3);
#undef PK4
}
__device__ __forceinline__ void qkt(f32x16& p0, f32x16& p1, const bf16* Ks, const bf16x8* qr, int r32, int hi) {
  p0 = f32x16{}; p1 = f32x16{};
  for (int d0 = 0; d0 < 8; ++d0) { int cb = (d0 * 16 + hi * 8) * 2;
    bf16x8 b0 = *reinterpret_cast<const bf16x8*>((const char*)Ks + KSWZ(r32, cb));
    bf16x8 b1 = *reinterpret_cast<const bf16x8*>((const char*)Ks + KSWZ(32 + r32, cb));
    p0 = __builtin_amdgcn_mfma_f32_32x32x16_bf16(b0, qr[d0], p0, 0, 0, 0);
    p1 = __builtin_amdgcn_mfma_f32_32x32x16_bf16(b1, qr[d0], p1, 0, 0, 0); }
}
__device__ __forceinline__ int v_st(int k, int c) { const int kk = (k & ~0xC) | ((k & 4) << 1) | ((k & 8) >> 1); return ((kk >> 3) * 4 + (c >> 5)) * 512 + ((kk & 7) * 32 + (c & 31)) * 2; }
__device__ __forceinline__ int v_rd_base(int lane) { return ((lane & 3) << 3) | (((lane >> 2) & 3) << 6) | (((lane >> 4) & 1) << 5) | (((lane >> 5) & 1) << 8); }
constexpr int v_rd_off(int d0, int ks, int half) { return d0 * 512 + ks * 4096 + half * 2048; }
template <int OFF> __device__ __forceinline__ s16x4 tr_read(int vb) {
  s16x4 r; asm volatile("ds_read_b64_tr_b16 %0, %1 offset:%2" : "=&v"(r) : "v"(vb), "i"(OFF) : "memory"); return r;
}
template <int D0> __device__ __forceinline__ void pv_one(f32x16& od, int vb, bf16x8 pa0, bf16x8 pa1, bf16x8 pa2, bf16x8 pa3) {
  const s16x4 l0 = tr_read<v_rd_off(D0, 0, 0)>(vb), h0 = tr_read<v_rd_off(D0, 0, 1)>(vb), l1 = tr_read<v_rd_off(D0, 1, 0)>(vb), h1 = tr_read<v_rd_off(D0, 1, 1)>(vb);
  const s16x4 l2 = tr_read<v_rd_off(D0, 2, 0)>(vb), h2 = tr_read<v_rd_off(D0, 2, 1)>(vb), l3 = tr_read<v_rd_off(D0, 3, 0)>(vb), h3 = tr_read<v_rd_off(D0, 3, 1)>(vb);
  asm volatile("s_waitcnt lgkmcnt(0)" ::: "memory"); SBAR();
#define PK(L, H) (bf16x8){L[0], L[1], L[2], L[3], H[0], H[1], H[2], H[3]}
  od = __builtin_amdgcn_mfma_f32_32x32x16_bf16(pa0, PK(l0, h0), od, 0, 0, 0);
  od = __builtin_amdgcn_mfma_f32_32x32x16_bf16(pa1, PK(l1, h1), od, 0, 0, 0);
  od = __builtin_amdgcn_mfma_f32_32x32x16_bf16(pa2, PK(l2, h2), od, 0, 0, 0);
  od = __builtin_amdgcn_mfma_f32_32x32x16_bf16(pa3, PK(l3, h3), od, 0, 0, 0);
#undef PK
}
__device__ __forceinline__ void pv_d0(f32x16* o, int vb, bf16x8 pa0, bf16x8 pa1, bf16x8 pa2, bf16x8 pa3) {
  pv_one<0>(o[0], vb, pa0, pa1, pa2, pa3); pv_one<1>(o[1], vb, pa0, pa1, pa2, pa3); pv_one<2>(o[2], vb, pa0, pa1, pa2, pa3); pv_one<3>(o[3], vb, pa0, pa1, pa2, pa3);
}


template <int U> __device__ __forceinline__ void pvp_issue(int vb, s16x4& lo, s16x4& hi) {
  constexpr int b = U >> 2, s = U & 3; lo = tr_read<v_rd_off(b & 3, s, 0) + (b >> 2) * 16384>(vb); hi = tr_read<v_rd_off(b & 3, s, 1) + (b >> 2) * 16384>(vb); }
#define PVP_PK(L, H) (bf16x8){L[0], L[1], L[2], L[3], H[0], H[1], H[2], H[3]}
__device__ __forceinline__ void pv_pipe(f32x16* o, int vb, bf16x8 pa0, bf16x8 pa1, bf16x8 pa2, bf16x8 pa3) {
  s16x4 L0, H0, L1, H1, L2, H2, L3, H3, L4, H4, L5, H5;
  asm volatile("s_waitcnt lgkmcnt(0)" ::: "memory"); SBAR();
  pvp_issue<0>(vb, L0, H0); pvp_issue<1>(vb, L1, H1); pvp_issue<2>(vb, L2, H2); pvp_issue<3>(vb, L3, H3); pvp_issue<4>(vb, L4, H4);
  pvp_issue<5>(vb, L5, H5); asm volatile("s_waitcnt lgkmcnt(10)" ::: "memory"); SBAR(); o[0] = __builtin_amdgcn_mfma_f32_32x32x16_bf16(pa0, PVP_PK(L0, H0), o[0], 0, 0, 0);
  pvp_issue<6>(vb, L0, H0); asm volatile("s_waitcnt lgkmcnt(10)" ::: "memory"); SBAR(); o[0] = __builtin_amdgcn_mfma_f32_32x32x16_bf16(pa1, PVP_PK(L1, H1), o[0], 0, 0, 0);
  pvp_issue<7>(vb, L1, H1); asm volatile("s_waitcnt lgkmcnt(10)" ::: "memory"); SBAR(); o[0] = __builtin_amdgcn_mfma_f32_32x32x16_bf16(pa2, PVP_PK(L2, H2), o[0], 0, 0, 0);
  pvp_issue<8>(vb, L2, H2); asm volatile("s_waitcnt lgkmcnt(10)" ::: "memory"); SBAR(); o[0] = __builtin_amdgcn_mfma_f32_32x32x16_bf16(pa3, PVP_PK(L3, H3), o[0], 0, 0, 0);
  pvp_issue<9>(vb, L3, H3); asm volatile("s_waitcnt lgkmcnt(10)" ::: "memory"); SBAR(); o[1] = __builtin_amdgcn_mfma_f32_32x32x16_bf16(pa0, PVP_PK(L4, H4), o[1], 0, 0, 0);
  pvp_issue<10>(vb, L4, H4); asm volatile("s_waitcnt lgkmcnt(10)" ::: "memory"); SBAR(); o[1] = __builtin_amdgcn_mfma_f32_32x32x16_bf16(pa1, PVP_PK(L5, H5), o[1], 0, 0, 0);
  pvp_issue<11>(vb, L5, H5); asm volatile("s_waitcnt lgkmcnt(10)" ::: "memory"); SBAR(); o[1] = __builtin_amdgcn_mfma_f32_32x32x16_bf16(pa2, PVP_PK(L0, H0), o[1], 0, 0, 0);
  pvp_issue<12>(vb, L0, H0); asm volatile("s_waitcnt lgkmcnt(10)" ::: "memory"); SBAR(); o[1] = __builtin_amdgcn_mfma_f32_32x32x16_bf16(pa3, PVP_PK(L1, H1), o[1], 0, 0, 0);
  pvp_issue<13>(vb, L1, H1); asm volatile("s_waitcnt lgkmcnt(10)" ::: "memory"); SBAR(); o[2] = __builtin_amdgcn_mfma_f32_32x32x16_bf16(pa0, PVP_PK(L2, H2), o[2], 0, 0, 0);
  pvp_issue<14>(vb, L2, H2); asm volatile("s_waitcnt lgkmcnt(10)" ::: "memory"); SBAR(); o[2] = __builtin_amdgcn_mfma_f32_32x32x16_bf16(pa1, PVP_PK(L3, H3), o[2], 0, 0, 0);
  pvp_issue<15>(vb, L3, H3); asm volatile("s_waitcnt lgkmcnt(10)" ::: "memory"); SBAR(); o[2] = __builtin_amdgcn_mfma_f32_32x32x16_bf16(pa2, PVP_PK(L4, H4), o[2], 0, 0, 0);
  pvp_issue<16>(vb, L4, H4); asm volatile("s_waitcnt lgkmcnt(10)" ::: "memory"); SBAR(); o[2] = __builtin_amdgcn_mfma_f32_32x32x16_bf16(pa3, PVP_PK(L5, H5), o[2], 0, 0, 0);
  pvp_issue<17>(vb, L5, H5); asm volatile("s_waitcnt lgkmcnt(10)" ::: "memory"); SBAR(); o[3] = __builtin_amdgcn_mfma_f32_32x32x16_bf16(pa0, PVP_PK(L0, H0), o[3], 0, 0, 0);
  pvp_issue<18>(vb, L0, H0); asm volatile("s_waitcnt lgkmcnt(10)" ::: "memory"); SBAR(); o[3] = __builtin_amdgcn_mfma_f32_32x32x16_bf16(pa1, PVP_PK(L1, H1), o[3], 0, 0, 0);
  pvp_issue<19>(vb, L1, H1); asm volatile("s_waitcnt lgkmcnt(10)" ::: "memory"); SBAR(); o[3] = __builtin_amdgcn_mfma_f32_32x32x16_bf16(pa2, PVP_PK(L2, H2), o[3], 0, 0, 0);
  pvp_issue<20>(vb, L2, H2); asm volatile("s_waitcnt lgkmcnt(10)" ::: "memory"); SBAR(); o[3] = __builtin_amdgcn_mfma_f32_32x32x16_bf16(pa3, PVP_PK(L3, H3), o[3], 0, 0, 0);
  pvp_issue<21>(vb, L3, H3); asm volatile("s_waitcnt lgkmcnt(10)" ::: "memory"); SBAR(); o[4] = __builtin_amdgcn_mfma_f32_32x32x16_bf16(pa0, PVP_PK(L4, H4), o[4], 0, 0, 0);
  pvp_issue<22>(vb, L4, H4); asm volatile("s_waitcnt lgkmcnt(10)" ::: "memory"); SBAR(); o[4] = __builtin_amdgcn_mfma_f32_32x32x16_bf16(pa1, PVP_PK(L5, H5), o[4], 0, 0, 0);
  pvp_issue<23>(vb, L5, H5); asm volatile("s_waitcnt lgkmcnt(10)" ::: "memory"); SBAR(); o[4] = __builtin_amdgcn_mfma_f32_32x32x16_bf16(pa2, PVP_PK(L0, H0), o[4], 0, 0, 0);
  pvp_issue<24>(vb, L0, H0); asm volatile("s_waitcnt lgkmcnt(10)" ::: "memory"); SBAR(); o[4] = __builtin_amdgcn_mfma_f32_32x32x16_bf16(pa3, PVP_PK(L1, H1), o[4], 0, 0, 0);
  pvp_issue<25>(vb, L1, H1); asm volatile("s_waitcnt lgkmcnt(10)" ::: "memory"); SBAR(); o[5] = __builtin_amdgcn_mfma_f32_32x32x16_bf16(pa0, PVP_PK(L2, H2), o[5], 0, 0, 0);
  pvp_issue<26>(vb, L2, H2); asm volatile("s_waitcnt lgkmcnt(10)" ::: "memory"); SBAR(); o[5] = __builtin_amdgcn_mfma_f32_32x32x16_bf16(pa1, PVP_PK(L3, H3), o[5], 0, 0, 0);
  pvp_issue<27>(vb, L3, H3); asm volatile("s_waitcnt lgkmcnt(10)" ::: "memory"); SBAR(); o[5] = __builtin_amdgcn_mfma_f32_32x32x16_bf16(pa2, PVP_PK(L4, H4), o[5], 0, 0, 0);
  pvp_issue<28>(vb, L4, H4); asm volatile("s_waitcnt lgkmcnt(10)" ::: "memory"); SBAR(); o[5] = __builtin_amdgcn_mfma_f32_32x32x16_bf16(pa3, PVP_PK(L5, H5), o[5], 0, 0, 0);
  pvp_issue<29>(vb, L5, H5); asm volatile("s_waitcnt lgkmcnt(10)" ::: "memory"); SBAR(); o[6] = __builtin_amdgcn_mfma_f32_32x32x16_bf16(pa0, PVP_PK(L0, H0), o[6], 0, 0, 0);
  pvp_issue<30>(vb, L0, H0); asm volatile("s_waitcnt lgkmcnt(10)" ::: "memory"); SBAR(); o[6] = __builtin_amdgcn_mfma_f32_32x32x16_bf16(pa1, PVP_PK(L1, H1), o[6], 0, 0, 0);
  pvp_issue<31>(vb, L1, H1); asm volatile("s_waitcnt lgkmcnt(10)" ::: "memory"); SBAR(); o[6] = __builtin_amdgcn_mfma_f32_32x32x16_bf16(pa2, PVP_PK(L2, H2), o[6], 0, 0, 0);
  asm volatile("s_waitcnt lgkmcnt(8)" ::: "memory"); SBAR(); o[6] = __builtin_amdgcn_mfma_f32_32x32x16_bf16(pa3, PVP_PK(L3, H3), o[6], 0, 0, 0);
  asm volatile("s_waitcnt lgkmcnt(6)" ::: "memory"); SBAR(); o[7] = __builtin_amdgcn_mfma_f32_32x32x16_bf16(pa0, PVP_PK(L4, H4), o[7], 0, 0, 0);
  asm volatile("s_waitcnt lgkmcnt(4)" ::: "memory"); SBAR(); o[7] = __builtin_amdgcn_mfma_f32_32x32x16_bf16(pa1, PVP_PK(L5, H5), o[7], 0, 0, 0);
  asm volatile("s_waitcnt lgkmcnt(2)" ::: "memory"); SBAR(); o[7] = __builtin_amdgcn_mfma_f32_32x32x16_bf16(pa2, PVP_PK(L0, H0), o[7], 0, 0, 0);
  asm volatile("s_waitcnt lgkmcnt(0)" ::: "memory"); SBAR(); o[7] = __builtin_amdgcn_mfma_f32_32x32x16_bf16(pa3, PVP_PK(L1, H1), o[7], 0, 0, 0);
}

__device__ __forceinline__ void pv_pipe4(f32x16* o, int vb, bf16x8 pa0, bf16x8 pa1, bf16x8 pa2, bf16x8 pa3) {
  s16x4 L0, H0, L1, H1, L2, H2, L3, H3;
  asm volatile("s_waitcnt lgkmcnt(0)" ::: "memory"); SBAR();
  pvp_issue<0>(vb, L0, H0); pvp_issue<1>(vb, L1, H1); pvp_issue<2>(vb, L2, H2);
  pvp_issue<3>(vb, L3, H3); asm volatile("s_waitcnt lgkmcnt(6)" ::: "memory"); SBAR(); o[0] = __builtin_amdgcn_mfma_f32_32x32x16_bf16(pa0, PVP_PK(L0, H0), o[0], 0, 0, 0);
  pvp_issue<4>(vb, L0, H0); asm volatile("s_waitcnt lgkmcnt(6)" ::: "memory"); SBAR(); o[0] = __builtin_amdgcn_mfma_f32_32x32x16_bf16(pa1, PVP_PK(L1, H1), o[0], 0, 0, 0);
  pvp_issue<5>(vb, L1, H1); asm volatile("s_waitcnt lgkmcnt(6)" ::: "memory"); SBAR(); o[0] = __builtin_amdgcn_mfma_f32_32x32x16_bf16(pa2, PVP_PK(L2, H2), o[0], 0, 0, 0);
  pvp_issue<6>(vb, L2, H2); asm volatile("s_waitcnt lgkmcnt(6)" ::: "memory"); SBAR(); o[0] = __builtin_amdgcn_mfma_f32_32x32x16_bf16(pa3, PVP_PK(L3, H3), o[0], 0, 0, 0);
  pvp_issue<7>(vb, L3, H3); asm volatile("s_waitcnt lgkmcnt(6)" ::: "memory"); SBAR(); o[1] = __builtin_amdgcn_mfma_f32_32x32x16_bf16(pa0, PVP_PK(L0, H0), o[1], 0, 0, 0);
  pvp_issue<8>(vb, L0, H0); asm volatile("s_waitcnt lgkmcnt(6)" ::: "memory"); SBAR(); o[1] = __builtin_amdgcn_mfma_f32_32x32x16_bf16(pa1, PVP_PK(L1, H1), o[1], 0, 0, 0);
  pvp_issue<9>(vb, L1, H1); asm volatile("s_waitcnt lgkmcnt(6)" ::: "memory"); SBAR(); o[1] = __builtin_amdgcn_mfma_f32_32x32x16_bf16(pa2, PVP_PK(L2, H2), o[1], 0, 0, 0);
  pvp_issue<10>(vb, L2, H2); asm volatile("s_waitcnt lgkmcnt(6)" ::: "memory"); SBAR(); o[1] = __builtin_amdgcn_mfma_f32_32x32x16_bf16(pa3, PVP_PK(L3, H3), o[1], 0, 0, 0);
  pvp_issue<11>(vb, L3, H3); asm volatile("s_waitcnt lgkmcnt(6)" ::: "memory"); SBAR(); o[2] = __builtin_amdgcn_mfma_f32_32x32x16_bf16(pa0, PVP_PK(L0, H0), o[2], 0, 0, 0);
  pvp_issue<12>(vb, L0, H0); asm volatile("s_waitcnt lgkmcnt(6)" ::: "memory"); SBAR(); o[2] = __builtin_amdgcn_mfma_f32_32x32x16_bf16(pa1, PVP_PK(L1, H1), o[2], 0, 0, 0);
  pvp_issue<13>(vb, L1, H1); asm volatile("s_waitcnt lgkmcnt(6)" ::: "memory"); SBAR(); o[2] = __builtin_amdgcn_mfma_f32_32x32x16_bf16(pa2, PVP_PK(L2, H2), o[2], 0, 0, 0);
  pvp_issue<14>(vb, L2, H2); asm volatile("s_waitcnt lgkmcnt(6)" ::: "memory"); SBAR(); o[2] = __builtin_amdgcn_mfma_f32_32x32x16_bf16(pa3, PVP_PK(L3, H3), o[2], 0, 0, 0);
  pvp_issue<15>(vb, L3, H3); asm volatile("s_waitcnt lgkmcnt(6)" ::: "memory"); SBAR(); o[3] = __builtin_amdgcn_mfma_f32_32x32x16_bf16(pa0, PVP_PK(L0, H0), o[3], 0, 0, 0);
  asm volatile("s_waitcnt lgkmcnt(4)" ::: "memory"); SBAR(); o[3] = __builtin_amdgcn_mfma_f32_32x32x16_bf16(pa1, PVP_PK(L1, H1), o[3], 0, 0, 0);
  asm volatile("s_waitcnt lgkmcnt(2)" ::: "memory"); SBAR(); o[3] = __builtin_amdgcn_mfma_f32_32x32x16_bf16(pa2, PVP_PK(L2, H2), o[3], 0, 0, 0);
  asm volatile("s_waitcnt lgkmcnt(0)" ::: "memory"); SBAR(); o[3] = __builtin_amdgcn_mfma_f32_32x32x16_bf16(pa3, PVP_PK(L3, H3), o[3], 0, 0, 0);
}

template <int OFF> __device__ __forceinline__ bf16x8 k_read(int a) { bf16x8 r; asm volatile("ds_read_b128 %0, %1 offset:%2" : "=&v"(r) : "v"(a), "i"(OFF) : "memory"); return r; }
__device__ __forceinline__ void qk_pipe(f32x16& p0, f32x16& p1, const int kb  , const bf16x8* qr, const int r32, const int hi) {
  const int rb = kb + r32 * 256, c0 = (hi << 4) ^ ((r32 & 7) << 4);
  bf16x8 K0, K1, K2, K3;
  p0 = f32x16{}; p1 = f32x16{};
  asm volatile("s_waitcnt lgkmcnt(0)" ::: "memory"); SBAR();
  K0 = k_read<0>(rb + ((0 << 5) ^ c0)); K1 = k_read<8192>(rb + ((0 << 5) ^ c0)); K2 = k_read<0>(rb + ((1 << 5) ^ c0));
  K3 = k_read<8192>(rb + ((1 << 5) ^ c0)); asm volatile("s_waitcnt lgkmcnt(3)" ::: "memory"); SBAR(); p0 = __builtin_amdgcn_mfma_f32_32x32x16_bf16(K0, qr[0], p0, 0, 0, 0);
  K0 = k_read<0>(rb + ((2 << 5) ^ c0)); asm volatile("s_waitcnt lgkmcnt(3)" ::: "memory"); SBAR(); p1 = __builtin_amdgcn_mfma_f32_32x32x16_bf16(K1, qr[0], p1, 0, 0, 0);
  K1 = k_read<8192>(rb + ((2 << 5) ^ c0)); asm volatile("s_waitcnt lgkmcnt(3)" ::: "memory"); SBAR(); p0 = __builtin_amdgcn_mfma_f32_32x32x16_bf16(K2, qr[1], p0, 0, 0, 0);
  K2 = k_read<0>(rb + ((3 << 5) ^ c0)); asm volatile("s_waitcnt lgkmcnt(3)" ::: "memory"); SBAR(); p1 = __builtin_amdgcn_mfma_f32_32x32x16_bf16(K3, qr[1], p1, 0, 0, 0);
  K3 = k_read<8192>(rb + ((3 << 5) ^ c0)); asm volatile("s_waitcnt lgkmcnt(3)" ::: "memory"); SBAR(); p0 = __builtin_amdgcn_mfma_f32_32x32x16_bf16(K0, qr[2], p0, 0, 0, 0);
  K0 = k_read<0>(rb + ((4 << 5) ^ c0)); asm volatile("s_waitcnt lgkmcnt(3)" ::: "memory"); SBAR(); p1 = __builtin_amdgcn_mfma_f32_32x32x16_bf16(K1, qr[2], p1, 0, 0, 0);
  K1 = k_read<8192>(rb + ((4 << 5) ^ c0)); asm volatile("s_waitcnt lgkmcnt(3)" ::: "memory"); SBAR(); p0 = __builtin_amdgcn_mfma_f32_32x32x16_bf16(K2, qr[3], p0, 0, 0, 0);
  K2 = k_read<0>(rb + ((5 << 5) ^ c0)); asm volatile("s_waitcnt lgkmcnt(3)" ::: "memory"); SBAR(); p1 = __builtin_amdgcn_mfma_f32_32x32x16_bf16(K3, qr[3], p1, 0, 0, 0);
  K3 = k_read<8192>(rb + ((5 << 5) ^ c0)); asm volatile("s_waitcnt lgkmcnt(3)" ::: "memory"); SBAR(); p0 = __builtin_amdgcn_mfma_f32_32x32x16_bf16(K0, qr[4], p0, 0, 0, 0);
  K0 = k_read<0>(rb + ((6 << 5) ^ c0)); asm volatile("s_waitcnt lgkmcnt(3)" ::: "memory"); SBAR(); p1 = __builtin_amdgcn_mfma_f32_32x32x16_bf16(K1, qr[4], p1, 0, 0, 0);
  K1 = k_read<8192>(rb + ((6 << 5) ^ c0)); asm volatile("s_waitcnt lgkmcnt(3)" ::: "memory"); SBAR(); p0 = __builtin_amdgcn_mfma_f32_32x32x16_bf16(K2, qr[5], p0, 0, 0, 0);
  K2 = k_read<0>(rb + ((7 << 5) ^ c0)); asm volatile("s_waitcnt lgkmcnt(3)" ::: "memory"); SBAR(); p1 = __builtin_amdgcn_mfma_f32_32x32x16_bf16(K3, qr[5], p1, 0, 0, 0);
  K3 = k_read<8192>(rb + ((7 << 5) ^ c0)); asm volatile("s_waitcnt lgkmcnt(3)" ::: "memory"); SBAR(); p0 = __builtin_amdgcn_mfma_f32_32x32x16_bf16(K0, qr[6], p0, 0, 0, 0);
  asm volatile("s_waitcnt lgkmcnt(2)" ::: "memory"); SBAR(); p1 = __builtin_amdgcn_mfma_f32_32x32x16_bf16(K1, qr[6], p1, 0, 0, 0);
  asm volatile("s_waitcnt lgkmcnt(1)" ::: "memory"); SBAR(); p0 = __builtin_amdgcn_mfma_f32_32x32x16_bf16(K2, qr[7], p0, 0, 0, 0);
  asm volatile("s_waitcnt lgkmcnt(0)" ::: "memory"); SBAR(); p1 = __builtin_amdgcn_mfma_f32_32x32x16_bf16(K3, qr[7], p1, 0, 0, 0);
}
__device__ __forceinline__ void qk_pipe_lq(f32x16& p0, f32x16& p1, const int kb, const int qa  , const int r32, const int hi) {
  const int rb = kb + r32 * 256, c0 = (hi << 4) ^ ((r32 & 7) << 4);
  bf16x8 QA, KA0, KA1, QB, KB0, KB1;
  p0 = f32x16{}; p1 = f32x16{};
  asm volatile("s_waitcnt lgkmcnt(0)" ::: "memory"); SBAR();
  QA = k_read<0>(qa); KA0 = k_read<0>(rb + ((0 << 5) ^ c0)); KA1 = k_read<8192>(rb + ((0 << 5) ^ c0)); QB = k_read<1024>(qa); KB0 = k_read<0>(rb + ((1 << 5) ^ c0)); KB1 = k_read<8192>(rb + ((1 << 5) ^ c0));
  asm volatile("s_waitcnt lgkmcnt(3)" ::: "memory"); SBAR(); p0 = __builtin_amdgcn_mfma_f32_32x32x16_bf16(KA0, QA, p0, 0, 0, 0); p1 = __builtin_amdgcn_mfma_f32_32x32x16_bf16(KA1, QA, p1, 0, 0, 0); SBAR(); QA = k_read<2048>(qa); KA0 = k_read<0>(rb + ((2 << 5) ^ c0)); KA1 = k_read<8192>(rb + ((2 << 5) ^ c0));
  asm volatile("s_waitcnt lgkmcnt(3)" ::: "memory"); SBAR(); p0 = __builtin_amdgcn_mfma_f32_32x32x16_bf16(KB0, QB, p0, 0, 0, 0); p1 = __builtin_amdgcn_mfma_f32_32x32x16_bf16(KB1, QB, p1, 0, 0, 0); SBAR(); QB = k_read<3072>(qa); KB0 = k_read<0>(rb + ((3 << 5) ^ c0)); KB1 = k_read<8192>(rb + ((3 << 5) ^ c0));
  asm volatile("s_waitcnt lgkmcnt(3)" ::: "memory"); SBAR(); p0 = __builtin_amdgcn_mfma_f32_32x32x16_bf16(KA0, QA, p0, 0, 0, 0); p1 = __builtin_amdgcn_mfma_f32_32x32x16_bf16(KA1, QA, p1, 0, 0, 0); SBAR(); QA = k_read<4096>(qa); KA0 = k_read<0>(rb + ((4 << 5) ^ c0)); KA1 = k_read<8192>(rb + ((4 << 5) ^ c0));
  asm volatile("s_waitcnt lgkmcnt(3)" ::: "memory"); SBAR(); p0 = __builtin_amdgcn_mfma_f32_32x32x16_bf16(KB0, QB, p0, 0, 0, 0); p1 = __builtin_amdgcn_mfma_f32_32x32x16_bf16(KB1, QB, p1, 0, 0, 0); SBAR(); QB = k_read<5120>(qa); KB0 = k_read<0>(rb + ((5 << 5) ^ c0)); KB1 = k_read<8192>(rb + ((5 << 5) ^ c0));
  asm volatile("s_waitcnt lgkmcnt(3)" ::: "memory"); SBAR(); p0 = __builtin_amdgcn_mfma_f32_32x32x16_bf16(KA0, QA, p0, 0, 0, 0); p1 = __builtin_amdgcn_mfma_f32_32x32x16_bf16(KA1, QA, p1, 0, 0, 0); SBAR(); QA = k_read<6144>(qa); KA0 = k_read<0>(rb + ((6 << 5) ^ c0)); KA1 = k_read<8192>(rb + ((6 << 5) ^ c0));
  asm volatile("s_waitcnt lgkmcnt(3)" ::: "memory"); SBAR(); p0 = __builtin_amdgcn_mfma_f32_32x32x16_bf16(KB0, QB, p0, 0, 0, 0); p1 = __builtin_amdgcn_mfma_f32_32x32x16_bf16(KB1, QB, p1, 0, 0, 0); SBAR(); QB = k_read<7168>(qa); KB0 = k_read<0>(rb + ((7 << 5) ^ c0)); KB1 = k_read<8192>(rb + ((7 << 5) ^ c0));
  asm volatile("s_waitcnt lgkmcnt(3)" ::: "memory"); SBAR(); p0 = __builtin_amdgcn_mfma_f32_32x32x16_bf16(KA0, QA, p0, 0, 0, 0); p1 = __builtin_amdgcn_mfma_f32_32x32x16_bf16(KA1, QA, p1, 0, 0, 0);
  asm volatile("s_waitcnt lgkmcnt(0)" ::: "memory"); SBAR(); p0 = __builtin_amdgcn_mfma_f32_32x32x16_bf16(KB0, QB, p0, 0, 0, 0); p1 = __builtin_amdgcn_mfma_f32_32x32x16_bf16(KB1, QB, p1, 0, 0, 0);
}

constexpr size_t SBUF = 65536;
template <int SV = 0>
__device__ __forceinline__ void attn_sample_unit(const bf16* __restrict__ QN, const bf16* __restrict__ KN, const bf16* __restrict__ VBn,
                                                 const float* __restrict__ ck, const float* __restrict__ cv, float* __restrict__ OA0, float* __restrict__ OA1,
                                                 const int b, const int h, char* lds, const int wv) {
  int tid_ = wv * 64 + lane_id(); asm volatile("" : "+v"(tid_));
  const int tid = tid_, wid = tid >> 6, lane = tid & 63, r32 = lane & 31, hi = lane >> 5;
  const int c = wid & 1, e = (wid >> 1) & 1, th = wid >> 2;
  float* wsf = (float*)(lds + 2 * SBUF) + wid * 64; float* li_l = wsf; float* al_l = wsf + 32;
  float m_reg = -1e30f, l_reg = 0; f32x16 o[4] = {};
  const long qrow = (long)MP + 64 * b + 32 * th + r32;
  const bf16* Qw = QN + qrow * 2048 + h * 256 + c * 128 + hi * 8;
  char* qlds = lds + SBUF + wid * 8192 + lane * 16;
#pragma unroll
  for (int d0 = 0; d0 < 8; ++d0) *reinterpret_cast<bf16x8*>(qlds + d0 * 1024) = *reinterpret_cast<const bf16x8*>(Qw + d0 * 16);
  const int kb0 = (int)(uintptr_t)lds + c * 16384, qa0 = (int)(uintptr_t)qlds;
  const int vb0 = (int)(uintptr_t)lds + 2 * 16384 + e * 16384 + v_rd_base(lane);
  f32x8 skA[4], skB[4], sv[4];
  const float* ckb = ck + ((long)b * PAST * 8 + h) * 256;
  const float* cvb = cv + ((long)b * PAST * 8 + h) * 256;
#define SS_TID int ts_ = wv * 64 + lane_id(); asm volatile("" : "+v"(ts_))
#define SS_LOADK(sk, k0) do { SS_TID; _Pragma("unroll") for (int i = 0; i < 4; ++i) { const int n = ts_ + 512 * i; \
      sk[i] = *reinterpret_cast<const f32x8*>(ckb + (unsigned)(((k0) + ((n >> 4) & 63)) * 2048 + (n >> 10) * 128 + (n & 15) * 8)); } } while (0)
#define SS_LOADV(k0) do { SS_TID; _Pragma("unroll") for (int i = 0; i < 4; ++i) { const int n = ts_ + 512 * i; \
      sv[i] = *reinterpret_cast<const f32x8*>(cvb + (unsigned)(((k0) + (n >> 5)) * 2048 + (n & 31) * 8)); } } while (0)
#define SS_WRITEK(sk, bufp) do { SS_TID; _Pragma("unroll") for (int i = 0; i < 4; ++i) { const int n = ts_ + 512 * i; \
      *(bf16x8*)((bufp) + (n >> 10) * 16384 + KSWZ((n >> 4) & 63, (n & 15) * 16)) = Stage<float>::tobf(sk[i]); } } while (0)
#define SS_WRITEV(bufp) do { SS_TID; _Pragma("unroll") for (int i = 0; i < 4; ++i) { const int n = ts_ + 512 * i; \
      *(bf16x8*)((bufp) + 32768 + ((n & 31) >> 4) * 16384 + v_st(n >> 5, (n & 15) * 8)) = Stage<float>::tobf(sv[i]); } } while (0)
#define SS_BAR() do { asm volatile("s_waitcnt lgkmcnt(0)" ::: "memory"); __builtin_amdgcn_s_barrier(); asm volatile("" ::: "memory"); } while (0)
#define SS_RESC(a) do { if (__any((a) < 1.f)) { if (hi == 0) al_l[r32] = (a); asm volatile("s_waitcnt lgkmcnt(0)" ::: "memory"); \
    for (int d = 0; d < 4; ++d) for (int r = 0; r < 16; ++r) o[d][r] *= al_l[crow(r, hi)]; } } while (0)
#define SS_QK(bufp) do { qk_pipe_lq(p0, p1, kb0, qa0, r32, hi); \
      partialSM(p0, p1, m_reg, mn, al); SS_RESC(al); finishSM(p0, p1, al, l_reg, pa0, pa1, pa2, pa3); } while (0)
#define SS_PV(vbase) do { pv_pipe4(o, (vbase), pa0, pa1, pa2, pa3); } while (0)
  constexpr int NTC = PAST / 64;
  SS_LOADK(skA, 0); SS_LOADV(0); SS_LOADK(skB, 64);
#define LD_ON (SV != 2)
#define CP_ON (SV != 1)
  for (int j = 0; j < NTC; j += 2) {
    {
      f32x16 p0, p1; float mn, al; bf16x8 pa0, pa1, pa2, pa3;
      SS_WRITEK(skA, lds); SS_BAR();
      if (LD_ON && j + 2 < NTC) SS_LOADK(skA, (j + 2) * 64);
      if (CP_ON) SS_QK(lds);
      SS_WRITEV(lds); SS_BAR();
      if (LD_ON) SS_LOADV((j + 1) * 64);
      if (CP_ON) SS_PV(vb0);
    }
    {
      f32x16 p0, p1; float mn, al; bf16x8 pa0, pa1, pa2, pa3;
      SS_WRITEK(skB, lds); SS_BAR();
      if (LD_ON && j + 3 < NTC) SS_LOADK(skB, (j + 3) * 64);
      if (CP_ON) SS_QK(lds);
      SS_WRITEV(lds); SS_BAR();
      if (LD_ON && j + 2 < NTC) SS_LOADV((j + 2) * 64);
      if (CP_ON) SS_PV(vb0);
    }
  }
  {
    bf16x8 nk[4], nv[4];
    const long nrow0 = (long)MP + 64 * b;
#pragma unroll
    for (int i = 0; i < 4; ++i) { const int n = tid + 512 * i;
      nk[i] = *reinterpret_cast<const bf16x8*>(KN + (nrow0 + ((n >> 4) & 63)) * 2048 + h * 256 + (n >> 10) * 128 + (n & 15) * 8);
      nv[i] = *reinterpret_cast<const bf16x8*>(VBn + (nrow0 + (n >> 5)) * 2048 + h * 256 + (n & 31) * 8); }
    __syncthreads();
#pragma unroll
    for (int i = 0; i < 4; ++i) { const int n = tid + 512 * i;
      *(bf16x8*)(lds + (n >> 10) * 16384 + KSWZ((n >> 4) & 63, (n & 15) * 16)) = nk[i];
      *(bf16x8*)(lds + 32768 + ((n & 31) >> 4) * 16384 + v_st(n >> 5, (n & 15) * 8)) = nv[i]; }
    __syncthreads();
    f32x16 p0, p1; float mn, al; bf16x8 pa0, pa1, pa2, pa3;
    SS_QK(lds); SS_PV(vb0);
  }
  if (hi == 0) li_l[r32] = l_reg; asm volatile("s_waitcnt lgkmcnt(0)" ::: "memory");
  float rli[16];
#pragma unroll
  for (int r = 0; r < 16; ++r) rli[r] = __builtin_amdgcn_rcpf(li_l[crow(r, hi)]);
  float* Ow = (c ? OA1 : OA0) + ((long)MP + 64 * b + 32 * th) * 2048 + h * 256 + e * 128;
#pragma unroll
  for (int r = 0; r < 16; ++r) { const int orow = crow(r, hi);
    for (int d0 = 0; d0 < 4; ++d0) Ow[(long)orow * 2048 + d0 * 32 + r32] = o[d0][r] * rli[r]; }
  __syncthreads();
#undef LD_ON
#undef CP_ON
#undef SS_TID
#undef SS_LOADK
#undef SS_LOADV
#undef SS_WRITEK
#undef SS_WRITEV
#undef SS_BAR
#undef SS_RESC
#undef SS_QK
#undef SS_PV
}


__device__ __forceinline__ void qk_half(f32x16& p, const char* Ks, const int half, const bf16x8* qr, int r32, int hi) {
  p = f32x16{};
#pragma unroll
  for (int d0 = 0; d0 < 8; ++d0) { const int cb = (d0 * 16 + hi * 8) * 2;
    const bf16x8 b = *reinterpret_cast<const bf16x8*>(Ks + KSWZ(32 * half + r32, cb));
    p = __builtin_amdgcn_mfma_f32_32x32x16_bf16(b, qr[d0], p, 0, 0, 0); }
}
__device__ __forceinline__ void sm_half(f32x16& p, float& m_reg, float& l_reg, float& alpha, bf16x8& paX, bf16x8& paY, const bool msk) {
  constexpr float C = SCALE * 1.4426950408889634f;
  float pmax = p[0]; for (int r = 1; r < 16; ++r) pmax = fmaxf(pmax, p[r]);
  { auto rr = __builtin_amdgcn_permlane32_swap(__float_as_uint(pmax), __float_as_uint(pmax), false, false); pmax = fmaxf(__uint_as_float(rr[0]), __uint_as_float(rr[1])); }
  if (msk) pmax = -INFINITY;
  float mn;
  if (__builtin_expect(__all(pmax - m_reg <= THR / SCALE), 1)) { mn = m_reg; alpha = 1.f; }
  else { mn = fmaxf(m_reg, pmax); alpha = __builtin_amdgcn_exp2f((m_reg - mn) * C); m_reg = mn; }
  const float mnC = msk ? -INFINITY : -mn * C;
  for (int r = 0; r < 16; ++r) p[r] = __builtin_amdgcn_exp2f(fmaf(p[r], C, mnC));
  float ps = 0; for (int r = 0; r < 16; ++r) ps += p[r];
  { auto rr = __builtin_amdgcn_permlane32_swap(__float_as_uint(ps), __float_as_uint(ps), false, false); ps = __uint_as_float(rr[0]) + __uint_as_float(rr[1]); }
  l_reg = l_reg * alpha + ps;
#define PK4H(P, BASE, OUT) do { unsigned a0 = cvtpk(P[BASE + 0], P[BASE + 1]), a1 = cvtpk(P[BASE + 2], P[BASE + 3]);   \
    unsigned b0 = cvtpk(P[BASE + 4], P[BASE + 5]), b1 = cvtpk(P[BASE + 6], P[BASE + 7]);                              \
    auto r0 = __builtin_amdgcn_permlane32_swap(a0, b0, false, false); auto r1 = __builtin_amdgcn_permlane32_swap(a1, b1, false, false); \
    u32x4 w = {r0[0], r1[0], r0[1], r1[1]}; OUT = *reinterpret_cast<bf16x8*>(&w); } while (0)
  PK4H(p, 0, paX); PK4H(p, 8, paY);
#undef PK4H
}
template <int D0, int H> __device__ __forceinline__ void pv_half_one(f32x16& od, int vb, bf16x8 paX, bf16x8 paY) {
  const s16x4 l0 = tr_read<v_rd_off(D0, 2 * H, 0)>(vb), h0 = tr_read<v_rd_off(D0, 2 * H, 1)>(vb), l1 = tr_read<v_rd_off(D0, 2 * H + 1, 0)>(vb), h1 = tr_read<v_rd_off(D0, 2 * H + 1, 1)>(vb);
  asm volatile("s_waitcnt lgkmcnt(0)" ::: "memory"); SBAR();
#define PKH(L, Hh) (bf16x8){L[0], L[1], L[2], L[3], Hh[0], Hh[1], Hh[2], Hh[3]}
  od = __builtin_amdgcn_mfma_f32_32x32x16_bf16(paX, PKH(l0, h0), od, 0, 0, 0);
  od = __builtin_amdgcn_mfma_f32_32x32x16_bf16(paY, PKH(l1, h1), od, 0, 0, 0);
#undef PKH
}
template <int H> __device__ __forceinline__ void pv_half(f32x16* o, int vb, bf16x8 paX, bf16x8 paY) {
  pv_half_one<0, H>(o[0], vb, paX, paY); pv_half_one<1, H>(o[1], vb, paX, paY); pv_half_one<2, H>(o[2], vb, paX, paY); pv_half_one<3, H>(o[3], vb, paX, paY);
  pv_half_one<0, H>(o[4], vb + 16384, paX, paY); pv_half_one<1, H>(o[5], vb + 16384, paX, paY); pv_half_one<2, H>(o[6], vb + 16384, paX, paY); pv_half_one<3, H>(o[7], vb + 16384, paX, paY);
}

constexpr size_t WBUF = 49152;
template <int VAR>
__device__ __forceinline__ void attn_wide_body(const bf16* __restrict__ Qb, const bf16* __restrict__ Kh, const bf16* __restrict__ Vh, float* __restrict__ Ob, const int NT, const int wlast, char* lds, const int wv) {
  int tid_ = wv * 64 + lane_id(); asm volatile("" : "+v"(tid_));
  const int tid = tid_, wid = tid >> 6, lane = tid & 63, r32 = lane & 31, hi = lane >> 5;
  float* wsf = (float*)(lds + 2 * WBUF) + wid * 64; float* li_l = wsf; float* al_l = wsf + 32;
  float m_reg = -1e30f, l_reg = 0; f32x16 o[8] = {}; bf16x8 qr[8];
  const bf16* Qw = Qb + (long)(wid * QBLK + r32) * 2048 + hi * 8;
#pragma unroll
  for (int d0 = 0; d0 < 8; ++d0) qr[d0] = *reinterpret_cast<const bf16x8*>(Qw + d0 * 16);
  unsigned doff[6];
  { int t2_ = lane_id(); asm volatile("" : "+v"(t2_));
#pragma unroll
    for (int i_ = 0; i_ < 6; ++i_) { const int I_ = i_ * 8 + wv, img_ = I_ >> 4, P_ = (I_ & 15) * 64 + t2_;
      if (img_ == 0) { const int row_ = P_ >> 4, sl_ = P_ & 15; doff[i_] = (unsigned)(row_ * 2048 + ((sl_ ^ (row_ & 7)) << 3)); }
      else { const int st_ = P_ >> 5, q_ = P_ & 31, kk_ = ((st_ >> 2) << 3) + (q_ >> 2), k_ = (kk_ & ~0xC) | ((kk_ & 4) << 1) | ((kk_ & 8) >> 1);
             doff[i_] = (unsigned)(k_ * 2048 + (img_ - 1) * 128 + (st_ & 3) * 32 + (q_ & 3) * 8); } } }
#define W_DMA(k0, bufp) do { const bf16* kt_ = Kh + (size_t)(k0) * 2048; const bf16* vt_ = Vh + (size_t)(k0) * 2048; _Pragma("unroll") for (int i_ = 0; i_ < 6; ++i_) { const int I_ = i_ * 8 + wv; \
      __builtin_amdgcn_global_load_lds((const unsigned*)((i_ < 2 ? kt_ : vt_) + doff[i_]), (LAS unsigned*)((bufp) + I_ * 1024), 16, 0, 0); } } while (0)
#define W_RESC(a) do { if (__any((a) < 1.f)) { if (hi == 0) al_l[r32] = (a); asm volatile("s_waitcnt lgkmcnt(0)" ::: "memory"); \
    for (int d = 0; d < 8; ++d) for (int r = 0; r < 16; ++r) o[d][r] *= al_l[crow(r, hi)]; } } while (0)
  W_DMA(0, lds); if (1 < NT) W_DMA(KVBLK, lds + WBUF);
  asm volatile("s_waitcnt vmcnt(0)" ::: "memory"); __syncthreads();
  for (int j = 0; j < NT; ++j) {
    char* bp = lds + (j & 1) * WBUF;
    f32x16 p0, p1; float mn, al; bf16x8 pa0, pa1, pa2, pa3;
    if constexpr (VAR == 3) { p0 = f32x16{}; p1 = f32x16{}; for (int r = 0; r < 16; ++r) { p0[r] = (float)(r + j); p1[r] = (float)(r - j); } } else qk_pipe(p0, p1, (int)(uintptr_t)bp, qr, r32, hi);
    {
      constexpr float C = SCALE * 1.4426950408889634f; const bool msk = j > wlast;
      float pmax = p0[0]; for (int r = 1; r < 16; ++r) pmax = fmaxf(pmax, p0[r]); for (int r = 0; r < 16; ++r) pmax = fmaxf(pmax, p1[r]);
      { auto rr = __builtin_amdgcn_permlane32_swap(__float_as_uint(pmax), __float_as_uint(pmax), false, false); pmax = fmaxf(__uint_as_float(rr[0]), __uint_as_float(rr[1])); }
      if (msk) pmax = -INFINITY;
      if (__builtin_expect(__all(pmax - m_reg <= THR / SCALE), 1)) { mn = m_reg; al = 1.f; }
      else { mn = fmaxf(m_reg, pmax); al = __builtin_amdgcn_exp2f((m_reg - mn) * C); m_reg = mn; }
      const float mnC = msk ? -INFINITY : -mn * C;
      for (int r = 0; r < 16; ++r) p0[r] = fmaf(p0[r], C, mnC); for (int r = 0; r < 16; ++r) p1[r] = fmaf(p1[r], C, mnC);
      if constexpr (VAR != 1 && VAR != 4) { for (int r = 0; r < 16; ++r) p0[r] = __builtin_amdgcn_exp2f(p0[r]); }
    }
    W_RESC(al);
    if constexpr (VAR == 1) { float ps = 0; for (int r = 0; r < 16; ++r) ps += p0[r] + p1[r]; l_reg = l_reg * al + ps;
        v4u w0 = {cvtpk(p0[0], p0[1]), cvtpk(p0[2], p0[3]), cvtpk(p0[4], p0[5]), cvtpk(p0[6], p0[7])}, w1 = {cvtpk(p0[8], p0[9]), cvtpk(p0[10], p0[11]), cvtpk(p0[12], p0[13]), cvtpk(p0[14], p0[15])};
        v4u w2 = {cvtpk(p1[0], p1[1]), cvtpk(p1[2], p1[3]), cvtpk(p1[4], p1[5]), cvtpk(p1[6], p1[7])}, w3 = {cvtpk(p1[8], p1[9]), cvtpk(p1[10], p1[11]), cvtpk(p1[12], p1[13]), cvtpk(p1[14], p1[15])};
        pa0 = __builtin_bit_cast(bf16x8, w0); pa1 = __builtin_bit_cast(bf16x8, w1); pa2 = __builtin_bit_cast(bf16x8, w2); pa3 = __builtin_bit_cast(bf16x8, w3); }
    else if constexpr (VAR == 4) { l_reg += p0[0];
        v4u w0 = {__float_as_uint(p0[0]), __float_as_uint(p0[1]), __float_as_uint(p0[2]), __float_as_uint(p0[3])}, w1 = {__float_as_uint(p0[4]), __float_as_uint(p0[5]), __float_as_uint(p0[6]), __float_as_uint(p0[7])};
        v4u w2 = {__float_as_uint(p1[0]), __float_as_uint(p1[1]), __float_as_uint(p1[2]), __float_as_uint(p1[3])}, w3 = {__float_as_uint(p1[4]), __float_as_uint(p1[5]), __float_as_uint(p1[6]), __float_as_uint(p1[7])};
        pa0 = __builtin_bit_cast(bf16x8, w0); pa1 = __builtin_bit_cast(bf16x8, w1); pa2 = __builtin_bit_cast(bf16x8, w2); pa3 = __builtin_bit_cast(bf16x8, w3); }
    else finishSM(p0, p1, al, l_reg, pa0, pa1, pa2, pa3);
    SBAR();
    { int t3_ = lane_id(); asm volatile("" : "+v"(t3_)); const int vb0 = (int)(uintptr_t)bp + 16384 + v_rd_base(t3_ & 63);
      if constexpr (VAR == 2) { o[0][0] += __builtin_bit_cast(float, pa0[0] | (pa1[1] << 16)) + __builtin_bit_cast(float, pa2[0] | (pa3[1] << 16)) + (float)vb0; } else pv_pipe(o, vb0, pa0, pa1, pa2, pa3); }
    asm volatile("s_waitcnt vmcnt(0)" ::: "memory"); __syncthreads();
    if (j + 2 < NT) W_DMA((j + 2) * KVBLK, bp);
  }
  {
    int t4_ = lane_id(); asm volatile("" : "+v"(t4_)); const int r32e = t4_ & 31, hie = t4_ >> 5;
    float* lil = (float*)(lds + 2 * WBUF) + wv * 64;
    if (hie == 0) lil[r32e] = l_reg; asm volatile("s_waitcnt lgkmcnt(0)" ::: "memory");
    float rli[16];
#pragma unroll
    for (int r = 0; r < 16; ++r) rli[r] = __builtin_amdgcn_rcpf(lil[crow(r, hie)]);
    float* Ow = Ob + (long)(wv * QBLK) * 2048;
#pragma unroll
    for (int r = 0; r < 16; ++r) { const int orow = crow(r, hie);
      for (int d0 = 0; d0 < 8; ++d0) Ow[(long)orow * 2048 + d0 * 32 + r32e] = o[d0][r] * rli[r]; }
  }
  __syncthreads();
#undef W_DMA
#undef W_RESC
}
}

struct Args { const float* in[25]; float* out; unsigned char* ws; int ph_lo, ph_hi; };

struct TrItem { const float* W; bf16* WT; const float* gain; int K, N, gmask, k0, n0, n0d; float gscale; };
__device__ __forceinline__ bool p0_item(const Args& a, int grp, int it, TrItem& t) {
    unsigned char* ws = a.ws;
    constexpr int I_HIN = (DM / 64) * (NHG / 64), I_SQ = (DM / 64) * (DM / 64), I_UP = (DM / 64) * (NUP / 64), I_DN = (DFF / 64) * (DM / 64), I_DIN = (DM / 64) * (NDI / 64);
    int r = it; t.gscale = 1.f;
    if (grp == 0) {
        if (r >= I_HIN) return false;
        t.W = a.in[9]; t.K = DM; t.N = NHG; t.WT = (bf16*)(ws + WS_W_HIN); t.gain = a.in[6]; t.gmask = DM - 1;
    } else if (grp == 1) {
        if (r >= I_SQ + I_UP + I_DN + I_DIN) return false;
        if (r < I_SQ) { t.W = a.in[10]; t.K = DM; t.N = DM; t.WT = (bf16*)(ws + WS_W_HOUT); t.gain = a.in[11]; t.gmask = 127; }
        else if ((r -= I_SQ) < I_UP) { t.W = a.in[21]; t.K = DM; t.N = NUP; t.WT = (bf16*)(ws + WS_W_UP0); t.gain = a.in[7]; t.gmask = DM - 1; }
        else if ((r -= I_UP) < I_DN) { t.W = a.in[24]; t.K = DFF; t.N = DM; t.WT = (bf16*)(ws + WS_W_DN0); t.gain = nullptr; t.gmask = 0; }
        else { r -= I_DN; t.W = a.in[12]; t.K = DM; t.N = NDI; t.WT = (bf16*)(ws + WS_W_DIN); t.gain = a.in[6] + DM; t.gmask = DM - 1; }
    } else {
        if (r >= I_SQ + I_UP + I_DN) return false;
        if (r < I_SQ) { t.W = a.in[13]; t.K = DM; t.N = DM; t.WT = (bf16*)(ws + WS_W_DOUT); t.gain = a.in[20]; t.gmask = 255; t.gscale = 1.f - LAM_INIT; }
        else if ((r -= I_SQ) < I_UP) { t.W = a.in[21] + (size_t)DM * NUP; t.K = DM; t.N = NUP; t.WT = (bf16*)(ws + WS_W_UP1); t.gain = a.in[7] + DM; t.gmask = DM - 1; }
        else { r -= I_UP; t.W = a.in[24] + (size_t)DFF * DM; t.K = DFF; t.N = DM; t.WT = (bf16*)(ws + WS_W_DN1); t.gain = nullptr; t.gmask = 0; }
    }
    const int nblk = t.N / 64; t.k0 = 64 * (r / nblk); t.n0 = 64 * (r % nblk);
    t.n0d = (t.N == NUP) ? ((t.n0 < DFF) ? 256 * (t.n0 >> 7) + (t.n0 & 127) : 256 * ((t.n0 - DFF) >> 7) + 128 + ((t.n0 - DFF) & 127)) : t.n0;
    return true;
}
constexpr int TR_GRP2_ITEMS = (DM / 64) * (DM / 64) + (DM / 64) * (NUP / 64) + (DFF / 64) * (DM / 64);
#define TR_LOAD(v, gk, t) do { _Pragma("unroll") for (int i = 0; i < 16; ++i) { const int k = 8 * (i >> 1) + 2 * kr + (i & 1); \
        v[i] = *(const GAS f32x4*)((t).W + (size_t)((t).k0 + k) * (t).N + (t).n0 + 4 * n4); gk[i] = (t).gain ? (t).gain[((t).k0 + k) & (t).gmask] * (t).gscale : 1.f; } } while (0)
#define TR_STORE(v, gk, t) do { _Pragma("unroll") for (int j = 0; j < 8; ++j) { const f32x4 a_ = v[2 * j] * gk[2 * j], b_ = v[2 * j + 1] * gk[2 * j + 1]; \
            _Pragma("unroll") for (int c = 0; c < 4; ++c) scr[(4 * n4 + c) * 33 + 4 * j + kr] = cvtpk(a_[c], b_[c]); } \
        LDS_WAIT(); asm volatile("" ::: "memory"); \
        _Pragma("unroll") for (int m = 0; m < 8; ++m) { const int n = (lane >> 3) + 8 * m; const LAS unsigned* sp = scr + n * 33 + 4 * (lane & 7); \
            v4u o_; o_.x = sp[0]; o_.y = sp[1]; o_.z = sp[2]; o_.w = sp[3]; *(GAS v4u*)((t).WT + (size_t)((t).n0d + n) * (t).K + (t).k0 + 8 * (lane & 7)) = o_; } \
        LDS_WAIT(); asm volatile("" ::: "memory"); } while (0)
__device__ __forceinline__ void tr_run(const Args& a, int grp, int first, int step, int last, LAS unsigned* scr, int lane) {
    const int n4 = lane & 15, kr = lane >> 4;
    f32x4 vA[16], vB[16]; float gA[16], gB[16]; TrItem tA, tB;
    int it = first; bool hA = it < last && p0_item(a, grp, it, tA), hB = false;
    if (hA) TR_LOAD(vA, gA, tA);
    while (hA) {
        hB = it + step < last && p0_item(a, grp, it + step, tB); if (hB) TR_LOAD(vB, gB, tB);
        TR_STORE(vA, gA, tA);
        if (!hB) break;
        it += 2 * step; hA = it < last && p0_item(a, grp, it, tA); if (hA) TR_LOAD(vA, gA, tA);
        TR_STORE(vB, gB, tB);
    }
}
__device__ __forceinline__ void p0_prologue(const Args& a, LAS unsigned char* lds, int vcu, int G, int wave, int lane) {
    LAS unsigned* scr = (LAS unsigned*)(lds + RING_OFF + wave * 16384);
    const int gw = vcu * NWAVES + wave, NGW = G * NWAVES;
    unsigned char* ws = a.ws;
    tr_run(a, 0, gw, NGW, 1 << 30, scr, lane);
    if (G != 256) tr_run(a, 1, gw, NGW, 1 << 30, scr, lane);
    float* sm = (float*)(ws + WS_SMALL); bf16* XB = (bf16*)(ws + WS_XB);
    for (int m = gw; m < MR; m += NGW) {
        const float* xrow = (m < MP) ? a.in[0] + (size_t)m * DM : a.in[1] + (size_t)(m - MP) * DM;
        const GAS f32x4* xr = (const GAS f32x4*)xrow + lane;
        f32x4 v[8]; float s = 0.f;
#pragma unroll
        for (int j = 0; j < 8; ++j) { v[j] = xr[64 * j]; s += (v[j].x * v[j].x + v[j].y * v[j].y) + (v[j].z * v[j].z + v[j].w * v[j].w); }
        s = wave_sum(s);
        GAS v2u* o8 = (GAS v2u*)(XB + (size_t)m * DM) + lane;
#pragma unroll
        for (int j = 0; j < 8; ++j) { v2u w; w.x = cvtpk(v[j].x, v[j].y); w.y = cvtpk(v[j].z, v[j].w); o8[64 * j] = w; }
        if (lane == 0) sm[SM_RINV0 + m] = 1.f / sqrtf(s * (1.f / DM) + EPS);
    }
    for (int i = gw * 64 + lane; i < DM; i += NGW * 64) {
        const float z0 = a.in[8][i], z1 = a.in[8][DM + i], z2 = a.in[8][2 * DM + i], mx = fmaxf(z0, fmaxf(z1, z2));
        const float e0 = expf(z0 - mx), e1 = expf(z1 - mx), e2 = expf(z2 - mx);
        sm[SM_LB + i] = e0 / (e0 + e1 + e2);
    }
    if (gw == 0) {
        const float s1 = wave_sum(a.in[16][lane] * a.in[17][lane] + a.in[16][lane + 64] * a.in[17][lane + 64]);
        const float s2 = wave_sum(a.in[18][lane] * a.in[19][lane] + a.in[18][lane + 64] * a.in[19][lane + 64]);
        if (lane == 0) sm[SM_LAM] = expf(s1) - expf(s2) + LAM_INIT;
    }
}

__device__ __forceinline__ unsigned img_off(unsigned row, unsigned ch) { return 256u * row + 16u * (ch ^ (((row & 3u) << 2) | ((row >> 2) & 3u))); }
__device__ __forceinline__ bf16x8 img_rowread(const LAS unsigned char* img, int rowbase, int ks, int lane) {
    return *(const LAS bf16x8*)(img + img_off(rowbase + (lane & 31), 2 * ks + (lane >> 5)));
}
__device__ __forceinline__ s16x4 vtr(const LAS unsigned char* p) { typedef short v4i16_t __attribute__((ext_vector_type(4)));
    return __builtin_bit_cast(s16x4, __builtin_amdgcn_ds_read_tr16_b64_v4i16((LAS v4i16_t*)p)); }
__device__ __forceinline__ bf16x8 img_trread_nat(const LAS unsigned char* img, int R0, int c, int lane) {
    const unsigned h = lane >> 5, blk = (lane >> 4) & 1, q = (lane & 15) >> 2, p = lane & 3;
    const s16x4 lo = vtr(img + img_off(R0 + 8 * h + q, 4 * c + 2 * blk + (p >> 1)) + 8 * (p & 1));
    const s16x4 hi = vtr(img + img_off(R0 + 8 * h + 4 + q, 4 * c + 2 * blk + (p >> 1)) + 8 * (p & 1));
    return (bf16x8){lo[0], lo[1], lo[2], lo[3], hi[0], hi[1], hi[2], hi[3]};
}
__device__ __forceinline__ bf16x8 img_trread_acc(const LAS unsigned char* img, int R0, int c, int lane) {
    const unsigned h = lane >> 5, blk = (lane >> 4) & 1, q = (lane & 15) >> 2, p = lane & 3;
    const s16x4 lo = vtr(img + img_off(R0 + 4 * h + q, 4 * c + 2 * blk + (p >> 1)) + 8 * (p & 1));
    const s16x4 hi = vtr(img + img_off(R0 + 8 + 4 * h + q, 4 * c + 2 * blk + (p >> 1)) + 8 * (p & 1));
    return (bf16x8){lo[0], lo[1], lo[2], lo[3], hi[0], hi[1], hi[2], hi[3]};
}
__device__ __forceinline__ int crow_(int r, int hi) { return (r & 3) + 8 * (r >> 2) + 4 * hi; }
#define MFMA32(a, b, c) __builtin_amdgcn_mfma_f32_32x32x16_bf16((a), (b), (c), 0, 0, 0)

#define RAW_BAR() do { asm volatile("s_waitcnt lgkmcnt(0)" ::: "memory"); __builtin_amdgcn_s_barrier(); asm volatile("" ::: "memory"); } while (0)
constexpr int SC_QT = 0, SC_KT = 16384, SC_QH = 32768, SC_VI = 49152, SC_SI = 65536, SC_PART = 98304, SC_RED = 102400;

constexpr int SR_KH = 98304, SR_PART = 114688, SR_RED = 118784, SR_DV = 119808;
constexpr size_t WS_RB = WS_LST, WS_RE = WS_LST + 32 * MiB;
__device__ __forceinline__ void sr_state_image(LAS unsigned char* lds, const f32x16& acc0, const f32x16& acc1, int db, int eb0, int hi_, int r32_) {
    int lz = lane_id(); asm volatile("" : "+v"(lz)); const int hi = lz >> 5, r32 = lz & 31; (void)hi_; (void)r32_;
#pragma unroll
    for (int r = 0; r < 16; ++r) { const int d = 32 * db + crow_(r, hi);
        { const int e = 32 * eb0 + r32; *(LAS unsigned short*)(lds + SC_SI + img_off(d, e >> 3) + (e & 7) * 2) = (unsigned short)cvtpk(acc0[r], acc0[r]); }
        { const int e = 32 * (eb0 + 1) + r32; *(LAS unsigned short*)(lds + SC_SI + img_off(d, e >> 3) + (e & 7) * 2) = (unsigned short)cvtpk(acc1[r], acc1[r]); } }
}
template <bool OUT>
__device__ __forceinline__ void scan_run_phase(const Args& a, LAS unsigned char* lds, int vcu, int G, int tid, int wave, int lane) {
    unsigned char* ws = a.ws;
    const bf16* QH = (const bf16*)(ws + WS_QH); const bf16* VH = (const bf16*)(ws + WS_VH); const bf16* SG = (const bf16*)(ws + WS_SG);
    const float* GG = (const float*)(ws + WS_G); bf16* HA = (bf16*)(ws + WS_HA);
    float* RB = (float*)(ws + WS_RB); const float* RE = (const float*)(ws + WS_RE); float* RA = (float*)(ws + WS_DC);
    LAS float* part = (LAS float*)(lds + SR_PART); LAS float* red = (LAS float*)(lds + SR_RED); LAS float* dvl = (LAS float*)(lds + SR_DV);
    const int hi = lane >> 5, r32 = lane & 31, db = wave & 3, eb0 = 2 * (wave >> 2);
    for (int unitid = vcu; unitid < 256; unitid += G) {
#pragma unroll 1
      for (int seq = 0; seq < (OUT ? 2 : 1); ++seq) {
        const int hh = seq == 0 ? (unitid >> 4) : (unitid & 15);
        const int c0 = seq == 0 ? 8 * (unitid & 15) : NCHP + (unitid >> 4);
        const int nck = seq == 0 ? 8 : 1;
        f32x16 acc0 = {}, acc1 = {}; f32x2 aprod = {1.f, 1.f};
        if (OUT) {
            const float* E = seq == 0 ? RE + (size_t)unitid * 16384 : a.in[2] + (size_t)unitid * 16384;
#pragma unroll
            for (int r = 0; r < 16; ++r) { int lz = lane_id(); asm volatile("" : "+v"(lz)); const int d = 32 * db + crow_(r, lz >> 5); acc0[r] = E[d * 128 + 32 * eb0 + (lz & 31)]; acc1[r] = E[d * 128 + 32 * (eb0 + 1) + (lz & 31)]; }
            sr_state_image(lds, acc0, acc1, db, eb0, hi, r32);
        }
        f32x2 g[8]; unsigned qv[8]; v4u vch[2];
#define SR_LOAD(cc) do { const size_t rb_ = (size_t)(cc) * 64; \
            _Pragma("unroll") for (int i = 0; i < 8; ++i) { const size_t off = (rb_ + wave * 8 + i) * DM + hh * 128 + 2 * lane; g[i] = *(const f32x2*)(GG + off); if (OUT) qv[i] = *(const unsigned*)(QH + off); } \
            _Pragma("unroll") for (int j = 0; j < 2; ++j) { const int n = tid + 512 * j; vch[j] = *(const v4u*)(VH + (rb_ + (n >> 4)) * DM + hh * 128 + (n & 15) * 8); } } while (0)
        SR_LOAD(c0);
#pragma unroll 1
        for (int k = 0; k < nck; ++k) {
            const int c = c0 + k; const size_t rb = (size_t)c * 64;
#pragma unroll
            for (int i = 1; i < 8; ++i) g[i] += g[i - 1];
            *(LAS f32x2*)(part + wave * 128 + 2 * lane) = g[7];
            RAW_BAR();
            f32x2 offv = {0.f, 0.f}, bmid = {0.f, 0.f}, blast = {0.f, 0.f};
#pragma unroll
            for (int s = 0; s < 8; ++s) { const f32x2 p = *(const LAS f32x2*)(part + s * 128 + 2 * lane); if (s < wave) offv += p; if (s < 4) bmid += p; blast += p; }
#pragma unroll
            for (int i = 0; i < 8; ++i) { const f32x2 b = offv + g[i];
                const f32x2 gr = i ? g[i] - g[i - 1] : g[0];
                const float k0 = 1.f - __expf(gr.x), k1 = 1.f - __expf(gr.y);
                const unsigned o = img_off(wave * 8 + i, lane >> 2) + (lane & 3) * 4;
                *(LAS unsigned*)(lds + SR_KH + o) = cvtpk(k0 * __expf(blast.x - b.x), k1 * __expf(blast.y - b.y));
                if (OUT) { const float q0 = bflo(qv[i]), q1 = bfhi(qv[i]);
                    *(LAS unsigned*)(lds + SC_QH + o) = cvtpk(q0 * __expf(b.x), q1 * __expf(b.y));
                    *(LAS unsigned*)(lds + SC_QT + o) = cvtpk(q0 * __expf(fminf(b.x - bmid.x, 80.f)), q1 * __expf(fminf(b.y - bmid.y, 80.f)));
                    *(LAS unsigned*)(lds + SC_KT + o) = cvtpk(k0 * __expf(fminf(bmid.x - b.x, 80.f)), k1 * __expf(fminf(bmid.y - b.y, 80.f))); } }
#pragma unroll
            for (int j = 0; j < 2; ++j) { const int n = tid + 512 * j; *(LAS v4u*)(lds + SC_VI + img_off(n >> 4, n & 15)) = vch[j]; }
            if (wave == 0) { const f32x2 ev = {__expf(blast.x), __expf(blast.y)}; *(LAS f32x2*)(dvl + 2 * lane) = ev; aprod = aprod * ev; }
            const int eb = wave & 3, tb = wave >> 2;
            const size_t orow = (rb + 32 * tb + r32) * DM + hh * 128 + 32 * eb + 4 * hi;
            v2u sgv[4];
            if (OUT) {
#pragma unroll
                for (int g4 = 0; g4 < 4; ++g4) sgv[g4] = *(const v2u*)(SG + orow + 8 * g4);
            }
            if (k + 1 < nck) SR_LOAD(c + 1);
            RAW_BAR();
            if (OUT) {
                f32x16 o = {};
                {
                    f32x16 X = {};
#pragma unroll
                    for (int ks = 0; ks < 8; ++ks) X = MFMA32(img_rowread(lds + SC_KT, 0, ks, lane), img_rowread(lds + SC_QT, 32 * tb, ks, lane), X);
                    if (tb == 0) {
#pragma unroll
                        for (int r = 0; r < 16; ++r) if (crow_(r, hi) > r32) X[r] = 0.f;
                    }
#pragma unroll
                    for (int s2 = 0; s2 < 2; ++s2) {
                        v4u w; w.x = cvtpk(X[8 * s2 + 0], X[8 * s2 + 1]); w.y = cvtpk(X[8 * s2 + 2], X[8 * s2 + 3]); w.z = cvtpk(X[8 * s2 + 4], X[8 * s2 + 5]); w.w = cvtpk(X[8 * s2 + 6], X[8 * s2 + 7]);
                        o = MFMA32(img_trread_acc(lds + SC_VI, 16 * s2, eb, lane), __builtin_bit_cast(bf16x8, w), o);
                    }
                }
                if (tb == 1) {
                    f32x16 X = {};
#pragma unroll
                    for (int ks = 0; ks < 8; ++ks) X = MFMA32(img_rowread(lds + SC_KT, 32, ks, lane), img_rowread(lds + SC_QT, 32, ks, lane), X);
#pragma unroll
                    for (int r = 0; r < 16; ++r) if (crow_(r, hi) > r32) X[r] = 0.f;
#pragma unroll
                    for (int s2 = 0; s2 < 2; ++s2) {
                        v4u w; w.x = cvtpk(X[8 * s2 + 0], X[8 * s2 + 1]); w.y = cvtpk(X[8 * s2 + 2], X[8 * s2 + 3]); w.z = cvtpk(X[8 * s2 + 4], X[8 * s2 + 5]); w.w = cvtpk(X[8 * s2 + 6], X[8 * s2 + 7]);
                        o = MFMA32(img_trread_acc(lds + SC_VI, 32 + 16 * s2, eb, lane), __builtin_bit_cast(bf16x8, w), o);
                    }
                }
#pragma unroll
                for (int ks = 0; ks < 8; ++ks) o = MFMA32(img_trread_nat(lds + SC_SI, 16 * ks, eb, lane), img_rowread(lds + SC_QH, 32 * tb, ks, lane), o);
                float ss = 0.f;
#pragma unroll
                for (int r = 0; r < 16; ++r) ss += o[r] * o[r];
                ss += __shfl_xor(ss, 32);
                if (lane < 32) red[(tb * 4 + eb) * 32 + lane] = ss;
                RAW_BAR();
                const float tot = (red[(tb * 4 + 0) * 32 + r32] + red[(tb * 4 + 1) * 32 + r32]) + (red[(tb * 4 + 2) * 32 + r32] + red[(tb * 4 + 3) * 32 + r32]);
                const float rn = __builtin_amdgcn_rsqf(tot * (1.f / 128.f) + EPS);
#pragma unroll
                for (int g4 = 0; g4 < 4; ++g4) {
                    const v2u sg = sgv[g4];
                    v2u w; w.x = cvtpk(o[4 * g4 + 0] * rn * bflo(sg.x), o[4 * g4 + 1] * rn * bfhi(sg.x)); w.y = cvtpk(o[4 * g4 + 2] * rn * bflo(sg.y), o[4 * g4 + 3] * rn * bfhi(sg.y));
                    *(v2u*)(HA + orow + 8 * g4) = w;
                }
            }
            { int lz = lane_id(); asm volatile("" : "+v"(lz)); const LAS float* dp = dvl + 32 * db + 4 * (lz >> 5);
#pragma unroll
              for (int r = 0; r < 16; ++r) { const float dv = dp[(r & 3) + 8 * (r >> 2)]; acc0[r] *= dv; acc1[r] *= dv; } }
#pragma unroll
            for (int ks = 0; ks < 4; ++ks) {
                const bf16x8 Af = img_trread_nat(lds + SR_KH, 16 * ks, db, lane);
                const bf16x8 B0 = img_trread_nat(lds + SC_VI, 16 * ks, eb0, lane), B1 = img_trread_nat(lds + SC_VI, 16 * ks, eb0 + 1, lane);
                acc0 = MFMA32(Af, B0, acc0); acc1 = MFMA32(Af, B1, acc1);
            }
            if (OUT && k + 1 < nck) sr_state_image(lds, acc0, acc1, db, eb0, hi, r32);
        }
        if (!OUT) {
            float* Bu = RB + (size_t)unitid * 16384;
#pragma unroll
            for (int r = 0; r < 16; ++r) { int lz = lane_id(); asm volatile("" : "+v"(lz)); const int d = 32 * db + crow_(r, lz >> 5); Bu[d * 128 + 32 * eb0 + (lz & 31)] = acc0[r]; Bu[d * 128 + 32 * (eb0 + 1) + (lz & 31)] = acc1[r]; }
            if (wave == 0) *(f32x2*)(RA + (size_t)unitid * 128 + 2 * lane) = aprod;
        } else if (seq == 1) {
            float* Su = a.out + O_HS + (size_t)unitid * 16384;
#pragma unroll
            for (int r = 0; r < 16; ++r) { int lz = lane_id(); asm volatile("" : "+v"(lz)); const int d = 32 * db + crow_(r, lz >> 5); Su[d * 128 + 32 * eb0 + (lz & 31)] = acc0[r]; Su[d * 128 + 32 * (eb0 + 1) + (lz & 31)] = acc1[r]; }
        }
        __syncthreads();
#undef SR_LOAD
      }
    }
}
__device__ __forceinline__ void scan_runcarry_phase(const Args& a, int vcu, int G, int tid) {
    unsigned char* ws = a.ws;
    const float* RB = (const float*)(ws + WS_RB); float* RE = (float*)(ws + WS_RE); const float* RA = (const float*)(ws + WS_DC);
    for (int p = vcu * 512 + tid; p < 131072; p += G * 512) {
        const int idx = 2 * p, hh = idx >> 14, d = (idx >> 7) & 127, e = idx & 127;
        f32x2 Bv[16]; float Av[16];
#pragma unroll
        for (int r = 0; r < 16; ++r) { const size_t run = (size_t)hh * 16 + r; Bv[r] = *(const f32x2*)(RB + run * 16384 + d * 128 + e); Av[r] = RA[run * 128 + d]; }
        f32x2 E = {0.f, 0.f};
#pragma unroll
        for (int r = 0; r < 16; ++r) { const size_t run = (size_t)hh * 16 + r; *(f32x2*)(RE + run * 16384 + d * 128 + e) = E; E = E * Av[r] + Bv[r]; }
        *(f32x2*)(a.out + O_HP + idx) = E;
    }
}

__device__ __forceinline__ void conv_fix_phase(const Args& a, int layer, int vcu, int G, int tid) {
    unsigned char* ws = a.ws;
    const bf16* SGF = (const bf16*)(ws + WS_GU); const bf16* SGL = SGF + (size_t)(MR / 16) * 4 * DFF; bf16* ACT = (bf16*)(ws + WS_ACT);
    const float* cw = a.in[22] + (size_t)layer * 3 * DFF; const float* cb = a.in[23] + (size_t)layer * DFF; const float* st = a.in[5] + (size_t)layer * 16 * 2 * DFF;
    constexpr int NCC = DFF / 8, NGRP = MR / 16;
    for (int it = vcu * 512 + tid; it < NCC * NGRP; it += G * 512) {
        const int cc = it % NCC, grp = it / NCC, c0 = cc * 8, t0 = grp * 16;
        float w0[8], w1[8], w2[8], bb[8], g1[8], g2[8];
#pragma unroll
        for (int j = 0; j < 8; ++j) { w0[j] = cw[c0 + j]; w1[j] = cw[DFF + c0 + j]; w2[j] = cw[2 * DFF + c0 + j]; bb[j] = cb[c0 + j]; }
        if (t0 == 0) {
#pragma unroll
            for (int j = 0; j < 8; ++j) { g1[j] = 0.f; g2[j] = 0.f; }
        } else if (t0 >= MP && (t0 & 63) == 0) {
            const float* sp = st + (size_t)((t0 - MP) >> 6) * 2 * DFF + c0;
#pragma unroll
            for (int j = 0; j < 8; ++j) { g2[j] = sp[j]; g1[j] = sp[DFF + j]; }
        } else {
            const v4u p2 = *(const v4u*)(SGL + ((size_t)(grp - 1) * 2 + 0) * DFF + c0), p1 = *(const v4u*)(SGL + ((size_t)(grp - 1) * 2 + 1) * DFF + c0);
            g2[0] = bflo(p2.x); g2[1] = bfhi(p2.x); g2[2] = bflo(p2.y); g2[3] = bfhi(p2.y); g2[4] = bflo(p2.z); g2[5] = bfhi(p2.z); g2[6] = bflo(p2.w); g2[7] = bfhi(p2.w);
            g1[0] = bflo(p1.x); g1[1] = bfhi(p1.x); g1[2] = bflo(p1.y); g1[3] = bfhi(p1.y); g1[4] = bflo(p1.z); g1[5] = bfhi(p1.z); g1[6] = bflo(p1.w); g1[7] = bfhi(p1.w);
        }
#pragma unroll
        for (int j2 = 0; j2 < 2; ++j2) {
            const v4u pg = *(const v4u*)(SGF + (((size_t)grp * 2 + j2) * 2 + 0) * DFF + c0), pu = *(const v4u*)(SGF + (((size_t)grp * 2 + j2) * 2 + 1) * DFF + c0);
            float g0[8], up[8], r[8];
            g0[0] = bflo(pg.x); g0[1] = bfhi(pg.x); g0[2] = bflo(pg.y); g0[3] = bfhi(pg.y); g0[4] = bflo(pg.z); g0[5] = bfhi(pg.z); g0[6] = bflo(pg.w); g0[7] = bfhi(pg.w);
            up[0] = bflo(pu.x); up[1] = bfhi(pu.x); up[2] = bflo(pu.y); up[3] = bfhi(pu.y); up[4] = bflo(pu.z); up[5] = bfhi(pu.z); up[6] = bflo(pu.w); up[7] = bfhi(pu.w);
#pragma unroll
            for (int j = 0; j < 8; ++j) { const float cv = bb[j] + w2[j] * g0[j] + w1[j] * g1[j] + w0[j] * g2[j]; r[j] = cv * sigmoidf_(cv) * up[j]; g2[j] = g1[j]; g1[j] = g0[j]; }
            v4u w; w.x = cvtpk(r[0], r[1]); w.y = cvtpk(r[2], r[3]); w.z = cvtpk(r[4], r[5]); w.w = cvtpk(r[6], r[7]);
            *(v4u*)(ACT + (size_t)(t0 + j2) * DFF + c0) = w;
        }
    }
}

__device__ __forceinline__ void diff_combine_phase(const Args& a, int vcu, int G, int wave, int lane) {
    unsigned char* ws = a.ws;
    const float* OA0 = (const float*)(ws + WS_OA); const float* OA1 = OA0 + (size_t)MR * DM; bf16* HA = (bf16*)(ws + WS_HA);
    const float lam = ((const float*)(ws + WS_SMALL))[SM_LAM];
    const int gw = vcu * NWAVES + wave, NGW = G * NWAVES;
    for (int it = gw; it < MR * 8; it += NGW) {
        const size_t off = (size_t)it * 256 + lane * 4;
        const f32x4 x0 = *(const f32x4*)(OA0 + off), x1 = *(const f32x4*)(OA1 + off);
        const f32x4 o = x0 - x1 * lam;
        const float s = wave_sum((o.x * o.x + o.y * o.y) + (o.z * o.z + o.w * o.w));
        const float rn = __builtin_amdgcn_rsqf(s * (1.f / 256.f) + EPS);
        v2u w; w.x = cvtpk(o.x * rn, o.y * rn); w.y = cvtpk(o.z * rn, o.w * rn);
        *(v2u*)(HA + off) = w;
    }
}

#ifndef ATT_NS
#define ATT_NS 8
#endif
__device__ __forceinline__ void attention_phase(const Args& a, char* lds, gu32* qctr, const int wv) {
    unsigned char* ws = a.ws;
    const att::bf16* QN = (const att::bf16*)(ws + WS_QH); const att::bf16* KN = (const att::bf16*)(ws + WS_KH); const att::bf16* VBn = (const att::bf16*)(ws + WS_VH);
    float* OA0 = (float*)(ws + WS_OA); float* OA1 = OA0 + (size_t)MR * DM;
    const int wid = wv; const bool t0 = (wv == 0 && lane_id() == 0);
    volatile unsigned* slot = (volatile unsigned*)(lds + SCR_OFF + 4096);
    const int x0 = (int)(xb_xcc_id() & 7u);
    bool conv_left = true;
    for (int dq = 0; dq < 8; ++dq) {
        const int x = (x0 + dq) & 7;
        for (;;) {
            __syncthreads();
            if (t0) *slot = __hip_atomic_fetch_add(qctr + 64 * x, 1u, __ATOMIC_RELAXED, __HIP_MEMORY_SCOPE_AGENT);
            __syncthreads();
            const int u = __builtin_amdgcn_readfirstlane((int)*slot);
            if (u >= 16 + 64) break;
            const bool smp = u < 8 || (u >= 32 && u < 40);
            if (smp) {
#ifndef NO_SAMPLE
                const int su = u < 8 ? u : u - 24;
                att::attn_sample_unit(QN, KN, VBn, a.in[3], a.in[4], OA0, OA1, 2 * x + (su >> 3), su & 7, lds, wv);
#endif
            } else {
#ifndef NO_PROMPT
                const int v = u < 32 ? u - 8 : u - 16, qb = 31 - (v >> 1), h = x, c = v & 1;
                const size_t qoff = (size_t)qb * 256 * DM + h * 256;
                att::attn_wide_body<0>(QN + qoff + c * 128, KN + h * 256 + c * 128, VBn + h * 256, (c ? OA1 : OA0) + qoff, 4 * qb + 4, 4 * qb + (wid >> 1), lds, wv);
#endif
            }
            if (conv_left) {
                __syncthreads();
                if (t0) *slot = __hip_atomic_fetch_add(qctr + 64 * 8, 1u, __ATOMIC_RELAXED, __HIP_MEMORY_SCOPE_AGENT);
                __syncthreads();
                const int cu_ = __builtin_amdgcn_readfirstlane((int)*slot);
                if (cu_ * 64 >= TR_GRP2_ITEMS) conv_left = false;
                else { const int last = (cu_ * 64 + 64 < TR_GRP2_ITEMS) ? cu_ * 64 + 64 : TR_GRP2_ITEMS; tr_run(a, 2, cu_ * 64 + wid, NWAVES, last, (LAS unsigned*)(lds + wid * 16384), lane_id()); }
            }
        }
    }
    while (conv_left) {
        __syncthreads();
        if (t0) *slot = __hip_atomic_fetch_add(qctr + 64 * 8, 1u, __ATOMIC_RELAXED, __HIP_MEMORY_SCOPE_AGENT);
        __syncthreads();
        const int u = __builtin_amdgcn_readfirstlane((int)*slot);
        if (u * 64 >= TR_GRP2_ITEMS) break;
        const int last = (u * 64 + 64 < TR_GRP2_ITEMS) ? u * 64 + 64 : TR_GRP2_ITEMS;
        tr_run(a, 2, u * 64 + wid, NWAVES, last, (LAS unsigned*)(lds + wid * 16384), lane_id());
    }
}

constexpr int NPH = 17;
#ifndef G1_CUS
#define G1_CUS 224
#endif
constexpr int SPLIT_0 = 7, SPLIT_1 = 8, SPLIT_2 = 8, SPLIT_3 = 8, SPLIT_4 = 8, SPLIT_5 = 8, SPLIT_6 = 8, SPLIT_7 = 8;
__global__ void __launch_bounds__(NWAVES * 64, 2) fwd_kernel(Args args) {
    extern __shared__ __attribute__((aligned(16))) unsigned char lds[];
    LAS unsigned char* L = (LAS unsigned char*)lds;
    volatile LAS unsigned* MISC = (volatile LAS unsigned*)(L + MISC_OFF);
#if defined(__HIP_DEVICE_COMPILE__)
#define ARGSL const __attribute__((address_space(4))) Args* ap__ = (const __attribute__((address_space(4))) Args*)__builtin_amdgcn_kernarg_segment_ptr(); asm volatile("" : "+s"(ap__)); \
    Args A; { _Pragma("unroll") for (int i_ = 0; i_ < 25; ++i_) A.in[i_] = ap__->in[i_]; A.out = ap__->out; A.ws = ap__->ws; A.ph_lo = ap__->ph_lo; A.ph_hi = ap__->ph_hi; }
#else
#define ARGSL const Args A = args
#endif
#define TIDS int t__ = wv * 64 + lane_id(); asm volatile("" : "+v"(t__)); const int tid = t__, lane = t__ & 63; (void)tid; (void)lane
#define ENV int bx = blockIdx.x; int G = gridDim.x; asm volatile("" : "+s"(bx), "+s"(G)); const int vcu = (G % 8 == 0) ? (bx % 8) * (G / 8) + bx / 8 : bx; \
    const int wave = wv; (void)vcu; (void)wave
    const int wv = __builtin_amdgcn_readfirstlane((int)threadIdx.x >> 6);
    for (int u = threadIdx.x; u < (LDS_BYTES - LDSCTL_OFF) / 4; u += NWAVES * 64) ((LAS unsigned*)(L + LDSCTL_OFF))[u] = 0u;
    __syncthreads();
    const int lo = args.ph_lo, hi = args.ph_hi;
#define BAROBJ XcdBarrier bar; bar.wv = wv; ARGSL; bar.bar = (unsigned*)((gu32*)(A.ws + WS_CTL) + CW_BAR); bar.x = xb_xcc_id(); bar.st = MISC + 8
    if (hi - lo > 1) { BAROBJ; (void)xcd_barrier_post(bar.bar, MISC + 8, wv); }
#ifndef PHMASK
#define PHMASK 0x1ffff
#endif
#define IN(k) ((((PHMASK) >> (k)) & 1) && lo <= (k) && (k) < hi)
#ifndef PROBE_MASK
#define PROBE_MASK 0
#endif
#define PR_WORDS ((volatile LAS unsigned long long*)(L + MISC_OFF + 64))
    if (PROBE_MASK && blockIdx.x == 0 && wv == 0 && lane_id() == 0) { PR_WORDS[0] = __builtin_amdgcn_s_memrealtime(); PR_WORDS[1] = 0ull; }
#define SEAM(k) do { if (IN(k) && IN((k) + 1)) { BAROBJ; xcd_barrier(bar); } \
    if (PROBE_MASK && blockIdx.x == 0 && wv == 0 && lane_id() == 0) { const unsigned long long t_ = __builtin_amdgcn_s_memrealtime(); if ((PROBE_MASK >> (k)) & 1) PR_WORDS[1] += t_ - PR_WORDS[0]; PR_WORDS[0] = t_; } } while (0)
#define PTRS ARGSL; unsigned char* ws = A.ws; float* out = A.out; asm volatile("" : "+s"(ws), "+s"(out)); gu32* ctl = (gu32*)(ws + WS_CTL); (void)ctl; (void)out; \
    float* sm = (float*)(ws + WS_SMALL); float* ss1 = (float*)(ctl + CW_SS1); float* ss2 = (float*)(ctl + CW_SS2); float* ss3 = (float*)(ctl + CW_SS3); (void)sm; (void)ss1; (void)ss2; (void)ss3; \
    bf16* XB = (bf16*)(ws + WS_XB); bf16* HA = (bf16*)(ws + WS_HA); float* X1 = (float*)(ws + WS_X1); bf16* GU = (bf16*)(ws + WS_GU); bf16* ACT = (bf16*)(ws + WS_ACT); (void)XB; (void)HA; (void)X1; (void)GU; (void)ACT

    if (IN(0)) { TIDS; ENV; ARGSL; p0_prologue(A, L, vcu, G, wave, lane); }
    SEAM(0);
    if (IN(1)) {
        PTRS; ENV;
        const bool spare = (G == 256);
        if (spare && bx >= G1_CUS) {
            TIDS; tr_run(A, 1, (bx - G1_CUS) * NWAVES + wave, (256 - G1_CUS) * NWAVES, 1 << 30, (LAS unsigned*)(L + RING_OFF + wave * 16384), lane);
        } else {
            const int Gg = spare ? G1_CUS : G, vcg = spare ? (bx % 8) * (G1_CUS / 8) + bx / 8 : vcu;
            pg8::Gemm g{XB, (const bf16*)(ws + WS_W_HIN), MR, NHG, DM}; pg8::SplitOrder S; S.init(MR, NHG, g.K, Gg, bx, vcg, (float*)(ws + WS_SLAB), (unsigned*)(ctl + CW_SKF + 0 * 4096), SPLIT_0, wv);
            EpiHgrnIn E{ws};
            pg8::gemm_phase<EpiHgrnIn, pg8::SplitOrder, true, true>(L + RING_OFF, g, S, E);
        }
    }
    SEAM(1);
    if (IN(2)) { TIDS; ENV; ARGSL; scan_run_phase<false>(A, L, vcu, G, tid, wave, lane); }
    SEAM(2);
    if (IN(3)) { TIDS; ENV; ARGSL; scan_runcarry_phase(A, vcu, G, tid); }
    SEAM(3);
    if (IN(4)) { TIDS; ENV; ARGSL; scan_run_phase<true>(A, L, vcu, G, tid, wave, lane); }
    SEAM(4);
    if (IN(5)) {
        PTRS; ENV;
        pg8::Gemm g{HA, (const bf16*)(ws + WS_W_HOUT), MR, DM, DM}; pg8::SplitOrder S; S.init(MR, DM, g.K, G, bx, vcu, (float*)(ws + WS_SLAB), (unsigned*)(ctl + CW_SKF + 1 * 4096), SPLIT_1, wv);
        EpiResid<true> E{A.in[0], A.in[1] - (size_t)MP * DM, X1, XB, ss1};
        pg8::gemm_phase<EpiResid<true>, pg8::SplitOrder, true, true>(L + RING_OFF, g, S, E);
    }
    SEAM(5);
    if (IN(6)) {
        PTRS; ENV;
        pg8::Gemm g{XB, (const bf16*)(ws + WS_W_UP0), MR, NUP, DM}; pg8::SplitOrder S; S.init(MR, NUP, g.K, G, bx, vcu, (float*)(ws + WS_SLAB), (unsigned*)(ctl + CW_SKF + 2 * 4096), SPLIT_2, wv);
        EpiUp E{ws, ss1, out + O_CP, out + O_CS, A.in[22], A.in[23]};
        pg8::gemm_phase<EpiUp, pg8::SplitOrder, true, true>(L + RING_OFF, g, S, E);
    }
    SEAM(6);
    if (IN(7)) { TIDS; ENV; ARGSL; conv_fix_phase(A, 0, vcu, G, tid); }
    SEAM(7);
    if (IN(8)) {
        PTRS; ENV;
        pg8::Gemm g{ACT, (const bf16*)(ws + WS_W_DN0), MR, DM, DFF}; pg8::SplitOrder S; S.init(MR, DM, g.K, G, bx, vcu, (float*)(ws + WS_SLAB), (unsigned*)(ctl + CW_SKF + 3 * 4096), SPLIT_3, wv);
        EpiResid<true> E{X1, X1, X1, XB, ss2};
        pg8::gemm_phase<EpiResid<true>, pg8::SplitOrder, true, true>(L + RING_OFF, g, S, E);
    }
    SEAM(8);
    if (IN(9)) {
        PTRS; ENV;
        pg8::Gemm g{XB, (const bf16*)(ws + WS_W_DIN), MR, NDI, DM}; pg8::SplitOrderT<16> S; S.init(MR, NDI, g.K, G, bx, vcu, (float*)(ws + WS_SLAB), (unsigned*)(ctl + CW_SKF + 4 * 4096), SPLIT_4, wv);
        EpiDiffIn E{ws, out, A.in[14], A.in[15], (LAS float*)(L + SCR_OFF)};
        pg8::gemm_phase<EpiDiffIn, pg8::SplitOrderT<16>, true, true>(L + RING_OFF, g, S, E);
    }
    SEAM(9);
    if (IN(11)) { PTRS; attention_phase(A, (char*)lds, ctl + CW_ATTQ, wv); }
    SEAM(11);
    if (IN(12)) { TIDS; ENV; ARGSL; diff_combine_phase(A, vcu, G, wave, lane); }
    SEAM(12);
    if (IN(13)) {
        PTRS; ENV;
        pg8::Gemm g{HA, (const bf16*)(ws + WS_W_DOUT), MR, DM, DM}; pg8::SplitOrder S; S.init(MR, DM, g.K, G, bx, vcu, (float*)(ws + WS_SLAB), (unsigned*)(ctl + CW_SKF + 5 * 4096), SPLIT_5, wv);
        EpiResid<true> E{X1, X1, X1, XB, ss3};
        pg8::gemm_phase<EpiResid<true>, pg8::SplitOrder, true, true>(L + RING_OFF, g, S, E);
    }
    SEAM(13);
    if (IN(14)) {
        PTRS; ENV;
        pg8::Gemm g{XB, (const bf16*)(ws + WS_W_UP1), MR, NUP, DM}; pg8::SplitOrder S; S.init(MR, NUP, g.K, G, bx, vcu, (float*)(ws + WS_SLAB), (unsigned*)(ctl + CW_SKF + 6 * 4096), SPLIT_6, wv);
        EpiUp E{ws, ss3, out + O_CP + 2 * DFF, out + O_CS + (size_t)16 * 2 * DFF, A.in[22] + 3 * DFF, A.in[23] + DFF};
        pg8::gemm_phase<EpiUp, pg8::SplitOrder, true, true>(L + RING_OFF, g, S, E);
    }
    SEAM(14);
    if (IN(15)) { TIDS; ENV; ARGSL; conv_fix_phase(A, 1, vcu, G, tid); }
    SEAM(15);
    if (IN(16)) {
        PTRS; ENV;
        pg8::Gemm g{ACT, (const bf16*)(ws + WS_W_DN1), MR, DM, DFF}; pg8::SplitOrder S; S.init(MR, DM, g.K, G, bx, vcu, (float*)(ws + WS_SLAB), (unsigned*)(ctl + CW_SKF + 7 * 4096), SPLIT_7, wv);
        EpiResid<false> E{X1, X1, out + O_Y, nullptr, nullptr};
        pg8::gemm_phase<EpiResid<false>, pg8::SplitOrder, true, true>(L + RING_OFF, g, S, E);
    }
#if defined(XPROBE)
    {
        { BAROBJ; xcd_barrier(bar); }
        unsigned long long tx0 = __builtin_amdgcn_s_memrealtime();
        { PTRS; ENV;
          const att::bf16* QN = (const att::bf16*)(ws + WS_QH); const att::bf16* KN = (const att::bf16*)(ws + WS_KH); const att::bf16* VBn = (const att::bf16*)(ws + WS_VH);
          float* OA0 = (float*)(ws + WS_OA); float* OA1 = OA0 + (size_t)MR * DM;
#if XPROBE_VAR >= 9
          {
            constexpr int K_ = XPROBE_VAR >= 20 ? 0 : XPROBE_VAR - 10; constexpr int SV_ = XPROBE_VAR >= 20 ? XPROBE_VAR - 20 : 0;     const int li = (int)(blockIdx.x >> 3), x = (int)(blockIdx.x & 7);
            if (XPROBE_VAR == 13) { const int u = li & 15; att::attn_sample_unit(QN, KN, VBn, A.in[3], A.in[4], OA0, OA1, 2 * x + (u >> 3), u & 7, (char*)lds, wv); }
            else if (XPROBE_VAR >= 10 && li < (16 >> K_)) {
#pragma unroll 1
              for (int r = 0; r < (1 << K_); ++r) { const int u = li + r * (16 >> K_); att::attn_sample_unit<SV_>(QN, KN, VBn, A.in[3], A.in[4], OA0, OA1, 2 * x + (u >> 3), u & 7, (char*)lds, wv); }
            }
          }
#else
          for (int p = vcu; p < 256; p += G) {
#pragma unroll 1
            for (int half = 0; half < 2; ++half) { const int hc = p >> 4, pr = p & 15, h = hc >> 1, c = hc & 1, qb = half ? 31 - pr : pr; const size_t qoff = (size_t)qb * 256 * DM + h * 256;
              att::attn_wide_body<XPROBE_VAR>(QN + qoff + c * 128, KN + h * 256 + c * 128, VBn + h * 256, (c ? OA1 : OA0) + qoff, 4 * qb + 4, 4 * qb + (wv >> 1), (char*)lds, wv); } }
#endif
        }
        { BAROBJ; xcd_barrier(bar); }
        if (blockIdx.x == 0 && wv == 0 && lane_id() == 0) { const unsigned long long w_ = __builtin_amdgcn_s_memrealtime() - tx0, t0_ = __builtin_amdgcn_s_memrealtime(); while (__builtin_amdgcn_s_memrealtime() - t0_ < w_) __builtin_amdgcn_s_sleep(32); }
    }
#endif
    if (PROBE_MASK && blockIdx.x == 0 && wv == 0 && lane_id() == 0) { if ((PROBE_MASK >> 16) & 1) PR_WORDS[1] += __builtin_amdgcn_s_memrealtime() - PR_WORDS[0];
        const unsigned long long t0_ = __builtin_amdgcn_s_memrealtime(), w_ = PR_WORDS[1]; while (__builtin_amdgcn_s_memrealtime() - t0_ < w_) __builtin_amdgcn_s_sleep(32); }
#undef IN
#undef SEAM
}

#ifndef MK_PER_PHASE
#define MK_PER_PHASE 0
#endif
extern "C" void kernel_launch(void* const* d_in, const int* in_sizes, int n_in, void* d_out, int out_size, void* d_ws, size_t ws_size, hipStream_t stream) {
    static int grid = 0;
    if (grid == 0) {
        if (n_in != 25 || out_size != (int)O_END || ws_size < WS_END) { fprintf(stderr, "kernel_launch: built for 25 inputs, %zu outputs, >= %zu bytes of workspace; got n_in %d, out %d, ws %zu; nothing launched\n", (size_t)O_END, (size_t)WS_END, n_in, out_size, ws_size); grid = -1; return; }
        int dev = 0, cus = 0, per_cu = 0;
        if (hipGetDevice(&dev) != hipSuccess || hipDeviceGetAttribute(&cus, hipDeviceAttributeMultiprocessorCount, dev) != hipSuccess) { fprintf(stderr, "kernel_launch: device query failed\n"); grid = -1; return; }
        if (hipFuncSetAttribute((const void*)fwd_kernel, hipFuncAttributeMaxDynamicSharedMemorySize, LDS_BYTES) != hipSuccess) { fprintf(stderr, "kernel_launch: hipFuncSetAttribute failed\n"); grid = -1; return; }
        if (hipOccupancyMaxActiveBlocksPerMultiprocessor(&per_cu, (const void*)fwd_kernel, NWAVES * 64, LDS_BYTES) != hipSuccess || per_cu < 1)
            fprintf(stderr, "kernel_launch: note: occupancy query reports %d workgroups per CU\n", per_cu);
        (void)hipGetLastError();
        grid = cus;
    }
    if (grid < 0) return;
    if (hipMemsetAsync((char*)d_ws + WS_CTL, 0, CTL_ZERO_BYTES, stream) != hipSuccess) { fprintf(stderr, "kernel_launch: memset failed\n"); return; }
    Args a{};
    for (int i = 0; i < 25; ++i) a.in[i] = (const float*)d_in[i];
    a.out = (float*)d_out; a.ws = (unsigned char*)d_ws;
#if MK_PER_PHASE
    for (int ph = 0; ph < NPH; ++ph) { a.ph_lo = ph; a.ph_hi = ph + 1; hipLaunchKernelGGL(fwd_kernel, dim3(grid), dim3(NWAVES * 64), LDS_BYTES, stream, a); }
#else
    a.ph_lo = 0; a.ph_hi = NPH; hipLaunchKernelGGL(fwd_kernel, dim3(grid), dim3(NWAVES * 64), LDS_BYTES, stream, a);
#endif
    const hipError_t le = hipPeekAtLastError();
    if (le != hipSuccess) fprintf(stderr, "kernel_launch: launch failed: %s\n", hipGetErrorName(le));
}
```

```cpp
#include <hip/hip_runtime.h>
#include <hip/hip_bf16.h>
#include <cstdio>
#include <cstdint>
#include <cmath>

constexpr int DM = 2048;
constexpr int MP = 8192, MS = 1024;
constexpr int MR = MP + MS;
constexpr int DFF = 5632, NUP = 2 * DFF;
constexpr int NHG = 4 * DM;
constexpr int NDI = 3 * DM;
constexpr int NCH = MR / 64;
constexpr int NCHP = MP / 64;
constexpr int PAST = 4096;
constexpr float EPS = 1e-6f;
constexpr float LAM_INIT = 0.35550906759f;

constexpr size_t O_Y = 0;
constexpr size_t O_HP = (size_t)MR * DM;
constexpr size_t O_HS = O_HP + 16 * 128 * 128;
constexpr size_t O_KP = O_HS + (size_t)16 * 16 * 128 * 128;
constexpr size_t O_VP = O_KP + (size_t)MP * DM;
constexpr size_t O_KS = O_VP + (size_t)MP * DM;
constexpr size_t O_VS = O_KS + (size_t)MS * DM;
constexpr size_t O_CP = O_VS + (size_t)MS * DM;
constexpr size_t O_CS = O_CP + 2 * 2 * DFF;
constexpr size_t O_END = O_CS + (size_t)2 * 16 * 2 * DFF;
static_assert(O_END == 61462528, "output size");

constexpr size_t MiB = 1u << 20;
constexpr size_t WS_CTL = 0, CTL_ZERO_BYTES = 1 * MiB;
constexpr size_t WS_SMALL = 1 * MiB;
constexpr size_t WS_W_HIN = 2 * MiB, WS_W_HOUT = 34 * MiB, WS_W_UP0 = 42 * MiB, WS_W_DN0 = 86 * MiB, WS_W_DIN = 108 * MiB, WS_W_DOUT = 132 * MiB, WS_W_UP1 = 140 * MiB, WS_W_DN1 = 184 * MiB;
constexpr size_t WS_XB = 206 * MiB, WS_QH = 242 * MiB, WS_KH = 278 * MiB, WS_VH = 314 * MiB, WS_SG = 350 * MiB, WS_G = 386 * MiB;
constexpr size_t WS_LST = 458 * MiB, WS_DC = 602 * MiB, WS_SIN = 604 * MiB, WS_HA = 676 * MiB, WS_X1 = 712 * MiB, WS_GU = 784 * MiB, WS_ACT = 982 * MiB;
constexpr size_t WS_QKR = 1081 * MiB, WS_OA = 1153 * MiB, WS_SLAB = 1297 * MiB, WS_END = 1329 * MiB;
constexpr int CW_TMO = 0;
constexpr int CW_ATTQ = 2048;
constexpr int CW_BAR = 4096;
constexpr int CW_SKF = 131072;
constexpr int CW_SS1 = 65536, CW_SS2 = 65536 + 16384, CW_SS3 = 65536 + 2 * 16384;
constexpr int SM_RINV0 = 0, SM_LB = 16384, SM_LAM = 16384 + 4096;

constexpr int RING_OFF = 0, RING_BYTES = 131072;
constexpr int SCR_OFF = RING_BYTES;
constexpr int LDSCTL_OFF = RING_BYTES + 8192, MISC_OFF = LDSCTL_OFF + 320;
constexpr int LDS_BYTES = 147456;
constexpr int NWAVES = 8;

#define GAS __attribute__((address_space(1)))
#define LAS __attribute__((address_space(3)))
typedef unsigned short bf16;
typedef unsigned v4u __attribute__((ext_vector_type(4)));
typedef unsigned v2u __attribute__((ext_vector_type(2)));
typedef float f32x4 __attribute__((ext_vector_type(4)));
typedef float f32x2 __attribute__((ext_vector_type(2)));
typedef float f32x16 __attribute__((ext_vector_type(16)));
typedef short bf16x8 __attribute__((ext_vector_type(8)));
typedef short s16x4 __attribute__((ext_vector_type(4)));
typedef GAS unsigned gu32;
#define RLX_AGENT __ATOMIC_RELAXED, __HIP_MEMORY_SCOPE_AGENT
#define LDS_WAIT() asm volatile("s_waitcnt lgkmcnt(0)" ::: "memory")
#define VM_WAIT() asm volatile("s_waitcnt vmcnt(0)" ::: "memory")
__device__ __forceinline__ unsigned f2bf(float f) { unsigned u = __builtin_bit_cast(unsigned, f); return (u + 0x7fffu + ((u >> 16) & 1u)) >> 16; }
__device__ __forceinline__ unsigned pk2(float lo, float hi) { return f2bf(lo) | (f2bf(hi) << 16); }
__device__ __forceinline__ unsigned cvtpk(float lo, float hi) { unsigned r; asm volatile("v_cvt_pk_bf16_f32 %0, %1, %2" : "=v"(r) : "v"(lo), "v"(hi)); return r; }
__device__ __forceinline__ float bflo(unsigned w) { return __uint_as_float(w << 16); }
__device__ __forceinline__ float bfhi(unsigned w) { return __uint_as_float(w & 0xffff0000u); }
__device__ __forceinline__ float wave_sum(float v) {
#pragma unroll
    for (int o = 1; o < 64; o <<= 1) v += __shfl_xor(v, o);
    return v;
}
__device__ __forceinline__ int lane_id() { int r; asm volatile("v_mbcnt_lo_u32_b32 %0, -1, 0\n\tv_mbcnt_hi_u32_b32 %0, -1, %0" : "=v"(r)); return r; }
__device__ __forceinline__ float sigmoidf_(float z) { return __builtin_amdgcn_rcpf(1.f + __expf(-z)); }
namespace pg8 {
#define PG8_LAS __attribute__((address_space(3)))
typedef unsigned short bf16_t;
typedef short bf16x8 __attribute__((ext_vector_type(8)));
typedef float f32x4 __attribute__((ext_vector_type(4)));
typedef unsigned u32x4 __attribute__((ext_vector_type(4)));
constexpr int BM = 256, BK = 64, HALF = 128, HTB = HALF * BK * 2  , STAGE_BYTES = 8 * HTB, NXCD = 8, WGM = 8;

__host__ __device__ __forceinline__ int lds_byte(int r, int c) { const int st = (r >> 4) * 2 + (c >> 5), rr = r & 15, cc = c & 31, ob = rr * 64 + cc * 2; return st * 1024 + (ob ^ (((ob >> 9) & 1) << 5)); }
__host__ __device__ __forceinline__ void stage_rc(int b, int& R, int& C) { const int st = b / 1024, sb = b % 1024, swz = sb ^ (((sb >> 9) & 1) << 5); R = (st >> 1) * 16 + swz / 64; C = (st & 1) * 32 + (swz % 64) / 2; }
__host__ __device__ __forceinline__ int perm32(int rho) { const int n = rho >> 4, i = rho & 15; return 8 * (i >> 2) + 4 * n + (i & 3); }

struct Unit { int pm, pn; int k0, nk, mode, tt, sj, ss; };
struct Gemm { const bf16_t* A; const bf16_t* Bt; int M, N, K; };

struct StaticOrder {
    int nM, nN, nwg, G, c;
    __host__ __device__ void init(int M, int N, int G_, int c_) { nM = M / BM; nN = N / BM; nwg = nM * nN; G = G_; c = c_; }
    __host__ __device__ bool next(int i, Unit& u) const {
        const long L = (long)i * G + c; if (L >= nwg) return false;
        int wgid = (int)L; { const int q = nwg / NXCD, r = nwg % NXCD, xcd = wgid % NXCD, off = wgid / NXCD; wgid = (xcd < r ? xcd * (q + 1) : r * (q + 1) + (xcd - r) * q) + off; }
        const int nig = WGM * nN, gid = wgid / nig, fm = gid * WGM, gsz = (nM - fm) < WGM ? (nM - fm) : WGM;
        u.pm = fm + ((wgid % nig) % gsz); u.pn = (wgid % nig) / gsz; return true;
    }
    __device__ __forceinline__ void a_ready(const Unit&) const {}
    __device__ __forceinline__ void done(const Unit&) const {}
};

__device__ __forceinline__ unsigned cvt_pk_bf16(float lo, float hi) { unsigned r; asm volatile("v_cvt_pk_bf16_f32 %0, %1, %2" : "=v"(r) : "v"(lo), "v"(hi)); return r; }
typedef float f32x2 __attribute__((ext_vector_type(2)));
template <int nN1>
struct SplitOrderT {
    int nM, nN, nwg, G, c, vc, R, r, s, npairs, wv; float* slab; unsigned* flags;
    __device__ __forceinline__ void init(int M, int N, int K, int G_, int c_, int vc_, float* slab_, unsigned* flags_, int smax, int wv_) { wv = wv_;
        nM = M / BM; nN = N / BM; nwg = nM * nN; G = __builtin_amdgcn_readfirstlane(G_); c = __builtin_amdgcn_readfirstlane(c_); vc = __builtin_amdgcn_readfirstlane(vc_); R = nwg / G;
        r = nwg - R * G; s = r ? G / r : 1; if (s > smax) s = smax; if (nN1 > 0 && !(r == 96 && G == 256 && s == 2)) s = 0; npairs = K / (2 * BK); slab = slab_; flags = flags_; }
    __device__ __forceinline__ void tile(int L, Unit& u) const {
        int nNg = nN, nwgg = nwg, pn0 = 0;
        if (nN1 > 0) { if (L >= nM * nN1) { L -= nM * nN1; nNg = nN - nN1; pn0 = nN1; } else nNg = nN1; nwgg = nM * nNg; }
        int wgid = L; { const int q = nwgg / NXCD, rr = nwgg % NXCD, xcd = wgid % NXCD, off = wgid / NXCD; wgid = (xcd < rr ? xcd * (q + 1) : rr * (q + 1) + (xcd - rr) * q) + off; }
        const int nig = WGM * nNg, gid = wgid / nig, fm = gid * WGM, gsz = (nM - fm) < WGM ? (nM - fm) : WGM;
        u.pm = fm + ((wgid % nig) % gsz); u.pn = pn0 + (wgid % nig) / gsz; }
    static constexpr int MIX3 = 64;
    __device__ __forceinline__ bool mixed() const { return nN1 > 0; }
    __device__ __forceinline__ bool has_slice() const { return s > 0 && vc < (mixed() ? 256 : r * s); }
    __device__ __forceinline__ void slice(Unit& u) const {
        int tt = vc / s, j = vc - tt * s, sl = s;
        if (mixed()) { const int hi3 = vc < 3 * MIX3; tt = __builtin_amdgcn_readfirstlane(hi3 ? (vc & 63) : MIX3 + (vc & 31)); j = __builtin_amdgcn_readfirstlane(hi3 ? (vc >> 6) : ((vc >> 5) & 1)); sl = __builtin_amdgcn_readfirstlane(hi3 ? 3 : 2); }
        tile(R * G + tt, u);
        const int p0 = (j * npairs) / sl, p1 = ((j + 1) * npairs) / sl; u.k0 = 2 * p0; u.nk = 2 * (p1 - p0); u.mode = 3; u.tt = tt; u.sj = j; u.ss = sl; }
    __device__ __forceinline__ bool next(int i_, Unit& u) const {
        int i = __builtin_amdgcn_readfirstlane(i_);
        if (has_slice()) { if (i == 0) { slice(u); return true; } --i; }
        if (i < R) { tile(i * G + c, u); u.k0 = 0; u.nk = 2 * npairs; u.mode = 0; u.tt = 0; u.sj = 0; u.ss = 1; return true; }
        if (i > R || s > 0 || c >= r) return false;
        tile(R * G + c, u); u.k0 = 0; u.nk = 2 * npairs; u.mode = 0; u.tt = 0; u.sj = 0; u.ss = 1; return true;
    }
    __device__ __forceinline__ void a_ready(const Unit&) const {}
    __device__ __forceinline__ void done(const Unit&) const {}
    template <class Epi>
    __device__ __forceinline__ bool pre(f32x4 (&acc)[2][2][4][2], const Unit& u, int wid, int lane, const Epi& E) const {
        if (u.mode == 0) return true;
        const __amdgpu_buffer_rsrc_t rs = __builtin_amdgcn_make_buffer_rsrc((void*)slab, (short)0, 256 * 131072, 0x00020000);
        {
            unsigned off = (unsigned)vc * 131072u + (unsigned)wid * 16384u + (unsigned)lane * 16u;
#pragma unroll
            for (int ai = 0; ai < 2; ++ai)
#pragma unroll
                for (int m = 0; m < 4; ++m)
#pragma unroll
                    for (int bj = 0; bj < 2; ++bj) { const f32x4 a = acc[ai][bj][m][0], b = acc[ai][bj][m][1];
                        u32x4 w; w.x = cvt_pk_bf16(a[0], a[1]); w.y = cvt_pk_bf16(a[2], a[3]); w.z = cvt_pk_bf16(b[0], b[1]); w.w = cvt_pk_bf16(b[2], b[3]);
                        __builtin_amdgcn_raw_buffer_store_b128(w, rs, off + (unsigned)(((ai * 4 + m) * 2 + bj) * 1024), 0, 16); }
            asm volatile("s_waitcnt vmcnt(0)" ::: "memory");
        }
        __builtin_amdgcn_s_barrier();
        if (wid == 0 && lane == 0) __hip_atomic_fetch_add(flags + 32 * u.tt, 1u, __ATOMIC_RELAXED, __HIP_MEMORY_SCOPE_AGENT);
        return false;
    }
    template <class Epi>
    __device__ __forceinline__ void post(const Epi& E, int wid, int lane) const {
        if (!has_slice()) return;
        Unit u; slice(u);
        const __amdgpu_buffer_rsrc_t rs = __builtin_amdgcn_make_buffer_rsrc((void*)slab, (short)0, 256 * 131072, 0x00020000);
        if (wid == 0) {
            const unsigned* fl = flags + 32 * u.tt; const unsigned want = (unsigned)u.ss; unsigned spins = 0;
            while ((unsigned)__builtin_amdgcn_readfirstlane(__hip_atomic_load(fl, __ATOMIC_RELAXED, __HIP_MEMORY_SCOPE_AGENT)) < want) { __builtin_amdgcn_s_sleep(16); if (++spins > (1u << 20)) break; }
        }
        __builtin_amdgcn_s_barrier();
        asm volatile("" ::: "memory");
        const int fr = lane & 15, fq = lane >> 4;
        const int sbase = !mixed() ? u.tt * u.ss : (u.ss == 3 ? u.tt : 192 + (u.tt - MIX3)); const unsigned sstr = !mixed() ? 131072u : (u.ss == 3 ? 64u * 131072u : 32u * 131072u);
        for (int p = u.sj; p < 8; p += u.ss) {
            f32x4 vv[2][2];
#pragma unroll
            for (int gg = 0; gg < 2; ++gg) {
                const int g = 2 * wid + gg;
                const unsigned off = (unsigned)sbase * 131072u + (unsigned)p * 16384u + (unsigned)g * 1024u + (unsigned)lane * 16u;
                u32x4 t[8];
#pragma unroll
                for (int jp = 0; jp < 8; ++jp) if (jp < u.ss) t[jp] = __builtin_amdgcn_raw_buffer_load_b128(rs, off + (unsigned)jp * sstr, 0, 16);
                f32x4 v0 = {0.f, 0.f, 0.f, 0.f}, v1 = {0.f, 0.f, 0.f, 0.f};
#pragma unroll
                for (int jp = 0; jp < 8; ++jp) if (jp < u.ss) {
                    v0 += (f32x4){__uint_as_float(t[jp].x << 16), __uint_as_float(t[jp].x & 0xffff0000u), __uint_as_float(t[jp].y << 16), __uint_as_float(t[jp].y & 0xffff0000u)};
                    v1 += (f32x4){__uint_as_float(t[jp].z << 16), __uint_as_float(t[jp].z & 0xffff0000u), __uint_as_float(t[jp].w << 16), __uint_as_float(t[jp].w & 0xffff0000u)}; }
                vv[gg][0] = v0; vv[gg][1] = v1;
                if constexpr (!Epi::PAIR) E.group(u, p >> 2, p & 3, fr, fq, g >> 3, (g >> 1) & 3, g & 1, v0, v1);
            }
            if constexpr (Epi::PAIR) E.group2(u, p >> 2, p & 3, fr, fq, wid >> 2, wid & 3, vv[0][0], vv[0][1], vv[1][0], vv[1][1]);
        }
    }
};
typedef SplitOrderT<0> SplitOrder;
template <class Epi, class Sched, bool ALIGN_EPI = false, bool SP2 = false>
__device__ __forceinline__ void gemm_phase(PG8_LAS unsigned char* lds, const Gemm g, const Sched& S, const Epi& E) {
    const int wid = S.wv, lane = lane_id(), tid = wid * 64 + lane, wr = wid >> 2, wc = wid & 3, fr = lane & 15, fq = lane >> 4;
    const int K = g.K;
    unsigned voffA[2], voffB[2];
#pragma unroll
    for (int i = 0; i < 2; ++i) { int R, C; stage_rc(tid * 16 + i * 8192, R, C); const int Rb = Epi::PERM ? ((R & ~31) + perm32(R & 31)) : R;
        voffA[i] = (unsigned)(R * K + C) * 2u; voffB[i] = (unsigned)(Rb * K + C) * 2u; }
    const size_t kstep = (size_t)(BK * 2);
    const size_t hstep = (size_t)HALF * K * 2;
    const size_t tstep = 2 * hstep;
    const unsigned ldsw = (unsigned)wid * 1024u;
    const int aoff = lds_byte(wr * 64 + fr, fq * 8), boff = lds_byte(wc * 32 + fr, fq * 8);
#define PG8_SA(b, h) (((b) * 2 + (h)) * HTB)
#define PG8_SB(b, h) ((4 + (b) * 2 + (h)) * HTB)
#define PG8_STAGE(bufoff, gbase, voff) do { _Pragma("unroll") for (int _i = 0; _i < 2; ++_i) \
        __builtin_amdgcn_global_load_lds((const unsigned*)((const char*)(gbase) + (voff)[_i]), (PG8_LAS unsigned*)(lds + (bufoff) + ldsw + _i * 8192), 16, 0, 0); } while (0)
#define PG8_LDA(dst, b, h) do { _Pragma("unroll") for (int m = 0; m < 4; ++m) _Pragma("unroll") for (int k = 0; k < 2; ++k) dst[m][k] = *(const PG8_LAS bf16x8*)(lds + PG8_SA(b, h) + aoff + m * 2048 + k * 1024); } while (0)
#define PG8_LDB(dst, b, h) do { _Pragma("unroll") for (int n = 0; n < 2; ++n) _Pragma("unroll") for (int k = 0; k < 2; ++k) dst[n][k] = *(const PG8_LAS bf16x8*)(lds + PG8_SB(b, h) + boff + n * 2048 + k * 1024); } while (0)
#define PG8_MMA(ai, bj, At, Bt) do { __builtin_amdgcn_s_setprio(1); _Pragma("unroll") for (int m = 0; m < 4; ++m) _Pragma("unroll") for (int n = 0; n < 2; ++n) _Pragma("unroll") for (int k = 0; k < 2; ++k) \
        acc[ai][bj][m][n] = __builtin_amdgcn_mfma_f32_16x16x32_bf16(Bt[n][k], At[m][k], acc[ai][bj][m][n], 0, 0, 0); __builtin_amdgcn_s_setprio(0); } while (0)
#define PG8_WAIT_V(n) asm volatile("s_waitcnt vmcnt(" #n ")" ::: "memory")
#define PG8_WAIT_L(n) asm volatile("s_waitcnt lgkmcnt(" #n ")" ::: "memory")
#define PG8_BAR __builtin_amdgcn_s_barrier()
#define PG8_SCHED __builtin_amdgcn_sched_barrier(0)
    Unit cur, nxt; int ui = 0;
    if (!S.next(0, cur)) return;
    f32x4 acc[2][2][4][2];
#pragma unroll
    for (int a = 0; a < 2; ++a)
#pragma unroll
        for (int b = 0; b < 2; ++b)
#pragma unroll
            for (int m = 0; m < 4; ++m)
#pragma unroll
                for (int n = 0; n < 2; ++n) acc[a][b][m][n] = (f32x4){0.f, 0.f, 0.f, 0.f};
    bf16x8 At[4][2], B0[2][2], B1[2][2];
    const char* cA = (const char*)g.A + (size_t)cur.pm * tstep + (size_t)cur.k0 * kstep; const char* cB = (const char*)g.Bt + (size_t)cur.pn * tstep + (size_t)cur.k0 * kstep;
    S.a_ready(cur);
    if constexpr (SP2) {
        PG8_STAGE(PG8_SB(0, 0), cB, voffB); PG8_STAGE(PG8_SB(0, 1), cB + hstep, voffB); PG8_STAGE(PG8_SA(0, 0), cA, voffA); PG8_STAGE(PG8_SA(0, 1), cA + hstep, voffA);
        if (wr == 1) PG8_BAR;
        PG8_WAIT_V(2); PG8_BAR;
        PG8_STAGE(PG8_SB(1, 0), cB + kstep, voffB); PG8_STAGE(PG8_SA(1, 0), cA + kstep, voffA); PG8_STAGE(PG8_SB(1, 1), cB + hstep + kstep, voffB);
        PG8_WAIT_V(6); PG8_BAR;
    } else {
        PG8_STAGE(PG8_SB(0, 0), cB, voffB); PG8_STAGE(PG8_SA(0, 0), cA, voffA); PG8_STAGE(PG8_SB(0, 1), cB + hstep, voffB); PG8_STAGE(PG8_SA(0, 1), cA + hstep, voffA);
        if (wr == 1) PG8_BAR;
        PG8_WAIT_V(4); PG8_BAR;
        PG8_STAGE(PG8_SB(1, 0), cB + kstep, voffB); PG8_STAGE(PG8_SA(1, 0), cA + kstep, voffA); PG8_STAGE(PG8_SB(1, 1), cB + hstep + kstep, voffB);
        PG8_WAIT_V(6); PG8_BAR;
    }
    for (;;) {
        const bool has_next = S.next(ui + 1, nxt);
        const char* nA = has_next ? (const char*)g.A + (size_t)nxt.pm * tstep + (size_t)nxt.k0 * kstep : cA; const char* nB = has_next ? (const char*)g.Bt + (size_t)nxt.pn * tstep + (size_t)nxt.k0 * kstep : cB;
        const int nt = cur.nk;
        for (int t = 0; t < nt; t += 2) {
            const bool last = (t == nt - 2);
            const char* a1 = cA + (size_t)(t + 1) * kstep;
            const char* a2 = last ? nA : cA + (size_t)(t + 2) * kstep; const char* b2 = last ? nB : cB + (size_t)(t + 2) * kstep;
            const char* a3 = a2 + kstep; const char* b3 = b2 + kstep;
            if (last && has_next) S.a_ready(nxt);
            if constexpr (SP2) {
            PG8_LDB(B0, 0, 0); PG8_LDB(B1, 0, 1); PG8_SCHED; PG8_LDA(At, 0, 0); PG8_STAGE(PG8_SA(1, 1), a1 + hstep, voffA);
            PG8_WAIT_V(8); PG8_WAIT_L(0); PG8_BAR; PG8_MMA(0, 0, At, B0); PG8_MMA(0, 1, At, B1); PG8_BAR; PG8_SCHED;
            PG8_LDA(At, 0, 1); PG8_STAGE(PG8_SB(0, 0), b2, voffB); PG8_STAGE(PG8_SB(0, 1), b2 + hstep, voffB); PG8_STAGE(PG8_SA(0, 0), a2, voffA);
            PG8_WAIT_V(8); PG8_WAIT_L(0); PG8_BAR; PG8_MMA(1, 0, At, B0); PG8_MMA(1, 1, At, B1); PG8_BAR; PG8_SCHED;
            PG8_LDB(B0, 1, 0); PG8_LDB(B1, 1, 1); PG8_SCHED; PG8_LDA(At, 1, 0); PG8_STAGE(PG8_SA(0, 1), a2 + hstep, voffA);
            PG8_WAIT_V(8); PG8_WAIT_L(0); PG8_BAR; PG8_MMA(0, 0, At, B0); PG8_MMA(0, 1, At, B1); PG8_BAR; PG8_SCHED;
            PG8_LDA(At, 1, 1); PG8_STAGE(PG8_SB(1, 0), b3, voffB); PG8_STAGE(PG8_SB(1, 1), b3 + hstep, voffB); PG8_STAGE(PG8_SA(1, 0), a3, voffA);
            PG8_WAIT_V(8); PG8_WAIT_L(0); PG8_BAR; PG8_MMA(1, 0, At, B0); PG8_MMA(1, 1, At, B1); PG8_BAR; PG8_SCHED;
            } else {
            PG8_LDB(B0, 0, 0); PG8_SCHED; PG8_LDA(At, 0, 0); PG8_STAGE(PG8_SA(1, 1), a1 + hstep, voffA);
            PG8_WAIT_L(8); PG8_BAR; PG8_WAIT_L(0); PG8_MMA(0, 0, At, B0); PG8_BAR; PG8_SCHED;
            PG8_LDB(B1, 0, 1); PG8_STAGE(PG8_SB(0, 0), b2, voffB);
            PG8_BAR; PG8_WAIT_L(0); PG8_MMA(0, 1, At, B1); PG8_BAR;
            PG8_LDA(At, 0, 1); PG8_STAGE(PG8_SA(0, 0), a2, voffA);
            PG8_BAR; PG8_WAIT_L(0); PG8_MMA(1, 0, At, B0); PG8_BAR; PG8_SCHED;
            PG8_STAGE(PG8_SB(0, 1), b2 + hstep, voffB);
            PG8_WAIT_V(6); PG8_BAR; PG8_MMA(1, 1, At, B1); PG8_BAR;
            PG8_LDB(B0, 1, 0); PG8_SCHED; PG8_LDA(At, 1, 0); PG8_STAGE(PG8_SA(0, 1), a2 + hstep, voffA);
            PG8_WAIT_L(8); PG8_BAR; PG8_WAIT_L(0); PG8_MMA(0, 0, At, B0); PG8_BAR; PG8_SCHED;
            PG8_LDB(B1, 1, 1); PG8_STAGE(PG8_SB(1, 0), b3, voffB);
            PG8_BAR; PG8_WAIT_L(0); PG8_MMA(0, 1, At, B1); PG8_BAR;
            PG8_LDA(At, 1, 1); PG8_STAGE(PG8_SA(1, 0), a3, voffA);
            PG8_BAR; PG8_WAIT_L(0); PG8_MMA(1, 0, At, B0); PG8_BAR; PG8_SCHED;
            PG8_STAGE(PG8_SB(1, 1), b3 + hstep, voffB);
            PG8_WAIT_V(6); PG8_BAR; PG8_MMA(1, 1, At, B1); PG8_BAR;
            }
        }
        if constexpr (ALIGN_EPI) { if (wr == 0) PG8_BAR; }
        if constexpr (!Epi::AFTER_DRAIN) { if (S.pre(acc, cur, wid, lane, E)) E(acc, cur, wr, wc, fr, fq); S.done(cur); }
        if (!has_next) break;
#pragma unroll
        for (int a = 0; a < 2; ++a)
#pragma unroll
            for (int b = 0; b < 2; ++b)
#pragma unroll
                for (int m = 0; m < 4; ++m)
#pragma unroll
                    for (int n = 0; n < 2; ++n) acc[a][b][m][n] = (f32x4){0.f, 0.f, 0.f, 0.f};
        cur = nxt; cA = nA; cB = nB; ++ui;
        if constexpr (ALIGN_EPI) { if (wr == 1) PG8_BAR; }
    }
    PG8_WAIT_V(0);
    if constexpr (!ALIGN_EPI) { if (wr == 0) PG8_BAR; }
    PG8_BAR;
    S.post(E, wid, lane);
    if constexpr (Epi::AFTER_DRAIN) { E.fused(acc, cur, wr, wc, fr, fq, lds, wid, lane); S.done(cur); }
#undef PG8_SA
#undef PG8_SB
#undef PG8_STAGE
#undef PG8_LDA
#undef PG8_LDB
#undef PG8_MMA
#undef PG8_WAIT_V
#undef PG8_WAIT_L
#undef PG8_BAR
#undef PG8_SCHED
}
}

#define EPI_ARGS const pg8::f32x4 (&acc)[2][2][4][2], const pg8::Unit& u, int wr, int wc, int fr, int fq
#define EPI_GARGS const pg8::Unit& u, int wr, int wc, int fr, int fq, int ai, int m, int bj, f32x4 v0, f32x4 v1
#define EPI_WALK _Pragma("unroll") for (int ai = 0; ai < 2; ++ai) _Pragma("unroll") for (int m = 0; m < 4; ++m) _Pragma("unroll") for (int bj = 0; bj < 2; ++bj) group(u, wr, wc, fr, fq, ai, m, bj, acc[ai][bj][m][0], acc[ai][bj][m][1]);
__device__ __forceinline__ void st8bf(bf16* p, f32x4 a, f32x4 b) {
    v4u w; w.x = cvtpk(a[0], a[1]); w.y = cvtpk(a[2], a[3]); w.z = cvtpk(b[0], b[1]); w.w = cvtpk(b[2], b[3]); *(v4u*)p = w;
}
__device__ __forceinline__ void st8f(float* p, f32x4 a, f32x4 b) { *(f32x4*)p = a; *(f32x4*)(p + 4) = b; }

struct EpiHgrnIn {
    static constexpr bool PERM = true, AFTER_DRAIN = false, PAIR = false;
    unsigned char* ws;
    __device__ __forceinline__ void group(EPI_GARGS) const {
        bf16* Q = (bf16*)(ws + WS_QH); bf16* V = (bf16*)(ws + WS_VH); bf16* SG = (bf16*)(ws + WS_SG); float* G = (float*)(ws + WS_G);
        const float* rinv = (const float*)(ws + WS_SMALL) + SM_RINV0; const float* lb = (const float*)(ws + WS_SMALL) + SM_LB;
        const int sec = u.pn >> 3, lc = (u.pn & 7) * 256 + bj * 128 + wc * 32 + 8 * fq;
        const int row = u.pm * 256 + ai * 128 + wr * 64 + m * 16 + fr; const float r = rinv[row];
        const size_t off = (size_t)row * DM + lc;
        f32x4 a = v0 * r, b = v1 * r;
        if (sec == 0) st8bf(Q + off, a, b);
        else if (sec == 2) st8bf(V + off, a, b);
        else if (sec == 3) {
#pragma unroll
            for (int i = 0; i < 4; ++i) { a[i] = a[i] * sigmoidf_(a[i]); b[i] = b[i] * sigmoidf_(b[i]); }
            st8bf(SG + off, a, b);
        } else {
            const f32x4 l0 = *(const f32x4*)(lb + lc), l1 = *(const f32x4*)(lb + lc + 4);
            f32x4 ga, gb;
#pragma unroll
            for (int i = 0; i < 4; ++i) {
                const float f0 = l0[i] + (1.f - l0[i]) * sigmoidf_(a[i]), f1 = l1[i] + (1.f - l1[i]) * sigmoidf_(b[i]);
                ga[i] = __logf(f0); gb[i] = __logf(f1);
            }
            st8f(G + off, ga, gb);
        }
    }
    __device__ __forceinline__ void operator()(EPI_ARGS) const { EPI_WALK }
};

template <bool NEXT> struct EpiResid {
    static constexpr bool PERM = true, AFTER_DRAIN = false, PAIR = false;
    const float* xin_p; const float* xin_s;
    float* Xout; bf16* XB; float* ss;
    __device__ __forceinline__ void group(EPI_GARGS) const {
        const float* xin = (u.pm < 32) ? xin_p : xin_s;
        const int row = u.pm * 256 + ai * 128 + wr * 64 + m * 16 + fr;
        const size_t off = (size_t)row * DM + u.pn * 256 + bj * 128 + wc * 32 + 8 * fq;
        const f32x4 a = v0 + *(const f32x4*)(xin + off), b = v1 + *(const f32x4*)(xin + off + 4);
        st8f(Xout + off, a, b);
        if (NEXT) { st8bf(XB + off, a, b);
            float s = (a[0] * a[0] + a[1] * a[1]) + (a[2] * a[2] + a[3] * a[3]) + (b[0] * b[0] + b[1] * b[1]) + (b[2] * b[2] + b[3] * b[3]);
            s += __shfl_xor(s, 16); s += __shfl_xor(s, 32); if (fq == 0) atomicAdd(ss + row, s); }
    }
    __device__ __forceinline__ void operator()(EPI_ARGS) const { EPI_WALK }
};

__device__ __forceinline__ float dpp_shr1(float v) { return __int_as_float(__builtin_amdgcn_update_dpp(0, __float_as_int(v), 0x111, 0xf, 0xf, true)); }
__device__ __forceinline__ float dpp_shr2(float v) { return __int_as_float(__builtin_amdgcn_update_dpp(0, __float_as_int(v), 0x112, 0xf, 0xf, true)); }
struct EpiUp {
    static constexpr bool PERM = true, AFTER_DRAIN = false, PAIR = true;
    unsigned char* ws; const float* ss; float* conv_p; float* conv_s; const float* cw; const float* cb;
    __device__ __forceinline__ void group(EPI_GARGS) const {}
    __device__ __forceinline__ void group2(const pg8::Unit& u, int wr, int wc, int fr, int fq, int ai, int m, f32x4 ga, f32x4 gb, f32x4 ua, f32x4 ub) const {
        bf16* ACT = (bf16*)(ws + WS_ACT); bf16* SGF = (bf16*)(ws + WS_GU); bf16* SGL = SGF + (size_t)(MR / 16) * 4 * DFF;
        int row = u.pm * 256 + ai * 128 + wr * 64 + m * 16 + fr; asm volatile("" : "+v"(row)); const float r = __builtin_amdgcn_rsqf(ss[row] * (1.f / DM) + EPS);
        const int col = u.pn * 128 + wc * 32 + 8 * fq;
        ga = ga * r; gb = gb * r; ua = ua * r; ub = ub * r;
        if (m == 3 && fr >= 14) {
            if (row >= MP) { const int sb = (row - MP) >> 6; st8f(conv_s + ((size_t)sb * 2 + (fr - 14)) * DFF + col, ga, gb); }
            else if (row >= MP - 2) st8f(conv_p + (size_t)(row - (MP - 2)) * DFF + col, ga, gb);
        }
        const int grp = row >> 4;
#define UP_HALF(g_, u_, cofs) do { f32x4 p1_, p2_; _Pragma("unroll") for (int i = 0; i < 4; ++i) { p1_[i] = dpp_shr1(g_[i]); p2_[i] = dpp_shr2(g_[i]); } \
        if (fr >= 2) { const float* wp_ = cw + col + (cofs); asm volatile("" : "+v"(wp_)); \
            f32x4 x_ = *(const f32x4*)(cb + col + (cofs)) + *(const f32x4*)(wp_ + 2 * DFF) * g_ + *(const f32x4*)(wp_ + DFF) * p1_ + *(const f32x4*)(wp_) * p2_; \
            _Pragma("unroll") for (int i = 0; i < 4; ++i) x_[i] = x_[i] * sigmoidf_(x_[i]) * u_[i]; g_##x = x_; } } while (0)
        f32x4 gax = ga, gbx = gb;
        UP_HALF(ga, ua, 0); UP_HALF(gb, ub, 4);
        if (fr >= 2) {
            st8bf(ACT + (size_t)row * DFF + col, gax, gbx);
            if (fr >= 14) st8bf(SGL + ((size_t)grp * 2 + (fr - 14)) * DFF + col, ga, gb);
        } else {
            st8bf(SGF + (((size_t)grp * 2 + fr) * 2 + 0) * DFF + col, ga, gb); st8bf(SGF + (((size_t)grp * 2 + fr) * 2 + 1) * DFF + col, ua, ub);
        }
#undef UP_HALF
    }
    __device__ __forceinline__ void operator()(EPI_ARGS) const {
#pragma unroll
        for (int ai = 0; ai < 2; ++ai)
#pragma unroll
            for (int m = 0; m < 4; ++m) group2(u, wr, wc, fr, fq, ai, m, acc[ai][0][m][0], acc[ai][0][m][1], acc[ai][1][m][0], acc[ai][1][m][1]);
    }
};

struct EpiDiffIn {
    static constexpr bool PERM = true, AFTER_DRAIN = false, PAIR = false;
    unsigned char* ws; float* out; const float* gq; const float* gk; LAS float* P;
    __device__ __forceinline__ void group(EPI_GARGS) const {
        bf16* VB = (bf16*)(ws + WS_VH); const float* ss = (const float*)(ws + WS_CTL) + CW_SS2;
        float* vout = (u.pm < 32) ? out + O_VP : out + O_VS - (size_t)MP * DM;
        int row = u.pm * 256 + ai * 128 + wr * 64 + m * 16 + fr; asm volatile("" : "+v"(row));
        const size_t off = (size_t)row * DM + (u.pn * 256 + wc * 32 + 8 * fq + bj * 128 - 4096);
        const float r_ = __builtin_amdgcn_rsqf(ss[row] * (1.f / DM) + EPS); const f32x4 a = v0 * r_, b = v1 * r_; st8bf(VB + off, a, b); st8f(vout + off, a, b);
    }
    __device__ __forceinline__ void operator()(const pg8::f32x4 (&acc)[2][2][4][2], const pg8::Unit& u, int wr, int wc, int fr_, int fq_) const {
        int t_ = lane_id(); asm volatile("" : "+v"(t_)); const int fr = t_ & 15, fq = (t_ >> 4) & 3; (void)fr_; (void)fq_;
        bf16* QN = (bf16*)(ws + WS_QH); bf16* KN = (bf16*)(ws + WS_KH); bf16* VB = (bf16*)(ws + WS_VH); const float* ss = (const float*)(ws + WS_CTL) + CW_SS2;
        float* vout_p = out + O_VP; float* vout_s = out + O_VS - (size_t)MP * DM; float* kout_p = out + O_KP; float* kout_s = out + O_KS - (size_t)MP * DM;
        const int c0 = u.pn * 256 + wc * 32 + 8 * fq;
#define RS_(ai, m) __builtin_amdgcn_rsqf(ss[u.pm * 256 + (ai) * 128 + wr * 64 + (m) * 16 + fr] * (1.f / DM) + EPS)
        if (u.pn >= 16) {
            float* vout = (u.pm < 32) ? vout_p : vout_s;
#pragma unroll
            for (int ai = 0; ai < 2; ++ai)
#pragma unroll
                for (int m = 0; m < 4; ++m)
#pragma unroll
                    for (int bj = 0; bj < 2; ++bj) { int row = u.pm * 256 + ai * 128 + wr * 64 + m * 16 + fr; asm volatile("" : "+v"(row)); const size_t off = (size_t)row * DM + (c0 + bj * 128 - 4096);
                        const float r_ = __builtin_amdgcn_rsqf(ss[row] * (1.f / DM) + EPS); const f32x4 a = acc[ai][bj][m][0] * r_, b = acc[ai][bj][m][1] * r_; st8bf(VB + off, a, b); st8f(vout + off, a, b); }
            return;
        }
#pragma unroll
        for (int ai = 0; ai < 2; ++ai)
#pragma unroll
            for (int m = 0; m < 4; ++m)
#pragma unroll
                for (int bj = 0; bj < 2; ++bj) { int rl = ai * 128 + wr * 64 + m * 16 + fr; asm volatile("" : "+v"(rl));
                    const float r_ = __builtin_amdgcn_rsqf(ss[u.pm * 256 + rl] * (1.f / DM) + EPS); const f32x4 a = acc[ai][bj][m][0], b = acc[ai][bj][m][1];
                    float q = ((a[0] * a[0] + a[1] * a[1]) + (a[2] * a[2] + a[3] * a[3]) + (b[0] * b[0] + b[1] * b[1]) + (b[2] * b[2] + b[3] * b[3])) * (r_ * r_);
                    q += __shfl_xor(q, 16); q += __shfl_xor(q, 32);
                    if (fq == 0) P[(rl * 2 + bj) * 4 + wc] = q; }
        asm volatile("s_waitcnt lgkmcnt(0)" ::: "memory"); __builtin_amdgcn_s_barrier(); asm volatile("" ::: "memory");
        const bool isk = u.pn >= 8; const float* gn = isk ? gk : gq; bf16* dst = isk ? KN : QN;
        float* kout = (u.pm < 32) ? kout_p : kout_s;
#pragma unroll
        for (int ai = 0; ai < 2; ++ai)
#pragma unroll
            for (int m = 0; m < 4; ++m)
#pragma unroll
                for (int bj = 0; bj < 2; ++bj) { int rl = ai * 128 + wr * 64 + m * 16 + fr; asm volatile("" : "+v"(rl)); const f32x4 pq = *(const LAS f32x4*)(P + (rl * 2 + bj) * 4);
                    const float rn = __builtin_amdgcn_rsqf(((pq[0] + pq[1]) + (pq[2] + pq[3])) * (1.f / 128.f) + EPS) * __builtin_amdgcn_rsqf(ss[u.pm * 256 + rl] * (1.f / DM) + EPS);
                    const float* gp = gn + wc * 32 + 8 * fq; asm volatile("" : "+v"(gp));
                    const f32x4 g0 = *(const f32x4*)gp, g1 = *(const f32x4*)(gp + 4);
                    const f32x4 a = acc[ai][bj][m][0] * rn * g0, b = acc[ai][bj][m][1] * rn * g1;
                    const size_t off = (size_t)(u.pm * 256 + rl) * DM + ((c0 + bj * 128) & 2047);
                    st8bf(dst + off, a, b); if (isk) st8f(kout + off, a, b); }
        asm volatile("s_waitcnt lgkmcnt(0)" ::: "memory"); __builtin_amdgcn_s_barrier(); asm volatile("" ::: "memory");
#undef RS_
    }
};
#define XB_TMO      128
#define XB_XCNT(j)  (256  + 64 * (j))
#define XB_XSUB(j)  (1280 + 64 * (j))
#define XB_XGEN(j)  (2304 + 64 * (j))
#define XB_TOP      3328
#define XB_TOPGEN   3392
#define XCD_BAR_WORDS 3456
#define XB_SPIN_CAP (1u << 18)

__device__ __forceinline__ unsigned xb_ld(unsigned* p)              { return __hip_atomic_load(p, __ATOMIC_RELAXED, __HIP_MEMORY_SCOPE_AGENT); }
__device__ __forceinline__ unsigned xb_add(unsigned* p, unsigned v) { return __hip_atomic_fetch_add(p, v, __ATOMIC_RELAXED, __HIP_MEMORY_SCOPE_AGENT); }
__device__ __forceinline__ unsigned xb_xcc_id() { return (unsigned)__builtin_amdgcn_s_getreg((3 << 11) | 20) & 0xFu; }
#define XB_SPIN(cond, bar) do { unsigned _sp = 0; while (cond) { __builtin_amdgcn_s_sleep(1); \
    if ((++_sp & 255u) == 0u) { if (xb_ld(&(bar)[XB_TMO])) break; if (_sp > XB_SPIN_CAP) { atomicAdd(&(bar)[XB_TMO], 1u); break; } } } } while (0)

#define XB_T0(b) ((b).wv == 0 && lane_id() == 0)
struct XcdBarrier {
    int wv;
    unsigned* bar; unsigned x;
    volatile LAS unsigned* st;
};

__device__ __forceinline__ XcdBarrier xcd_barrier_post(unsigned* bar, volatile LAS unsigned* st, int wv) {
    XcdBarrier b; b.wv = wv; b.bar = bar; b.x = xb_xcc_id(); b.st = st;
    if (XB_T0(b)) (void)xb_add(&bar[XB_XCNT(b.x)], 1u);
    return b;
}
__device__ __forceinline__ void xcd_barrier_complete(unsigned* bar, unsigned x, unsigned& nloc, unsigned& nx) {
    const unsigned G = gridDim.x * gridDim.y * gridDim.z;
    unsigned sum, cnt, mine, sp = 0u;
    for (;;) {
        sum = 0u; cnt = 0u; mine = 0u;
#pragma unroll
        for (unsigned j = 0; j < 16; ++j) { const unsigned c = xb_ld(&bar[XB_XCNT(j)]); sum += c; cnt += (c > 0u) ? 1u : 0u; mine = (j == x) ? c : mine; }
        if (sum == G) break;
        __builtin_amdgcn_s_sleep(1);
        if ((++sp & 255u) == 0u) { if (xb_ld(&bar[XB_TMO])) break; if (sp > XB_SPIN_CAP) { atomicAdd(&bar[XB_TMO], 1u); break; } }
    }
    nloc = mine > 0u ? mine : 1u; nx = cnt > 0u ? cnt : 1u;
}

__device__ __forceinline__ void xcd_barrier(const XcdBarrier& b) {
    asm volatile("s_waitcnt vmcnt(0)" ::: "memory");
    __syncthreads();
    if (XB_T0(b)) {
        unsigned* bar = b.bar;
        __builtin_amdgcn_s_waitcnt(0);
        unsigned nloc = b.st[0], nx = b.st[1];
        if (nloc == 0u) { xcd_barrier_complete(bar, b.x, nloc, nx); b.st[0] = nloc; b.st[1] = nx; }
        const unsigned old = xb_add(&bar[XB_XSUB(b.x)], 1u);
        const unsigned gen = old / nloc;
        if (old + 1u == (gen + 1u) * nloc) {
            __builtin_amdgcn_fence(__ATOMIC_RELEASE, "agent");
            asm volatile("s_waitcnt vmcnt(0)" ::: "memory");
            const unsigned og = xb_add(&bar[XB_TOP], 1u);
            const unsigned tg = og / nx;
            if (og + 1u == (tg + 1u) * nx) xb_add(&bar[XB_TOPGEN], 1u);
            else XB_SPIN(xb_ld(&bar[XB_TOPGEN]) == tg, bar);
            __builtin_amdgcn_fence(__ATOMIC_ACQUIRE, "agent");
            xb_add(&bar[XB_XGEN(b.x)], 1u);
            asm volatile("s_waitcnt vmcnt(0)" ::: "memory");
        } else {
            XB_SPIN(xb_ld(&bar[XB_XGEN(b.x)]) == gen, bar);
            __builtin_amdgcn_fence(__ATOMIC_ACQUIRE, "agent");
            asm volatile("s_waitcnt vmcnt(0)" ::: "memory");
        }
    }
    __syncthreads();
}

namespace att {
using bf16 = __hip_bfloat16;
constexpr int   D = 128, NW = 8, QBLK = 32, KVBLK = 64;
constexpr float SCALE = 0.088388347648318440f;
constexpr float THR = 8.f;
constexpr int SDEPTH = 2;
constexpr int LDQ = 2048, LDK = 2048, LDO = 2048;
constexpr size_t SHM_V = KVBLK * D * 2, SHM_K = KVBLK * D * 2;
#define MASKALL(P0, P1) do { _Pragma("unroll") for (int r_ = 0; r_ < 16; ++r_) { P0[r_] = -INFINITY; P1[r_] = -INFINITY; } } while (0)
using bf16x8 = __attribute__((ext_vector_type(8))) short;
using s16x4  = __attribute__((ext_vector_type(4))) short;
using f32x16 = __attribute__((ext_vector_type(16))) float;
using f32x8  = __attribute__((ext_vector_type(8))) float;
using u32x4  = __attribute__((ext_vector_type(4))) unsigned;
#define KSWZ(row, colB) ((row) * 256 + ((colB) ^ (((row) & 7) << 4)))
#define SBAR() __builtin_amdgcn_sched_barrier(0)
__device__ __forceinline__ int crow(int r, int hi) { return (r & 3) + 8 * (r >> 2) + 4 * hi; }
__device__ __forceinline__ unsigned cvtpk(float lo, float hi) {
  unsigned r; asm volatile("v_cvt_pk_bf16_f32 %0, %1, %2" : "=v"(r) : "v"(lo), "v"(hi)); return r;
}
template <typename TIn> struct Stage;
template <> struct Stage<bf16>  { using T = bf16x8;
  __device__ static __forceinline__ T ld8(const bf16* p) { return *reinterpret_cast<const bf16x8*>(p); }
  __device__ static __forceinline__ bf16x8 tobf(T x) { return x; } };
template <> struct Stage<float> { using T = f32x8;
  __device__ static __forceinline__ T ld8(const float* p) { return *reinterpret_cast<const f32x8*>(p); }
  __device__ static __forceinline__ bf16x8 tobf(T x) {
    u32x4 w = {cvtpk(x[0], x[1]), cvtpk(x[2], x[3]), cvtpk(x[4], x[5]), cvtpk(x[6], x[7])}; return *reinterpret_cast<bf16x8*>(&w); } };

__device__ __forceinline__ void partialSM(f32x16& p0, f32x16& p1, float& m_reg, float& mn, float& alpha) {
  constexpr float C = SCALE * 1.4426950408889634f;
  float pmax = p0[0]; for (int r = 1; r < 16; ++r) pmax = fmaxf(pmax, p0[r]); for (int r = 0; r < 16; ++r) pmax = fmaxf(pmax, p1[r]);
  { auto rr = __builtin_amdgcn_permlane32_swap(__float_as_uint(pmax), __float_as_uint(pmax), false, false);
    pmax = fmaxf(__uint_as_float(rr[0]), __uint_as_float(rr[1])); }
  if (__builtin_expect(__all(pmax - m_reg <= THR / SCALE), 1)) { mn = m_reg; alpha = 1.f; }
  else { mn = fmaxf(m_reg, pmax); alpha = __builtin_amdgcn_exp2f((m_reg - mn) * C); m_reg = mn; }
  float mnC = -mn * C;
  for (int r = 0; r < 16; ++r) p0[r] = fmaf(p0[r], C, mnC); for (int r = 0; r < 16; ++r) p1[r] = fmaf(p1[r], C, mnC);
  for (int r = 0; r < 16; ++r) p0[r] = __builtin_amdgcn_exp2f(p0[r]);
}
__device__ __forceinline__ void finishSM(f32x16& p0, f32x16& p1, float alpha, float& l_reg, bf16x8& pa0, bf16x8& pa1, bf16x8& pa2, bf16x8& pa3) {
  for (int r = 0; r < 16; ++r) p1[r] = __builtin_amdgcn_exp2f(p1[r]);
  float ps = 0; for (int r = 0; r < 16; ++r) ps += p0[r]; for (int r = 0; r < 16; ++r) ps += p1[r];
  { auto rr = __builtin_amdgcn_permlane32_swap(__float_as_uint(ps), __float_as_uint(ps), false, false);
    ps = __uint_as_float(rr[0]) + __uint_as_float(rr[1]); }
  l_reg = l_reg * alpha + ps;
#define PK4(P, BASE, OUT) do { unsigned a0 = cvtpk(P[BASE + 0], P[BASE + 1]), a1 = cvtpk(P[BASE + 2], P[BASE + 3]);   \
    unsigned b0 = cvtpk(P[BASE + 4], P[BASE + 5]), b1 = cvtpk(P[BASE + 6], P[BASE + 7]);                              \
    auto r0 = __builtin_amdgcn_permlane32_swap(a0, b0, false, false); auto r1 = __builtin_amdgcn_permlane32_swap(a1, b1, false, false); \
    u32x4 w = {r0[0], r1[0], r0[1], r1[1]}; OUT = *reinterpret_cast<bf16x8*>(&w); } while (0)
  PK4(p0, 0, pa0); PK4(p0, 8, pa1); PK4(p1, 0, pa2); PK4(p1, 8, pa3);
#undef PK4
}
__device__ __forceinline__ void qkt(f32x16& p0, f32x16& p1, const bf16* Ks, const bf16x8* qr, int r32, int hi) {
  p0 = f32x16{}; p1 = f32x16{};
  for (int d0 = 0; d0 < 8; ++d0) { int cb = (d0 * 16 + hi * 8) * 2;
    bf16x8 b0 = *reinterpret_cast<const bf16x8*>((const char*)Ks + KSWZ(r32, cb));
    bf16x8 b1 = *reinterpret_cast<const bf16x8*>((const char*)Ks + KSWZ(32 + r32, cb));
    p0 = __builtin_amdgcn_mfma_f32_32x32x16_bf16(b0, qr[d0], p0, 0, 0, 0);
    p1 = __builtin_amdgcn_mfma_f32_32x32x16_bf16(b1, qr[d0], p1, 0, 0, 0); }
}
__device__ __forceinline__ int v_st(int k, int c) { const int kk = (k & ~0xC) | ((k & 4) << 1) | ((k & 8) >> 1); return ((kk >> 3) * 4 + (c >> 5)) * 512 + ((kk & 7) * 32 + (c & 31)) * 2; }
__device__ __forceinline__ int v_rd_base(int lane) { return ((lane & 3) << 3) | (((lane >> 2) & 3) << 6) | (((lane >> 4) & 1) << 5) | (((lane >> 5) & 1) << 8); }
constexpr int v_rd_off(int d0, int ks, int half) { return d0 * 512 + ks * 4096 + half * 2048; }
template <int OFF> __device__ __forceinline__ s16x4 tr_read(int vb) {
  s16x4 r; asm volatile("ds_read_b64_tr_b16 %0, %1 offset:%2" : "=&v"(r) : "v"(vb), "i"(OFF) : "memory"); return r;
}
template <int D0> __device__ __forceinline__ void pv_one(f32x16& od, int vb, bf16x8 pa0, bf16x8 pa1, bf16x8 pa2, bf16x8 pa3) {
  const s16x4 l0 = tr_read<v_rd_off(D0, 0, 0)>(vb), h0 = tr_read<v_rd_off(D0, 0, 1)>(vb), l1 = tr_read<v_rd_off(D0, 1, 0)>(vb), h1 = tr_read<v_rd_off(D0, 1, 1)>(vb);
  const s16x4 l2 = tr_read<v_rd_off(D0, 2, 0)>(vb), h2 = tr_read<v_rd_off(D0, 2, 1)>(vb), l3 = tr_read<v_rd_off(D0, 3, 0)>(vb), h3 = tr_read<v_rd_off(D0, 3, 1)>(vb);
  asm volatile("s_waitcnt lgkmcnt(0)" ::: "memory"); SBAR();
#define PK(L, H) (bf16x8){L[0], L[1], L[2], L[3], H[0], H[1], H[2], H[3]}
  od = __builtin_amdgcn_mfma_f32_32x32x16_bf16(pa0, PK(l0, h0), od, 0, 0, 0);
  od = __builtin_amdgcn_mfma_f32_32x32x16_bf16(pa1, PK(l1, h1), od, 0, 0, 0);
  od = __builtin_amdgcn_mfma_f32_32x32x16_bf16(pa2, PK(l2, h2), od, 0, 0, 0);
  od = __builtin_amdgcn_mfma_f32_32x32x16_bf16(pa3, PK(l3, h3), od, 0, 0, 0);
#undef PK
}
__device__ __forceinline__ void pv_d0(f32x16* o, int vb, bf16x8 pa0, bf16x8 pa1, bf16x8 pa2, bf16x8 pa3) {
  pv_one<0>(o[0], vb, pa0, pa1, pa2, pa3); pv_one<1>(o[1], vb, pa0, pa1, pa2, pa3); pv_one<2>(o[2], vb, pa0, pa1, pa2, pa3); pv_one<3>(o[3], vb, pa0, pa1, pa2, pa3);
}


template <int U> __device__ __forceinline__ void pvp_issue(int vb, s16x4& lo, s16x4& hi) {
  constexpr int b = U >> 2, s = U & 3; lo = tr_read<v_rd_off(b & 3, s, 0) + (b >> 2) * 16384>(vb); hi = tr_read<v_rd_off(b & 3, s, 1) + (b >> 2) * 16384>(vb); }
#define PVP_PK(L, H) (bf16x8){L[0], L[1], L[2], L[3], H[0], H[1], H[2], H[3]}
__device__ __forceinline__ void pv_pipe(f32x16* o, int vb, bf16x8 pa0, bf16x8 pa1, bf16x8 pa2, bf16x8 pa3) {
  s16x4 L0, H0, L1, H1, L2, H2, L3, H3, L4, H4, L5, H5;
  asm volatile("s_waitcnt lgkmcnt(0)" ::: "memory"); SBAR();
  pvp_issue<0>(vb, L0, H0); pvp_issue<1>(vb, L1, H1); pvp_issue<2>(vb, L2, H2); pvp_issue<3>(vb, L3, H3); pvp_issue<4>(vb, L4, H4);
  pvp_issue<5>(vb, L5, H5); asm volatile("s_waitcnt lgkmcnt(10)" ::: "memory"); SBAR(); o[0] = __builtin_amdgcn_mfma_f32_32x32x16_bf16(pa0, PVP_PK(L0, H0), o[0], 0, 0, 0);
  pvp_issue<6>(vb, L0, H0); asm volatile("s_waitcnt lgkmcnt(10)" ::: "memory"); SBAR(); o[0] = __builtin_amdgcn_mfma_f32_32x32x16_bf16(pa1, PVP_PK(L1, H1), o[0], 0, 0, 0);
  pvp_issue<7>(vb, L1, H1); asm volatile("s_waitcnt lgkmcnt(10)" ::: "memory"); SBAR(); o[0] = __builtin_amdgcn_mfma_f32_32x32x16_bf16(pa2, PVP_PK(L2, H2), o[0], 0, 0, 0);
  pvp_issue<8>(vb, L2, H2); asm volatile("s_waitcnt lgkmcnt(10)" ::: "memory"); SBAR(); o[0] = __builtin_amdgcn_mfma_f32_32x32x16_bf16(pa3, PVP_PK(L3, H3), o[0], 0, 0, 0);
  pvp_issue<9>(vb, L3, H3); asm volatile("s_waitcnt lgkmcnt(10)" ::: "memory"); SBAR(); o[1] = __builtin_amdgcn_mfma_f32_32x32x16_bf16(pa0, PVP_PK(L4, H4), o[1], 0, 0, 0);
  pvp_issue<10>(vb, L4, H4); asm volatile("s_waitcnt lgkmcnt(10)" ::: "memory"); SBAR(); o[1] = __builtin_amdgcn_mfma_f32_32x32x16_bf16(pa1, PVP_PK(L5, H5), o[1], 0, 0, 0);
  pvp_issue<11>(vb, L5, H5); asm volatile("s_waitcnt lgkmcnt(10)" ::: "memory"); SBAR(); o[1] = __builtin_amdgcn_mfma_f32_32x32x16_bf16(pa2, PVP_PK(L0, H0), o[1], 0, 0, 0);
  pvp_issue<12>(vb, L0, H0); asm volatile("s_waitcnt lgkmcnt(10)" ::: "memory"); SBAR(); o[1] = __builtin_amdgcn_mfma_f32_32x32x16_bf16(pa3, PVP_PK(L1, H1), o[1], 0, 0, 0);
  pvp_issue<13>(vb, L1, H1); asm volatile("s_waitcnt lgkmcnt(10)" ::: "memory"); SBAR(); o[2] = __builtin_amdgcn_mfma_f32_32x32x16_bf16(pa0, PVP_PK(L2, H2), o[2], 0, 0, 0);
  pvp_issue<14>(vb, L2, H2); asm volatile("s_waitcnt lgkmcnt(10)" ::: "memory"); SBAR(); o[2] = __builtin_amdgcn_mfma_f32_32x32x16_bf16(pa1, PVP_PK(L3, H3), o[2], 0, 0, 0);
  pvp_issue<15>(vb, L3, H3); asm volatile("s_waitcnt lgkmcnt(10)" ::: "memory"); SBAR(); o[2] = __builtin_amdgcn_mfma_f32_32x32x16_bf16(pa2, PVP_PK(L4, H4), o[2], 0, 0, 0);
  pvp_issue<16>(vb, L4, H4); asm volatile("s_waitcnt lgkmcnt(10)" ::: "memory"); SBAR(); o[2] = __builtin_amdgcn_mfma_f32_32x32x16_bf16(pa3, PVP_PK(L5, H5), o[2], 0, 0, 0);
  pvp_issue<17>(vb, L5, H5); asm volatile("s_waitcnt lgkmcnt(10)" ::: "memory"); SBAR(); o[3] = __builtin_amdgcn_mfma_f32_32x32x16_bf16(pa0, PVP_PK(L0, H0), o[3], 0, 0, 0);
  pvp_issue<18>(vb, L0, H0); asm volatile("s_waitcnt lgkmcnt(10)" ::: "memory"); SBAR(); o[3] = __builtin_amdgcn_mfma_f32_32x32x16_bf16(pa1, PVP_PK(L1, H1), o[3], 0, 0, 0);
  pvp_issue<19>(vb, L1, H1); asm volatile("s_waitcnt lgkmcnt(10)" ::: "memory"); SBAR(); o[3] = __builtin_amdgcn_mfma_f32_32x32x16_bf16(pa2, PVP_PK(L2, H2), o[3], 0, 0, 0);
  pvp_issue<20>(vb, L2, H2); asm volatile("s_waitcnt lgkmcnt(10)" ::: "memory"); SBAR(); o[3] = __builtin_amdgcn_mfma_f32_32x32x16_bf16(pa3, PVP_PK(L3, H3), o[3], 0, 0, 0);
  pvp_issue<21>(vb, L3, H3); asm volatile("s_waitcnt lgkmcnt(10)" ::: "memory"); SBAR(); o[4] = __builtin_amdgcn_mfma_f32_32x32x16_bf16(pa0, PVP_PK(L4, H4), o[4], 0, 0, 0);
  pvp_issue<22>(vb, L4, H4); asm volatile("s_waitcnt lgkmcnt(10)" ::: "memory"); SBAR(); o[4] = __builtin_amdgcn_mfma_f32_32x32x16_bf16(pa1, PVP_PK(L5, H5), o[4], 0, 0, 0);
  pvp_issue<23>(vb, L5, H5); asm volatile("s_waitcnt lgkmcnt(10)" ::: "memory"); SBAR(); o[4] = __builtin_amdgcn_mfma_f32_32x32x16_bf16(pa2, PVP_PK(L0, H0), o[4], 0, 0, 0);
  pvp_issue<24>(vb, L0, H0); asm volatile("s_waitcnt lgkmcnt(10)" ::: "memory"); SBAR(); o[4] = __builtin_amdgcn_mfma_f32_32x32x16_bf16(pa3, PVP_PK(L1, H1), o[4], 0, 0, 0);
  pvp_issue<25>(vb, L1, H1); asm volatile("s_waitcnt lgkmcnt(10)" ::: "memory"); SBAR(); o[5] = __builtin_amdgcn_mfma_f32_32x32x16_bf16(pa0, PVP_PK(L2, H2), o[5], 0, 0, 0);
  pvp_issue<26>(vb, L2, H2); asm volatile("s_waitcnt lgkmcnt(10)" ::: "memory"); SBAR(); o[5] = __builtin_amdgcn_mfma_f32_32x32x16_bf16(pa1, PVP_PK(L3, H3), o[5], 0, 0, 0);
  pvp_issue<27>(vb, L3, H3); asm volatile("s_waitcnt lgkmcnt(10)" ::: "memory"); SBAR(); o[5] = __builtin_amdgcn_mfma_f32_32x32x16_bf16(pa2, PVP_PK(L4, H4), o[5], 0, 0, 0);
  pvp_issue<28>(vb, L4, H4); asm volatile("s_waitcnt lgkmcnt(10)" ::: "memory"); SBAR(); o[5] = __builtin_amdgcn_mfma_f32_32x32x16_bf16(pa3, PVP_PK(L5, H5), o[5], 0, 0, 0);
  pvp_issue<29>(vb, L5, H5); asm volatile("s_waitcnt lgkmcnt(10)" ::: "memory"); SBAR(); o[6] = __builtin_amdgcn_mfma_f32_32x32x16_bf16(pa0, PVP_PK(L0, H0), o[6], 0, 0, 0);
  pvp_issue<30>(vb, L0, H0); asm volatile("s_waitcnt lgkmcnt(10)" ::: "memory"); SBAR(); o[6] = __builtin_amdgcn_mfma_f32_32x32x16_bf16(pa1, PVP_PK(L1, H1), o[6], 0, 0, 0);
  pvp_issue<31>(vb, L1, H1); asm volatile("s_waitcnt lgkmcnt(10)" ::: "memory"); SBAR(); o[6] = __builtin_amdgcn_mfma_f32_32x32x16_bf16(pa2, PVP_PK(L2, H2), o[6], 0, 0, 0);
  asm volatile("s_waitcnt lgkmcnt(8)" ::: "memory"); SBAR(); o[6] = __builtin_amdgcn_mfma_f32_32x32x16_bf16(pa3, PVP_PK(L3, H3), o[6], 0, 0, 0);
  asm volatile("s_waitcnt lgkmcnt(6)" ::: "memory"); SBAR(); o[7] = __builtin_amdgcn_mfma_f32_32x32x16_bf16(pa0, PVP_PK(L4, H4), o[7], 0, 0, 0);
  asm volatile("s_waitcnt lgkmcnt(4)" ::: "memory"); SBAR(); o[7] = __builtin_amdgcn_mfma_f32_32x32x16_bf16(pa1, PVP_PK(L5, H5), o[7], 0, 0, 0);
  asm volatile("s_waitcnt lgkmcnt(2)" ::: "memory"); SBAR(); o[7] = __builtin_amdgcn_mfma_f32_32x32x16_bf16(pa2, PVP_PK(L0, H0), o[7], 0, 0, 0);
  asm volatile("s_waitcnt lgkmcnt(0)" ::: "memory"); SBAR(); o[7] = __builtin_amdgcn_mfma_f32_32x32x16_bf16(pa3, PVP_PK(L1, H1), o[7], 0, 0, 0);
}

__device__ __forceinline__ void pv_pipe4(f32x16* o, int vb, bf16x8 pa0, bf16x8 pa1, bf16x8 pa2, bf16x8 pa3) {
  s16x4 L0, H0, L1, H1, L2, H2, L3, H3;
  asm volatile("s_waitcnt lgkmcnt(0)" ::: "memory"); SBAR();
  pvp_issue<0>(vb, L0, H0); pvp_issue<1>(vb, L1, H1); pvp_issue<2>(vb, L2, H2);
  pvp_issue<3>(vb, L3, H3); asm volatile("s_waitcnt lgkmcnt(6)" ::: "memory"); SBAR(); o[0] = __builtin_amdgcn_mfma_f32_32x32x16_bf16(pa0, PVP_PK(L0, H0), o[0], 0, 0, 0);
  pvp_issue<4>(vb, L0, H0); asm volatile("s_waitcnt lgkmcnt(6)" ::: "memory"); SBAR(); o[0] = __builtin_amdgcn_mfma_f32_32x32x16_bf16(pa1, PVP_PK(L1, H1), o[0], 0, 0, 0);
  pvp_issue<5>(vb, L1, H1); asm volatile("s_waitcnt lgkmcnt(6)" ::: "memory"); SBAR(); o[0] = __builtin_amdgcn_mfma_f32_32x32x16_bf16(pa2, PVP_PK(L2, H2), o[0], 0, 0, 0);
  pvp_issue<6>(vb, L2, H2); asm volatile("s_waitcnt lgkmcnt(6)" ::: "memory"); SBAR(); o[0] = __builtin_amdgcn_mfma_f32_32x32x16_bf16(pa3, PVP_PK(L3, H3), o[0], 0, 0, 0);
  pvp_issue<7>(vb, L3, H3); asm volatile("s_waitcnt lgkmcnt(6)" ::: "memory"); SBAR(); o[1] = __builtin_amdgcn_mfma_f32_32x32x16_bf16(pa0, PVP_PK(L0, H0), o[1], 0, 0, 0);
  pvp_issue<8>(vb, L0, H0); asm volatile("s_waitcnt lgkmcnt(6)" ::: "memory"); SBAR(); o[1] = __builtin_amdgcn_mfma_f32_32x32x16_bf16(pa1, PVP_PK(L1, H1), o[1], 0, 0, 0);
  pvp_issue<9>(vb, L1, H1); asm volatile("s_waitcnt lgkmcnt(6)" ::: "memory"); SBAR(); o[1] = __builtin_amdgcn_mfma_f32_32x32x16_bf16(pa2, PVP_PK(L2, H2), o[1], 0, 0, 0);
  pvp_issue<10>(vb, L2, H2); asm volatile("s_waitcnt lgkmcnt(6)" ::: "memory"); SBAR(); o[1] = __builtin_amdgcn_mfma_f32_32x32x16_bf16(pa3, PVP_PK(L3, H3), o[1], 0, 0, 0);
  pvp_issue<11>(vb, L3, H3); asm volatile("s_waitcnt lgkmcnt(6)" ::: "memory"); SBAR(); o[2] = __builtin_amdgcn_mfma_f32_32x32x16_bf16(pa0, PVP_PK(L0, H0), o[2], 0, 0, 0);
  pvp_issue<12>(vb, L0, H0); asm volatile("s_waitcnt lgkmcnt(6)" ::: "memory"); SBAR(); o[2] = __builtin_amdgcn_mfma_f32_32x32x16_bf16(pa1, PVP_PK(L1, H1), o[2], 0, 0, 0);
  pvp_issue<13>(vb, L1, H1); asm volatile("s_waitcnt lgkmcnt(6)" ::: "memory"); SBAR(); o[2] = __builtin_amdgcn_mfma_f32_32x32x16_bf16(pa2, PVP_PK(L2, H2), o[2], 0, 0, 0);
  pvp_issue<14>(vb, L2, H2); asm volatile("s_waitcnt lgkmcnt(6)" ::: "memory"); SBAR(); o[2] = __builtin_amdgcn_mfma_f32_32x32x16_bf16(pa3, PVP_PK(L3, H3), o[2], 0, 0, 0);
  pvp_issue<15>(vb, L3, H3); asm volatile("s_waitcnt lgkmcnt(6)" ::: "memory"); SBAR(); o[3] = __builtin_amdgcn_mfma_f32_32x32x16_bf16(pa0, PVP_PK(L0, H0), o[3], 0, 0, 0);
  asm volatile("s_waitcnt lgkmcnt(4)" ::: "memory"); SBAR(); o[3] = __builtin_amdgcn_mfma_f32_32x32x16_bf16(pa1, PVP_PK(L1, H1), o[3], 0, 0, 0);
  asm volatile("s_waitcnt lgkmcnt(2)" ::: "memory"); SBAR(); o[3] = __builtin_amdgcn_mfma_f32_32x32x16_bf16(pa2, PVP_PK(L2, H2), o[3], 0, 0, 0);
  asm volatile("s_waitcnt lgkmcnt(0)" ::: "memory"); SBAR(); o[3] = __builtin_amdgcn_mfma_f32_32x32x16_bf16(pa3, PVP_PK(L3, H3), o[3], 0, 0, 0);
}

template <int OFF> __device__ __forceinline__ bf16x8 k_read(int a) { bf16x8 r; asm volatile("ds_read_b128 %0, %1 offset:%2" : "=&v"(r) : "v"(a), "i"(OFF) : "memory"); return r; }
__device__ __forceinline__ void qk_pipe(f32x16& p0, f32x16& p1, const int kb  , const bf16x8* qr, const int r32, const int hi) {
  const int rb = kb + r32 * 256, c0 = (hi << 4) ^ ((r32 & 7) << 4);
  bf16x8 K0, K1, K2, K3;
  p0 = f32x16{}; p1 = f32x16{};
  asm volatile("s_waitcnt lgkmcnt(0)" ::: "memory"); SBAR();
  K0 = k_read<0>(rb + ((0 << 5) ^ c0)); K1 = k_read<8192>(rb + ((0 << 5) ^ c0)); K2 = k_read<0>(rb + ((1 << 5) ^ c0));
  K3 = k_read<8192>(rb + ((1 << 5) ^ c0)); asm volatile("s_waitcnt lgkmcnt(3)" ::: "memory"); SBAR(); p0 = __builtin_amdgcn_mfma_f32_32x32x16_bf16(K0, qr[0], p0, 0, 0, 0);
  K0 = k_read<0>(rb + ((2 << 5) ^ c0)); asm volatile("s_waitcnt lgkmcnt(3)" ::: "memory"); SBAR(); p1 = __builtin_amdgcn_mfma_f32_32x32x16_bf16(K1, qr[0], p1, 0, 0, 0);
  K1 = k_read<8192>(rb + ((2 << 5) ^ c0)); asm volatile("s_waitcnt lgkmcnt(3)" ::: "memory"); SBAR(); p0 = __builtin_amdgcn_mfma_f32_32x32x16_bf16(K2, qr[1], p0, 0, 0, 0);
  K2 = k_read<0>(rb + ((3 << 5) ^ c0)); asm volatile("s_waitcnt lgkmcnt(3)" ::: "memory"); SBAR(); p1 = __builtin_amdgcn_mfma_f32_32x32x16_bf16(K3, qr[1], p1, 0, 0, 0);
  K3 = k_read<8192>(rb + ((3 << 5) ^ c0)); asm volatile("s_waitcnt lgkmcnt(3)" ::: "memory"); SBAR(); p0 = __builtin_amdgcn_mfma_f32_32x32x16_bf16(K0, qr[2], p0, 0, 0, 0);
  K0 = k_read<0>(rb + ((4 << 5) ^ c0)); asm volatile("s_waitcnt lgkmcnt(3)" ::: "memory"); SBAR(); p1 = __builtin_amdgcn_mfma_f32_32x32x16_bf16(K1, qr[2], p1, 0, 0, 0);
  K1 = k_read<8192>(rb + ((4 << 5) ^ c0)); asm volatile("s_waitcnt lgkmcnt(3)" ::: "memory"); SBAR(); p0 = __builtin_amdgcn_mfma_f32_32x32x16_bf16(K2, qr[3], p0, 0, 0, 0);
  K2 = k_read<0>(rb + ((5 << 5) ^ c0)); asm volatile("s_waitcnt lgkmcnt(3)" ::: "memory"); SBAR(); p1 = __builtin_amdgcn_mfma_f32_32x32x16_bf16(K3, qr[3], p1, 0, 0, 0);
  K3 = k_read<8192>(rb + ((5 << 5) ^ c0)); asm volatile("s_waitcnt lgkmcnt(3)" ::: "memory"); SBAR(); p0 = __builtin_amdgcn_mfma_f32_32x32x16_bf16(K0, qr[4], p0, 0, 0, 0);
  K0 = k_read<0>(rb + ((6 << 5) ^ c0)); asm volatile("s_waitcnt lgkmcnt(3)" ::: "memory"); SBAR(); p1 = __builtin_amdgcn_mfma_f32_32x32x16_bf16(K1, qr[4], p1, 0, 0, 0);
  K1 = k_read<8192>(rb + ((6 << 5) ^ c0)); asm volatile("s_waitcnt lgkmcnt(3)" ::: "memory"); SBAR(); p0 = __builtin_amdgcn_mfma_f32_32x32x16_bf16(K2, qr[5], p0, 0, 0, 0);
  K2 = k_read<0>(rb + ((7 << 5) ^ c0)); asm volatile("s_waitcnt lgkmcnt(3)" ::: "memory"); SBAR(); p1 = __builtin_amdgcn_mfma_f32_32x32x16_bf16(K3, qr[5], p1, 0, 0, 0);
  K3 = k_read<8192>(rb + ((7 << 5) ^ c0)); asm volatile("s_waitcnt lgkmcnt(3)" ::: "memory"); SBAR(); p0 = __builtin_amdgcn_mfma_f32_32x32x16_bf16(K0, qr[6], p0, 0, 0, 0);
  asm volatile("s_waitcnt lgkmcnt(2)" ::: "memory"); SBAR(); p1 = __builtin_amdgcn_mfma_f32_32x32x16_bf16(K1, qr[6], p1, 0, 0, 0);
  asm volatile("s_waitcnt lgkmcnt(1)" ::: "memory"); SBAR(); p0 = __builtin_amdgcn_mfma_f32_32x32x16_bf16(K2, qr[7], p0, 0, 0, 0);
  asm volatile("s_waitcnt lgkmcnt(0)" ::: "memory"); SBAR(); p1 = __builtin_amdgcn_mfma_f32_32x32x16_bf16(K3, qr[7], p1, 0, 0, 0);
}
__device__ __forceinline__ void qk_pipe_lq(f32x16& p0, f32x16& p1, const int kb, const int qa  , const int r32, const int hi) {
  const int rb = kb + r32 * 256, c0 = (hi << 4) ^ ((r32 & 7) << 4);
  bf16x8 QA, KA0, KA1, QB, KB0, KB1;
  p0 = f32x16{}; p1 = f32x16{};
  asm volatile("s_waitcnt lgkmcnt(0)" ::: "memory"); SBAR();
  QA = k_read<0>(qa); KA0 = k_read<0>(rb + ((0 << 5) ^ c0)); KA1 = k_read<8192>(rb + ((0 << 5) ^ c0)); QB = k_read<1024>(qa); KB0 = k_read<0>(rb + ((1 << 5) ^ c0)); KB1 = k_read<8192>(rb + ((1 << 5) ^ c0));
  asm volatile("s_waitcnt lgkmcnt(3)" ::: "memory"); SBAR(); p0 = __builtin_amdgcn_mfma_f32_32x32x16_bf16(KA0, QA, p0, 0, 0, 0); p1 = __builtin_amdgcn_mfma_f32_32x32x16_bf16(KA1, QA, p1, 0, 0, 0); SBAR(); QA = k_read<2048>(qa); KA0 = k_read<0>(rb + ((2 << 5) ^ c0)); KA1 = k_read<8192>(rb + ((2 << 5) ^ c0));
  asm volatile("s_waitcnt lgkmcnt(3)" ::: "memory"); SBAR(); p0 = __builtin_amdgcn_mfma_f32_32x32x16_bf16(KB0, QB, p0, 0, 0, 0); p1 = __builtin_amdgcn_mfma_f32_32x32x16_bf16(KB1, QB, p1, 0, 0, 0); SBAR(); QB = k_read<3072>(qa); KB0 = k_read<0>(rb + ((3 << 5) ^ c0)); KB1 = k_read<8192>(rb + ((3 << 5) ^ c0));
  asm volatile("s_waitcnt lgkmcnt(3)" ::: "memory"); SBAR(); p0 = __builtin_amdgcn_mfma_f32_32x32x16_bf16(KA0, QA, p0, 0, 0, 0); p1 = __builtin_amdgcn_mfma_f32_32x32x16_bf16(KA1, QA, p1, 0, 0, 0); SBAR(); QA = k_read<4096>(qa); KA0 = k_read<0>(rb + ((4 << 5) ^ c0)); KA1 = k_read<8192>(rb + ((4 << 5) ^ c0));
  asm volatile("s_waitcnt lgkmcnt(3)" ::: "memory"); SBAR(); p0 = __builtin_amdgcn_mfma_f32_32x32x16_bf16(KB0, QB, p0, 0, 0, 0); p1 = __builtin_amdgcn_mfma_f32_32x32x16_bf16(KB1, QB, p1, 0, 0, 0); SBAR(); QB = k_read<5120>(qa); KB0 = k_read<0>(rb + ((5 << 5) ^ c0)); KB1 = k_read<8192>(rb + ((5 << 5) ^ c0));
  asm volatile("s_waitcnt lgkmcnt(3)" ::: "memory"); SBAR(); p0 = __builtin_amdgcn_mfma_f32_32x32x16_bf16(KA0, QA, p0, 0, 0, 0); p1 = __builtin_amdgcn_mfma_f32_32x32x16_bf16(KA1, QA, p1, 0, 0, 0); SBAR(); QA = k_read<6144>(qa); KA0 = k_read<0>(rb + ((6 << 5) ^ c0)); KA1 = k_read<8192>(rb + ((6 << 5) ^ c0));
  asm volatile("s_waitcnt lgkmcnt(3)" ::: "memory"); SBAR(); p0 = __builtin_amdgcn_mfma_f32_32x32x16_bf16(KB0, QB, p0, 0, 0, 0); p1 = __builtin_amdgcn_mfma_f32_32x32x16_bf16(KB1, QB, p1, 0, 0, 0); SBAR(); QB = k_read<7168>(qa); KB0 = k_read<0>(rb + ((7 << 5) ^ c0)); KB1 = k_read<8192>(rb + ((7 << 5) ^ c0));
  asm volatile("s_waitcnt lgkmcnt(3)" ::: "memory"); SBAR(); p0 = __builtin_amdgcn_mfma_f32_32x32x16_bf16(KA0, QA, p0, 0, 0, 0); p1 = __builtin_amdgcn_mfma_f32_32x32x16_bf16(KA1, QA, p1, 0, 0, 0);
  asm volatile("s_waitcnt lgkmcnt(0)" ::: "memory"); SBAR(); p0 = __builtin_amdgcn_mfma_f32_32x32x16_bf16(KB0, QB, p0, 0, 0, 0); p1 = __builtin_amdgcn_mfma_f32_32x32x16_bf16(KB1, QB, p1, 0, 0, 0);
}

constexpr size_t SBUF = 65536;
template <int SV = 0>
__device__ __forceinline__ void attn_sample_unit(const bf16* __restrict__ QN, const bf16* __restrict__ KN, const bf16* __restrict__ VBn,
                                                 const float* __restrict__ ck, const float* __restrict__ cv, float* __restrict__ OA0, float* __restrict__ OA1,
                                                 const int b, const int h, char* lds, const int wv) {
  int tid_ = wv * 64 + lane_id(); asm volatile("" : "+v"(tid_));
  const int tid = tid_, wid = tid >> 6, lane = tid & 63, r32 = lane & 31, hi = lane >> 5;
  const int c = wid & 1, e = (wid >> 1) & 1, th = wid >> 2;
  float* wsf = (float*)(lds + 2 * SBUF) + wid * 64; float* li_l = wsf; float* al_l = wsf + 32;
  float m_reg = -1e30f, l_reg = 0; f32x16 o[4] = {};
  const long qrow = (long)MP + 64 * b + 32 * th + r32;
  const bf16* Qw = QN + qrow * 2048 + h * 256 + c * 128 + hi * 8;
  char* qlds = lds + SBUF + wid * 8192 + lane * 16;
#pragma unroll
  for (int d0 = 0; d0 < 8; ++d0) *reinterpret_cast<bf16x8*>(qlds + d0 * 1024) = *reinterpret_cast<const bf16x8*>(Qw + d0 * 16);
  const int kb0 = (int)(uintptr_t)lds + c * 16384, qa0 = (int)(uintptr_t)qlds;
  const int vb0 = (int)(uintptr_t)lds + 2 * 16384 + e * 16384 + v_rd_base(lane);
  f32x8 skA[4], skB[4], sv[4];
  const float* ckb = ck + ((long)b * PAST * 8 + h) * 256;
  const float* cvb = cv + ((long)b * PAST * 8 + h) * 256;
#define SS_TID int ts_ = wv * 64 + lane_id(); asm volatile("" : "+v"(ts_))
#define SS_LOADK(sk, k0) do { SS_TID; _Pragma("unroll") for (int i = 0; i < 4; ++i) { const int n = ts_ + 512 * i; \
      sk[i] = *reinterpret_cast<const f32x8*>(ckb + (unsigned)(((k0) + ((n >> 4) & 63)) * 2048 + (n >> 10) * 128 + (n & 15) * 8)); } } while (0)
#define SS_LOADV(k0) do { SS_TID; _Pragma("unroll") for (int i = 0; i < 4; ++i) { const int n = ts_ + 512 * i; \
      sv[i] = *reinterpret_cast<const f32x8*>(cvb + (unsigned)(((k0) + (n >> 5)) * 2048 + (n & 31) * 8)); } } while (0)
#define SS_WRITEK(sk, bufp) do { SS_TID; _Pragma("unroll") for (int i = 0; i < 4; ++i) { const int n = ts_ + 512 * i; \
      *(bf16x8*)((bufp) + (n >> 10) * 16384 + KSWZ((n >> 4) & 63, (n & 15) * 16)) = Stage<float>::tobf(sk[i]); } } while (0)
#define SS_WRITEV(bufp) do { SS_TID; _Pragma("unroll") for (int i = 0; i < 4; ++i) { const int n = ts_ + 512 * i; \
      *(bf16x8*)((bufp) + 32768 + ((n & 31) >> 4) * 16384 + v_st(n >> 5, (n & 15) * 8)) = Stage<float>::tobf(sv[i]); } } while (0)
#define SS_BAR() do { asm volatile("s_waitcnt lgkmcnt(0)" ::: "memory"); __builtin_amdgcn_s_barrier(); asm volatile("" ::: "memory"); } while (0)
#define SS_RESC(a) do { if (__any((a) < 1.f)) { if (hi == 0) al_l[r32] = (a); asm volatile("s_waitcnt lgkmcnt(0)" ::: "memory"); \
    for (int d = 0; d < 4; ++d) for (int r = 0; r < 16; ++r) o[d][r] *= al_l[crow(r, hi)]; } } while (0)
#define SS_QK(bufp) do { qk_pipe_lq(p0, p1, kb0, qa0, r32, hi); \
      partialSM(p0, p1, m_reg, mn, al); SS_RESC(al); finishSM(p0, p1, al, l_reg, pa0, pa1, pa2, pa3); } while (0)
#define SS_PV(vbase) do { pv_pipe4(o, (vbase), pa0, pa1, pa2, pa3); } while (0)
  constexpr int NTC = PAST / 64;
  SS_LOADK(skA, 0); SS_LOADV(0); SS_LOADK(skB, 64);
#define LD_ON (SV != 2)
#define CP_ON (SV != 1)
  for (int j = 0; j < NTC; j += 2) {
    {
      f32x16 p0, p1; float mn, al; bf16x8 pa0, pa1, pa2, pa3;
      SS_WRITEK(skA, lds); SS_BAR();
      if (LD_ON && j + 2 < NTC) SS_LOADK(skA, (j + 2) * 64);
      if (CP_ON) SS_QK(lds);
      SS_WRITEV(lds); SS_BAR();
      if (LD_ON) SS_LOADV((j + 1) * 64);
      if (CP_ON) SS_PV(vb0);
    }
    {
      f32x16 p0, p1; float mn, al; bf16x8 pa0, pa1, pa2, pa3;
      SS_WRITEK(skB, lds); SS_BAR();
      if (LD_ON && j + 3 < NTC) SS_LOADK(skB, (j + 3) * 64);
      if (CP_ON) SS_QK(lds);
      SS_WRITEV(lds); SS_BAR();
      if (LD_ON && j + 2 < NTC) SS_LOADV((j + 2) * 64);
      if (CP_ON) SS_PV(vb0);
    }
  }
  {
    bf16x8 nk[4], nv[4];
    const long nrow0 = (long)MP + 64 * b;
#pragma unroll
    for (int i = 0; i < 4; ++i) { const int n = tid + 512 * i;
      nk[i] = *reinterpret_cast<const bf16x8*>(KN + (nrow0 + ((n >> 4) & 63)) * 2048 + h * 256 + (n >> 10) * 128 + (n & 15) * 8);
      nv[i] = *reinterpret_cast<const bf16x8*>(VBn + (nrow0 + (n >> 5)) * 2048 + h * 256 + (n & 31) * 8); }
    __syncthreads();
#pragma unroll
    for (int i = 0; i < 4; ++i) { const int n = tid + 512 * i;
      *(bf16x8*)(lds + (n >> 10) * 16384 + KSWZ((n >> 4) & 63, (n & 15) * 16)) = nk[i];
      *(bf16x8*)(lds + 32768 + ((n & 31) >> 4) * 16384 + v_st(n >> 5, (n & 15) * 8)) = nv[i]; }
    __syncthreads();
    f32x16 p0, p1; float mn, al; bf16x8 pa0, pa1, pa2, pa3;
    SS_QK(lds); SS_PV(vb0);
  }
  if (hi == 0) li_l[r32] = l_reg; asm volatile("s_waitcnt lgkmcnt(0)" ::: "memory");
  float rli[16];
#pragma unroll
  for (int r = 0; r < 16; ++r) rli[r] = __builtin_amdgcn_rcpf(li_l[crow(r, hi)]);
  float* Ow = (c ? OA1 : OA0) + ((long)MP + 64 * b + 32 * th) * 2048 + h * 256 + e * 128;
#pragma unroll
  for (int r = 0; r < 16; ++r) { const int orow = crow(r, hi);
    for (int d0 = 0; d0 < 4; ++d0) Ow[(long)orow * 2048 + d0 * 32 + r32] = o[d0][r] * rli[r]; }
  __syncthreads();
#undef LD_ON
#undef CP_ON
#undef SS_TID
#undef SS_LOADK
#undef SS_LOADV
#undef SS_WRITEK
#undef SS_WRITEV
#undef SS_BAR
#undef SS_RESC
#undef SS_QK
#undef SS_PV
}


__device__ __forceinline__ void qk_half(f32x16& p, const char* Ks, const int half, const bf16x8* qr, int r32, int hi) {
  p = f32x16{};
#pragma unroll
  for (int d0 = 0; d0 < 8; ++d0) { const int cb = (d0 * 16 + hi * 8) * 2;
    const bf16x8 b = *reinterpret_cast<const bf16x8*>(Ks + KSWZ(32 * half + r32, cb));
    p = __builtin_amdgcn_mfma_f32_32x32x16_bf16(b, qr[d0], p, 0, 0, 0); }
}
__device__ __forceinline__ void sm_half(f32x16& p, float& m_reg, float& l_reg, float& alpha, bf16x8& paX, bf16x8& paY, const bool msk) {
  constexpr float C = SCALE * 1.4426950408889634f;
  float pmax = p[0]; for (int r = 1; r < 16; ++r) pmax = fmaxf(pmax, p[r]);
  { auto rr = __builtin_amdgcn_permlane32_swap(__float_as_uint(pmax), __float_as_uint(pmax), false, false); pmax = fmaxf(__uint_as_float(rr[0]), __uint_as_float(rr[1])); }
  if (msk) pmax = -INFINITY;
  float mn;
  if (__builtin_expect(__all(pmax - m_reg <= THR / SCALE), 1)) { mn = m_reg; alpha = 1.f; }
  else { mn = fmaxf(m_reg, pmax); alpha = __builtin_amdgcn_exp2f((m_reg - mn) * C); m_reg = mn; }
  const float mnC = msk ? -INFINITY : -mn * C;
  for (int r = 0; r < 16; ++r) p[r] = __builtin_amdgcn_exp2f(fmaf(p[r], C, mnC));
  float ps = 0; for (int r = 0; r < 16; ++r) ps += p[r];
  { auto rr = __builtin_amdgcn_permlane32_swap(__float_as_uint(ps), __float_as_uint(ps), false, false); ps = __uint_as_float(rr[0]) + __uint_as_float(rr[1]); }
  l_reg = l_reg * alpha + ps;
#define PK4H(P, BASE, OUT) do { unsigned a0 = cvtpk(P[BASE + 0], P[BASE + 1]), a1 = cvtpk(P[BASE + 2], P[BASE + 3]);   \
    unsigned b0 = cvtpk(P[BASE + 4], P[BASE + 5]), b1 = cvtpk(P[BASE + 6], P[BASE + 7]);                              \
    auto r0 = __builtin_amdgcn_permlane32_swap(a0, b0, false, false); auto r1 = __builtin_amdgcn_permlane32_swap(a1, b1, false, false); \
    u32x4 w = {r0[0], r1[0], r0[1], r1[1]}; OUT = *reinterpret_cast<bf16x8*>(&w); } while (0)
  PK4H(p, 0, paX); PK4H(p, 8, paY);
#undef PK4H
}
template <int D0, int H> __device__ __forceinline__ void pv_half_one(f32x16& od, int vb, bf16x8 paX, bf16x8 paY) {
  const s16x4 l0 = tr_read<v_rd_off(D0, 2 * H, 0)>(vb), h0 = tr_read<v_rd_off(D0, 2 * H, 1)>(vb), l1 = tr_read<v_rd_off(D0, 2 * H + 1, 0)>(vb), h1 = tr_read<v_rd_off(D0, 2 * H + 1, 1)>(vb);
  asm volatile("s_waitcnt lgkmcnt(0)" ::: "memory"); SBAR();
#define PKH(L, Hh) (bf16x8){L[0], L[1], L[2], L[3], Hh[0], Hh[1], Hh[2], Hh[3]}
  od = __builtin_amdgcn_mfma_f32_32x32x16_bf16(paX, PKH(l0, h0), od, 0, 0, 0);
  od = __builtin_amdgcn_mfma_f32_32x32x16_bf16(paY, PKH(l1, h1), od, 0, 0, 0);
#undef PKH
}
template <int H> __device__ __forceinline__ void pv_half(f32x16* o, int vb, bf16x8 paX, bf16x8 paY) {
  pv_half_one<0, H>(o[0], vb, paX, paY); pv_half_one<1, H>(o[1], vb, paX, paY); pv_half_one<2, H>(o[2], vb, paX, paY); pv_half_one<3, H>(o[3], vb, paX, paY);
  pv_half_one<0, H>(o[4], vb + 16384, paX, paY); pv_half_one<1, H>(o[5], vb + 16384, paX, paY); pv_half_one<2, H>(o[6], vb + 16384, paX, paY); pv_half_one<3, H>(o[7], vb + 16384, paX, paY);
}

constexpr size_t WBUF = 49152;
template <int VAR>
__device__ __forceinline__ void attn_wide_body(const bf16* __restrict__ Qb, const bf16* __restrict__ Kh, const bf16* __restrict__ Vh, float* __restrict__ Ob, const int NT, const int wlast, char* lds, const int wv) {
  int tid_ = wv * 64 + lane_id(); asm volatile("" : "+v"(tid_));
  const int tid = tid_, wid = tid >> 6, lane = tid & 63, r32 = lane & 31, hi = lane >> 5;
  float* wsf = (float*)(lds + 2 * WBUF) + wid * 64; float* li_l = wsf; float* al_l = wsf + 32;
  float m_reg = -1e30f, l_reg = 0; f32x16 o[8] = {}; bf16x8 qr[8];
  const bf16* Qw = Qb + (long)(wid * QBLK + r32) * 2048 + hi * 8;
#pragma unroll
  for (int d0 = 0; d0 < 8; ++d0) qr[d0] = *reinterpret_cast<const bf16x8*>(Qw + d0 * 16);
  unsigned doff[6];
  { int t2_ = lane_id(); asm volatile("" : "+v"(t2_));
#pragma unroll
    for (int i_ = 0; i_ < 6; ++i_) { const int I_ = i_ * 8 + wv, img_ = I_ >> 4, P_ = (I_ & 15) * 64 + t2_;
      if (img_ == 0) { const int row_ = P_ >> 4, sl_ = P_ & 15; doff[i_] = (unsigned)(row_ * 2048 + ((sl_ ^ (row_ & 7)) << 3)); }
      else { const int st_ = P_ >> 5, q_ = P_ & 31, kk_ = ((st_ >> 2) << 3) + (q_ >> 2), k_ = (kk_ & ~0xC) | ((kk_ & 4) << 1) | ((kk_ & 8) >> 1);
             doff[i_] = (unsigned)(k_ * 2048 + (img_ - 1) * 128 + (st_ & 3) * 32 + (q_ & 3) * 8); } } }
#define W_DMA(k0, bufp) do { const bf16* kt_ = Kh + (size_t)(k0) * 2048; const bf16* vt_ = Vh + (size_t)(k0) * 2048; _Pragma("unroll") for (int i_ = 0; i_ < 6; ++i_) { const int I_ = i_ * 8 + wv; \
      __builtin_amdgcn_global_load_lds((const unsigned*)((i_ < 2 ? kt_ : vt_) + doff[i_]), (LAS unsigned*)((bufp) + I_ * 1024), 16, 0, 0); } } while (0)
#define W_RESC(a) do { if (__any((a) < 1.f)) { if (hi == 0) al_l[r32] = (a); asm volatile("s_waitcnt lgkmcnt(0)" ::: "memory"); \
    for (int d = 0; d < 8; ++d) for (int r = 0; r < 16; ++r) o[d][r] *= al_l[crow(r, hi)]; } } while (0)
  W_DMA(0, lds); if (1 < NT) W_DMA(KVBLK, lds + WBUF);
  asm volatile("s_waitcnt vmcnt(0)" ::: "memory"); __syncthreads();
  for (int j = 0; j < NT; ++j) {
    char* bp = lds + (j & 1) * WBUF;
    f32x16 p0, p1; float mn, al; bf16x8 pa0, pa1, pa2, pa3;
    if constexpr (VAR == 3) { p0 = f32x16{}; p1 = f32x16{}; for (int r = 0; r < 16; ++r) { p0[r] = (float)(r + j); p1[r] = (float)(r - j); } } else qk_pipe(p0, p1, (int)(uintptr_t)bp, qr, r32, hi);
    {
      constexpr float C = SCALE * 1.4426950408889634f; const bool msk = j > wlast;
      float pmax = p0[0]; for (int r = 1; r < 16; ++r) pmax = fmaxf(pmax, p0[r]); for (int r = 0; r < 16; ++r) pmax = fmaxf(pmax, p1[r]);
      { auto rr = __builtin_amdgcn_permlane32_swap(__float_as_uint(pmax), __float_as_uint(pmax), false, false); pmax = fmaxf(__uint_as_float(rr[0]), __uint_as_float(rr[1])); }
      if (msk) pmax = -INFINITY;
      if (__builtin_expect(__all(pmax - m_reg <= THR / SCALE), 1)) { mn = m_reg; al = 1.f; }
      else { mn = fmaxf(m_reg, pmax); al = __builtin_amdgcn_exp2f((m_reg - mn) * C); m_reg = mn; }
      const float mnC = msk ? -INFINITY : -mn * C;
      for (int r = 0; r < 16; ++r) p0[r] = fmaf(p0[r], C, mnC); for (int r = 0; r < 16; ++r) p1[r] = fmaf(p1[r], C, mnC);
      if constexpr (VAR != 1 && VAR != 4) { for (int r = 0; r < 16; ++r) p0[r] = __builtin_amdgcn_exp2f(p0[r]); }
    }
    W_RESC(al);
    if constexpr (VAR == 1) { float ps = 0; for (int r = 0; r < 16; ++r) ps += p0[r] + p1[r]; l_reg = l_reg * al + ps;
        v4u w0 = {cvtpk(p0[0], p0[1]), cvtpk(p0[2], p0[3]), cvtpk(p0[4], p0[5]), cvtpk(p0[6], p0[7])}, w1 = {cvtpk(p0[8], p0[9]), cvtpk(p0[10], p0[11]), cvtpk(p0[12], p0[13]), cvtpk(p0[14], p0[15])};
        v4u w2 = {cvtpk(p1[0], p1[1]), cvtpk(p1[2], p1[3]), cvtpk(p1[4], p1[5]), cvtpk(p1[6], p1[7])}, w3 = {cvtpk(p1[8], p1[9]), cvtpk(p1[10], p1[11]), cvtpk(p1[12], p1[13]), cvtpk(p1[14], p1[15])};
        pa0 = __builtin_bit_cast(bf16x8, w0); pa1 = __builtin_bit_cast(bf16x8, w1); pa2 = __builtin_bit_cast(bf16x8, w2); pa3 = __builtin_bit_cast(bf16x8, w3); }
    else if constexpr (VAR == 4) { l_reg += p0[0];
        v4u w0 = {__float_as_uint(p0[0]), __float_as_uint(p0[1]), __float_as_uint(p0[2]), __float_as_uint(p0[3])}, w1 = {__float_as_uint(p0[4]), __float_as_uint(p0[5]), __float_as_uint(p0[6]), __float_as_uint(p0[7])};
        v4u w2 = {__float_as_uint(p1[0]), __float_as_uint(p1[1]), __float_as_uint(p1[2]), __float_as_uint(p1[3])}, w3 = {__float_as_uint(p1[4]), __float_as_uint(p1[5]), __float_as_uint(p1[6]), __float_as_uint(p1[7])};
        pa0 = __builtin_bit_cast(bf16x8, w0); pa1 = __builtin_bit_cast(bf16x8, w1); pa2 = __builtin_bit_cast(bf16x8, w2); pa3 = __builtin_bit_cast(bf16x8, w3); }
    else finishSM(p0, p1, al, l_reg, pa0, pa1, pa2, pa3);
    SBAR();
    { int t3_ = lane_id(); asm volatile("" : "+v"(t3_)); const int vb0 = (int)(uintptr_t)bp + 16384 + v_rd_base(t3_ & 63);
      if constexpr (VAR == 2) { o[0][0] += __builtin_bit_cast(float, pa0[0] | (pa1[1] << 16)) + __builtin_bit_cast(float, pa2[0] | (pa3[1] << 16)) + (float)vb0; } else pv_pipe(o, vb0, pa0, pa1, pa2, pa3); }
    asm volatile("s_waitcnt vmcnt(0)" ::: "memory"); __syncthreads();
    if (j + 2 < NT) W_DMA((j + 2) * KVBLK, bp);
  }
  {
    int t4_ = lane_id(); asm volatile("" : "+v"(t4_)); const int r32e = t4_ & 31, hie = t4_ >> 5;
    float* lil = (float*)(lds + 2 * WBUF) + wv * 64;
    if (hie == 0) lil[r32e] = l_reg; asm volatile("s_waitcnt lgkmcnt(0)" ::: "memory");
    float rli[16];
#pragma unroll
    for (int r = 0; r < 16; ++r) rli[r] = __builtin_amdgcn_rcpf(lil[crow(r, hie)]);
    float* Ow = Ob + (long)(wv * QBLK) * 2048;
#pragma unroll
    for (int r = 0; r < 16; ++r) { const int orow = crow(r, hie);
      for (int d0 = 0; d0 < 8; ++d0) Ow[(long)orow * 2048 + d0 * 32 + r32e] = o[d0][r] * rli[r]; }
  }
  __syncthreads();
#undef W_DMA
#undef W_RESC
}
}

struct Args { const float* in[25]; float* out; unsigned char* ws; int ph_lo, ph_hi; };

struct TrItem { const float* W; bf16* WT; const float* gain; int K, N, gmask, k0, n0, n0d; float gscale; };
__device__ __forceinline__ bool p0_item(const Args& a, int grp, int it, TrItem& t) {
    unsigned char* ws = a.ws;
    constexpr int I_HIN = (DM / 64) * (NHG / 64), I_SQ = (DM / 64) * (DM / 64), I_UP = (DM / 64) * (NUP / 64), I_DN = (DFF / 64) * (DM / 64), I_DIN = (DM / 64) * (NDI / 64);
    int r = it; t.gscale = 1.f;
    if (grp == 0) {
        if (r >= I_HIN) return false;
        t.W = a.in[9]; t.K = DM; t.N = NHG; t.WT = (bf16*)(ws + WS_W_HIN); t.gain = a.in[6]; t.gmask = DM - 1;
    } else if (grp == 1) {
        if (r >= I_SQ + I_UP + I_DN + I_DIN) return false;
        if (r < I_SQ) { t.W = a.in[10]; t.K = DM; t.N = DM; t.WT = (bf16*)(ws + WS_W_HOUT); t.gain = a.in[11]; t.gmask = 127; }
        else if ((r -= I_SQ) < I_UP) { t.W = a.in[21]; t.K = DM; t.N = NUP; t.WT = (bf16*)(ws + WS_W_UP0); t.gain = a.in[7]; t.gmask = DM - 1; }
        else if ((r -= I_UP) < I_DN) { t.W = a.in[24]; t.K = DFF; t.N = DM; t.WT = (bf16*)(ws + WS_W_DN0); t.gain = nullptr; t.gmask = 0; }
        else { r -= I_DN; t.W = a.in[12]; t.K = DM; t.N = NDI; t.WT = (bf16*)(ws + WS_W_DIN); t.gain = a.in[6] + DM; t.gmask = DM - 1; }
    } else {
        if (r >= I_SQ + I_UP + I_DN) return false;
        if (r < I_SQ) { t.W = a.in[13]; t.K = DM; t.N = DM; t.WT = (bf16*)(ws + WS_W_DOUT); t.gain = a.in[20]; t.gmask = 255; t.gscale = 1.f - LAM_INIT; }
        else if ((r -= I_SQ) < I_UP) { t.W = a.in[21] + (size_t)DM * NUP; t.K = DM; t.N = NUP; t.WT = (bf16*)(ws + WS_W_UP1); t.gain = a.in[7] + DM; t.gmask = DM - 1; }
        else { r -= I_UP; t.W = a.in[24] + (size_t)DFF * DM; t.K = DFF; t.N = DM; t.WT = (bf16*)(ws + WS_W_DN1); t.gain = nullptr; t.gmask = 0; }
    }
    const int nblk = t.N / 64; t.k0 = 64 * (r / nblk); t.n0 = 64 * (r % nblk);
    t.n0d = (t.N == NUP) ? ((t.n0 < DFF) ? 256 * (t.n0 >> 7) + (t.n0 & 127) : 256 * ((t.n0 - DFF) >> 7) + 128 + ((t.n0 - DFF) & 127)) : t.n0;
    return true;
}
constexpr int TR_GRP2_ITEMS = (DM / 64) * (DM / 64) + (DM / 64) * (NUP / 64) + (DFF / 64) * (DM / 64);
#define TR_LOAD(v, gk, t) do { _Pragma("unroll") for (int i = 0; i < 16; ++i) { const int k = 8 * (i >> 1) + 2 * kr + (i & 1); \
        v[i] = *(const GAS f32x4*)((t).W + (size_t)((t).k0 + k) * (t).N + (t).n0 + 4 * n4); gk[i] = (t).gain ? (t).gain[((t).k0 + k) & (t).gmask] * (t).gscale : 1.f; } } while (0)
#define TR_STORE(v, gk, t) do { _Pragma("unroll") for (int j = 0; j < 8; ++j) { const f32x4 a_ = v[2 * j] * gk[2 * j], b_ = v[2 * j + 1] * gk[2 * j + 1]; \
            _Pragma("unroll") for (int c = 0; c < 4; ++c) scr[(4 * n4 + c) * 33 + 4 * j + kr] = cvtpk(a_[c], b_[c]); } \
        LDS_WAIT(); asm volatile("" ::: "memory"); \
        _Pragma("unroll") for (int m = 0; m < 8; ++m) { const int n = (lane >> 3) + 8 * m; const LAS unsigned* sp = scr + n * 33 + 4 * (lane & 7); \
            v4u o_; o_.x = sp[0]; o_.y = sp[1]; o_.z = sp[2]; o_.w = sp[3]; *(GAS v4u*)((t).WT + (size_t)((t).n0d + n) * (t).K + (t).k0 + 8 * (lane & 7)) = o_; } \
        LDS_WAIT(); asm volatile("" ::: "memory"); } while (0)
__device__ __forceinline__ void tr_run(const Args& a, int grp, int first, int step, int last, LAS unsigned* scr, int lane) {
    const int n4 = lane & 15, kr = lane >> 4;
    f32x4 vA[16], vB[16]; float gA[16], gB[16]; TrItem tA, tB;
    int it = first; bool hA = it < last && p0_item(a, grp, it, tA), hB = false;
    if (hA) TR_LOAD(vA, gA, tA);
    while (hA) {
        hB = it + step < last && p0_item(a, grp, it + step, tB); if (hB) TR_LOAD(vB, gB, tB);
        TR_STORE(vA, gA, tA);
        if (!hB) break;
        it += 2 * step; hA = it < last && p0_item(a, grp, it, tA); if (hA) TR_LOAD(vA, gA, tA);
        TR_STORE(vB, gB, tB);
    }
}
__device__ __forceinline__ void p0_prologue(const Args& a, LAS unsigned char* lds, int vcu, int G, int wave, int lane) {
    LAS unsigned* scr = (LAS unsigned*)(lds + RING_OFF + wave * 16384);
    const int gw = vcu * NWAVES + wave, NGW = G * NWAVES;
    unsigned char* ws = a.ws;
    tr_run(a, 0, gw, NGW, 1 << 30, scr, lane);
    if (G != 256) tr_run(a, 1, gw, NGW, 1 << 30, scr, lane);
    float* sm = (float*)(ws + WS_SMALL); bf16* XB = (bf16*)(ws + WS_XB);
    for (int m = gw; m < MR; m += NGW) {
        const float* xrow = (m < MP) ? a.in[0] + (size_t)m * DM : a.in[1] + (size_t)(m - MP) * DM;
        const GAS f32x4* xr = (const GAS f32x4*)xrow + lane;
        f32x4 v[8]; float s = 0.f;
#pragma unroll
        for (int j = 0; j < 8; ++j) { v[j] = xr[64 * j]; s += (v[j].x * v[j].x + v[j].y * v[j].y) + (v[j].z * v[j].z + v[j].w * v[j].w); }
        s = wave_sum(s);
        GAS v2u* o8 = (GAS v2u*)(XB + (size_t)m * DM) + lane;
#pragma unroll
        for (int j = 0; j < 8; ++j) { v2u w; w.x = cvtpk(v[j].x, v[j].y); w.y = cvtpk(v[j].z, v[j].w); o8[64 * j] = w; }
        if (lane == 0) sm[SM_RINV0 + m] = 1.f / sqrtf(s * (1.f / DM) + EPS);
    }
    for (int i = gw * 64 + lane; i < DM; i += NGW * 64) {
        const float z0 = a.in[8][i], z1 = a.in[8][DM + i], z2 = a.in[8][2 * DM + i], mx = fmaxf(z0, fmaxf(z1, z2));
        const float e0 = expf(z0 - mx), e1 = expf(z1 - mx), e2 = expf(z2 - mx);
        sm[SM_LB + i] = e0 / (e0 + e1 + e2);
    }
    if (gw == 0) {
        const float s1 = wave_sum(a.in[16][lane] * a.in[17][lane] + a.in[16][lane + 64] * a.in[17][lane + 64]);
        const float s2 = wave_sum(a.in[18][lane] * a.in[19][lane] + a.in[18][lane + 64] * a.in[19][lane + 64]);
        if (lane == 0) sm[SM_LAM] = expf(s1) - expf(s2) + LAM_INIT;
    }
}

__device__ __forceinline__ unsigned img_off(unsigned row, unsigned ch) { return 256u * row + 16u * (ch ^ (((row & 3u) << 2) | ((row >> 2) & 3u))); }
__device__ __forceinline__ bf16x8 img_rowread(const LAS unsigned char* img, int rowbase, int ks, int lane) {
    return *(const LAS bf16x8*)(img + img_off(rowbase + (lane & 31), 2 * ks + (lane >> 5)));
}
__device__ __forceinline__ s16x4 vtr(const LAS unsigned char* p) { typedef short v4i16_t __attribute__((ext_vector_type(4)));
    return __builtin_bit_cast(s16x4, __builtin_amdgcn_ds_read_tr16_b64_v4i16((LAS v4i16_t*)p)); }
__device__ __forceinline__ bf16x8 img_trread_nat(const LAS unsigned char* img, int R0, int c, int lane) {
    const unsigned h = lane >> 5, blk = (lane >> 4) & 1, q = (lane & 15) >> 2, p = lane & 3;
    const s16x4 lo = vtr(img + img_off(R0 + 8 * h + q, 4 * c + 2 * blk + (p >> 1)) + 8 * (p & 1));
    const s16x4 hi = vtr(img + img_off(R0 + 8 * h + 4 + q, 4 * c + 2 * blk + (p >> 1)) + 8 * (p & 1));
    return (bf16x8){lo[0], lo[1], lo[2], lo[3], hi[0], hi[1], hi[2], hi[3]};
}
__device__ __forceinline__ bf16x8 img_trread_acc(const LAS unsigned char* img, int R0, int c, int lane) {
    const unsigned h = lane >> 5, blk = (lane >> 4) & 1, q = (lane & 15) >> 2, p = lane & 3;
    const s16x4 lo = vtr(img + img_off(R0 + 4 * h + q, 4 * c + 2 * blk + (p >> 1)) + 8 * (p & 1));
    const s16x4 hi = vtr(img + img_off(R0 + 8 + 4 * h + q, 4 * c + 2 * blk + (p >> 1)) + 8 * (p & 1));
    return (bf16x8){lo[0], lo[1], lo[2], lo[3], hi[0], hi[1], hi[2], hi[3]};
}
__device__ __forceinline__ int crow_(int r, int hi) { return (r & 3) + 8 * (r >> 2) + 4 * hi; }
#define MFMA32(a, b, c) __builtin_amdgcn_mfma_f32_32x32x16_bf16((a), (b), (c), 0, 0, 0)

#define RAW_BAR() do { asm volatile("s_waitcnt lgkmcnt(0)" ::: "memory"); __builtin_amdgcn_s_barrier(); asm volatile("" ::: "memory"); } while (0)
constexpr int SC_QT = 0, SC_KT = 16384, SC_QH = 32768, SC_VI = 49152, SC_SI = 65536, SC_PART = 98304, SC_RED = 102400;

constexpr int SR_KH = 98304, SR_PART = 114688, SR_RED = 118784, SR_DV = 119808;
constexpr size_t WS_RB = WS_LST, WS_RE = WS_LST + 32 * MiB;
__device__ __forceinline__ void sr_state_image(LAS unsigned char* lds, const f32x16& acc0, const f32x16& acc1, int db, int eb0, int hi_, int r32_) {
    int lz = lane_id(); asm volatile("" : "+v"(lz)); const int hi = lz >> 5, r32 = lz & 31; (void)hi_; (void)r32_;
#pragma unroll
    for (int r = 0; r < 16; ++r) { const int d = 32 * db + crow_(r, hi);
        { const int e = 32 * eb0 + r32; *(LAS unsigned short*)(lds + SC_SI + img_off(d, e >> 3) + (e & 7) * 2) = (unsigned short)cvtpk(acc0[r], acc0[r]); }
        { const int e = 32 * (eb0 + 1) + r32; *(LAS unsigned short*)(lds + SC_SI + img_off(d, e >> 3) + (e & 7) * 2) = (unsigned short)cvtpk(acc1[r], acc1[r]); } }
}
template <bool OUT>
__device__ __forceinline__ void scan_run_phase(const Args& a, LAS unsigned char* lds, int vcu, int G, int tid, int wave, int lane) {
    unsigned char* ws = a.ws;
    const bf16* QH = (const bf16*)(ws + WS_QH); const bf16* VH = (const bf16*)(ws + WS_VH); const bf16* SG = (const bf16*)(ws + WS_SG);
    const float* GG = (const float*)(ws + WS_G); bf16* HA = (bf16*)(ws + WS_HA);
    float* RB = (float*)(ws + WS_RB); const float* RE = (const float*)(ws + WS_RE); float* RA = (float*)(ws + WS_DC);
    LAS float* part = (LAS float*)(lds + SR_PART); LAS float* red = (LAS float*)(lds + SR_RED); LAS float* dvl = (LAS float*)(lds + SR_DV);
    const int hi = lane >> 5, r32 = lane & 31, db = wave & 3, eb0 = 2 * (wave >> 2);
    for (int unitid = vcu; unitid < 256; unitid += G) {
#pragma unroll 1
      for (int seq = 0; seq < (OUT ? 2 : 1); ++seq) {
        const int hh = seq == 0 ? (unitid >> 4) : (unitid & 15);
        const int c0 = seq == 0 ? 8 * (unitid & 15) : NCHP + (unitid >> 4);
        const int nck = seq == 0 ? 8 : 1;
        f32x16 acc0 = {}, acc1 = {}; f32x2 aprod = {1.f, 1.f};
        if (OUT) {
            const float* E = seq == 0 ? RE + (size_t)unitid * 16384 : a.in[2] + (size_t)unitid * 16384;
#pragma unroll
            for (int r = 0; r < 16; ++r) { int lz = lane_id(); asm volatile("" : "+v"(lz)); const int d = 32 * db + crow_(r, lz >> 5); acc0[r] = E[d * 128 + 32 * eb0 + (lz & 31)]; acc1[r] = E[d * 128 + 32 * (eb0 + 1) + (lz & 31)]; }
            sr_state_image(lds, acc0, acc1, db, eb0, hi, r32);
        }
        f32x2 g[8]; unsigned qv[8]; v4u vch[2];
#define SR_LOAD(cc) do { const size_t rb_ = (size_t)(cc) * 64; \
            _Pragma("unroll") for (int i = 0; i < 8; ++i) { const size_t off = (rb_ + wave * 8 + i) * DM + hh * 128 + 2 * lane; g[i] = *(const f32x2*)(GG + off); if (OUT) qv[i] = *(const unsigned*)(QH + off); } \
            _Pragma("unroll") for (int j = 0; j < 2; ++j) { const int n = tid + 512 * j; vch[j] = *(const v4u*)(VH + (rb_ + (n >> 4)) * DM + hh * 128 + (n & 15) * 8); } } while (0)
        SR_LOAD(c0);
#pragma unroll 1
        for (int k = 0; k < nck; ++k) {
            const int c = c0 + k; const size_t rb = (size_t)c * 64;
#pragma unroll
            for (int i = 1; i < 8; ++i) g[i] += g[i - 1];
            *(LAS f32x2*)(part + wave * 128 + 2 * lane) = g[7];
            RAW_BAR();
            f32x2 offv = {0.f, 0.f}, bmid = {0.f, 0.f}, blast = {0.f, 0.f};
#pragma unroll
            for (int s = 0; s < 8; ++s) { const f32x2 p = *(const LAS f32x2*)(part + s * 128 + 2 * lane); if (s < wave) offv += p; if (s < 4) bmid += p; blast += p; }
#pragma unroll
            for (int i = 0; i < 8; ++i) { const f32x2 b = offv + g[i];
                const f32x2 gr = i ? g[i] - g[i - 1] : g[0];
                const float k0 = 1.f - __expf(gr.x), k1 = 1.f - __expf(gr.y);
                const unsigned o = img_off(wave * 8 + i, lane >> 2) + (lane & 3) * 4;
                *(LAS unsigned*)(lds + SR_KH + o) = cvtpk(k0 * __expf(blast.x - b.x), k1 * __expf(blast.y - b.y));
                if (OUT) { const float q0 = bflo(qv[i]), q1 = bfhi(qv[i]);
                    *(LAS unsigned*)(lds + SC_QH + o) = cvtpk(q0 * __expf(b.x), q1 * __expf(b.y));
                    *(LAS unsigned*)(lds + SC_QT + o) = cvtpk(q0 * __expf(fminf(b.x - bmid.x, 80.f)), q1 * __expf(fminf(b.y - bmid.y, 80.f)));
                    *(LAS unsigned*)(lds + SC_KT + o) = cvtpk(k0 * __expf(fminf(bmid.x - b.x, 80.f)), k1 * __expf(fminf(bmid.y - b.y, 80.f))); } }
#pragma unroll
            for (int j = 0; j < 2; ++j) { const int n = tid + 512 * j; *(LAS v4u*)(lds + SC_VI + img_off(n >> 4, n & 15)) = vch[j]; }
            if (wave == 0) { const f32x2 ev = {__expf(blast.x), __expf(blast.y)}; *(LAS f32x2*)(dvl + 2 * lane) = ev; aprod = aprod * ev; }
            const int eb = wave & 3, tb = wave >> 2;
            const size_t orow = (rb + 32 * tb + r32) * DM + hh * 128 + 32 * eb + 4 * hi;
            v2u sgv[4];
            if (OUT) {
#pragma unroll
                for (int g4 = 0; g4 < 4; ++g4) sgv[g4] = *(const v2u*)(SG + orow + 8 * g4);
            }
            if (k + 1 < nck) SR_LOAD(c + 1);
            RAW_BAR();
            if (OUT) {
                f32x16 o = {};
                {
                    f32x16 X = {};
#pragma unroll
                    for (int ks = 0; ks < 8; ++ks) X = MFMA32(img_rowread(lds + SC_KT, 0, ks, lane), img_rowread(lds + SC_QT, 32 * tb, ks, lane), X);
                    if (tb == 0) {
#pragma unroll
                        for (int r = 0; r < 16; ++r) if (crow_(r, hi) > r32) X[r] = 0.f;
                    }
#pragma unroll
                    for (int s2 = 0; s2 < 2; ++s2) {
                        v4u w; w.x = cvtpk(X[8 * s2 + 0], X[8 * s2 + 1]); w.y = cvtpk(X[8 * s2 + 2], X[8 * s2 + 3]); w.z = cvtpk(X[8 * s2 + 4], X[8 * s2 + 5]); w.w = cvtpk(X[8 * s2 + 6], X[8 * s2 + 7]);
                        o = MFMA32(img_trread_acc(lds + SC_VI, 16 * s2, eb, lane), __builtin_bit_cast(bf16x8, w), o);
                    }
                }
                if (tb == 1) {
                    f32x16 X = {};
#pragma unroll
                    for (int ks = 0; ks < 8; ++ks) X = MFMA32(img_rowread(lds + SC_KT, 32, ks, lane), img_rowread(lds + SC_QT, 32, ks, lane), X);
#pragma unroll
                    for (int r = 0; r < 16; ++r) if (crow_(r, hi) > r32) X[r] = 0.f;
#pragma unroll
                    for (int s2 = 0; s2 < 2; ++s2) {
                        v4u w; w.x = cvtpk(X[8 * s2 + 0], X[8 * s2 + 1]); w.y = cvtpk(X[8 * s2 + 2], X[8 * s2 + 3]); w.z = cvtpk(X[8 * s2 + 4], X[8 * s2 + 5]); w.w = cvtpk(X[8 * s2 + 6], X[8 * s2 + 7]);
                        o = MFMA32(img_trread_acc(lds + SC_VI, 32 + 16 * s2, eb, lane), __builtin_bit_cast(bf16x8, w), o);
                    }
                }
#pragma unroll
                for (int ks = 0; ks < 8; ++ks) o = MFMA32(img_trread_nat(lds + SC_SI, 16 * ks, eb, lane), img_rowread(lds + SC_QH, 32 * tb, ks, lane), o);
                float ss = 0.f;
#pragma unroll
                for (int r = 0; r < 16; ++r) ss += o[r] * o[r];
                ss += __shfl_xor(ss, 32);
                if (lane < 32) red[(tb * 4 + eb) * 32 + lane] = ss;
                RAW_BAR();
                const float tot = (red[(tb * 4 + 0) * 32 + r32] + red[(tb * 4 + 1) * 32 + r32]) + (red[(tb * 4 + 2) * 32 + r32] + red[(tb * 4 + 3) * 32 + r32]);
                const float rn = __builtin_amdgcn_rsqf(tot * (1.f / 128.f) + EPS);
#pragma unroll
                for (int g4 = 0; g4 < 4; ++g4) {
                    const v2u sg = sgv[g4];
                    v2u w; w.x = cvtpk(o[4 * g4 + 0] * rn * bflo(sg.x), o[4 * g4 + 1] * rn * bfhi(sg.x)); w.y = cvtpk(o[4 * g4 + 2] * rn * bflo(sg.y), o[4 * g4 + 3] * rn * bfhi(sg.y));
                    *(v2u*)(HA + orow + 8 * g4) = w;
                }
            }
            { int lz = lane_id(); asm volatile("" : "+v"(lz)); const LAS float* dp = dvl + 32 * db + 4 * (lz >> 5);
#pragma unroll
              for (int r = 0; r < 16; ++r) { const float dv = dp[(r & 3) + 8 * (r >> 2)]; acc0[r] *= dv; acc1[r] *= dv; } }
#pragma unroll
            for (int ks = 0; ks < 4; ++ks) {
                const bf16x8 Af = img_trread_nat(lds + SR_KH, 16 * ks, db, lane);
                const bf16x8 B0 = img_trread_nat(lds + SC_VI, 16 * ks, eb0, lane), B1 = img_trread_nat(lds + SC_VI, 16 * ks, eb0 + 1, lane);
                acc0 = MFMA32(Af, B0, acc0); acc1 = MFMA32(Af, B1, acc1);
            }
            if (OUT && k + 1 < nck) sr_state_image(lds, acc0, acc1, db, eb0, hi, r32);
        }
        if (!OUT) {
            float* Bu = RB + (size_t)unitid * 16384;
#pragma unroll
            for (int r = 0; r < 16; ++r) { int lz = lane_id(); asm volatile("" : "+v"(lz)); const int d = 32 * db + crow_(r, lz >> 5); Bu[d * 128 + 32 * eb0 + (lz & 31)] = acc0[r]; Bu[d * 128 + 32 * (eb0 + 1) + (lz & 31)] = acc1[r]; }
            if (wave == 0) *(f32x2*)(RA + (size_t)unitid * 128 + 2 * lane) = aprod;
        } else if (seq == 1) {
            float* Su = a.out + O_HS + (size_t)unitid * 16384;
#pragma unroll
            for (int r = 0; r < 16; ++r) { int lz = lane_id(); asm volatile("" : "+v"(lz)); const int d = 32 * db + crow_(r, lz >> 5); Su[d * 128 + 32 * eb0 + (lz & 31)] = acc0[r]; Su[d * 128 + 32 * (eb0 + 1) + (lz & 31)] = acc1[r]; }
        }
        __syncthreads();
#undef SR_LOAD
      }
    }
}
__device__ __forceinline__ void scan_runcarry_phase(const Args& a, int vcu, int G, int tid) {
    unsigned char* ws = a.ws;
    const float* RB = (const float*)(ws + WS_RB); float* RE = (float*)(ws + WS_RE); const float* RA = (const float*)(ws + WS_DC);
    for (int p = vcu * 512 + tid; p < 131072; p += G * 512) {
        const int idx = 2 * p, hh = idx >> 14, d = (idx >> 7) & 127, e = idx & 127;
        f32x2 Bv[16]; float Av[16];
#pragma unroll
        for (int r = 0; r < 16; ++r) { const size_t run = (size_t)hh * 16 + r; Bv[r] = *(const f32x2*)(RB + run * 16384 + d * 128 + e); Av[r] = RA[run * 128 + d]; }
        f32x2 E = {0.f, 0.f};
#pragma unroll
        for (int r = 0; r < 16; ++r) { const size_t run = (size_t)hh * 16 + r; *(f32x2*)(RE + run * 16384 + d * 128 + e) = E; E = E * Av[r] + Bv[r]; }
        *(f32x2*)(a.out + O_HP + idx) = E;
    }
}

__device__ __forceinline__ void conv_fix_phase(const Args& a, int layer, int vcu, int G, int tid) {
    unsigned char* ws = a.ws;
    const bf16* SGF = (const bf16*)(ws + WS_GU); const bf16* SGL = SGF + (size_t)(MR / 16) * 4 * DFF; bf16* ACT = (bf16*)(ws + WS_ACT);
    const float* cw = a.in[22] + (size_t)layer * 3 * DFF; const float* cb = a.in[23] + (size_t)layer * DFF; const float* st = a.in[5] + (size_t)layer * 16 * 2 * DFF;
    constexpr int NCC = DFF / 8, NGRP = MR / 16;
    for (int it = vcu * 512 + tid; it < NCC * NGRP; it += G * 512) {
        const int cc = it % NCC, grp = it / NCC, c0 = cc * 8, t0 = grp * 16;
        float w0[8], w1[8], w2[8], bb[8], g1[8], g2[8];
#pragma unroll
        for (int j = 0; j < 8; ++j) { w0[j] = cw[c0 + j]; w1[j] = cw[DFF + c0 + j]; w2[j] = cw[2 * DFF + c0 + j]; bb[j] = cb[c0 + j]; }
        if (t0 == 0) {
#pragma unroll
            for (int j = 0; j < 8; ++j) { g1[j] = 0.f; g2[j] = 0.f; }
        } else if (t0 >= MP && (t0 & 63) == 0) {
            const float* sp = st + (size_t)((t0 - MP) >> 6) * 2 * DFF + c0;
#pragma unroll
            for (int j = 0; j < 8; ++j) { g2[j] = sp[j]; g1[j] = sp[DFF + j]; }
        } else {
            const v4u p2 = *(const v4u*)(SGL + ((size_t)(grp - 1) * 2 + 0) * DFF + c0), p1 = *(const v4u*)(SGL + ((size_t)(grp - 1) * 2 + 1) * DFF + c0);
            g2[0] = bflo(p2.x); g2[1] = bfhi(p2.x); g2[2] = bflo(p2.y); g2[3] = bfhi(p2.y); g2[4] = bflo(p2.z); g2[5] = bfhi(p2.z); g2[6] = bflo(p2.w); g2[7] = bfhi(p2.w);
            g1[0] = bflo(p1.x); g1[1] = bfhi(p1.x); g1[2] = bflo(p1.y); g1[3] = bfhi(p1.y); g1[4] = bflo(p1.z); g1[5] = bfhi(p1.z); g1[6] = bflo(p1.w); g1[7] = bfhi(p1.w);
        }
#pragma unroll
        for (int j2 = 0; j2 < 2; ++j2) {
            const v4u pg = *(const v4u*)(SGF + (((size_t)grp * 2 + j2) * 2 + 0) * DFF + c0), pu = *(const v4u*)(SGF + (((size_t)grp * 2 + j2) * 2 + 1) * DFF + c0);
            float g0[8], up[8], r[8];
            g0[0] = bflo(pg.x); g0[1] = bfhi(pg.x); g0[2] = bflo(pg.y); g0[3] = bfhi(pg.y); g0[4] = bflo(pg.z); g0[5] = bfhi(pg.z); g0[6] = bflo(pg.w); g0[7] = bfhi(pg.w);
            up[0] = bflo(pu.x); up[1] = bfhi(pu.x); up[2] = bflo(pu.y); up[3] = bfhi(pu.y); up[4] = bflo(pu.z); up[5] = bfhi(pu.z); up[6] = bflo(pu.w); up[7] = bfhi(pu.w);
#pragma unroll
            for (int j = 0; j < 8; ++j) { const float cv = bb[j] + w2[j] * g0[j] + w1[j] * g1[j] + w0[j] * g2[j]; r[j] = cv * sigmoidf_(cv) * up[j]; g2[j] = g1[j]; g1[j] = g0[j]; }
            v4u w; w.x = cvtpk(r[0], r[1]); w.y = cvtpk(r[2], r[3]); w.z = cvtpk(r[4], r[5]); w.w = cvtpk(r[6], r[7]);
            *(v4u*)(ACT + (size_t)(t0 + j2) * DFF + c0) = w;
        }
    }
}

__device__ __forceinline__ void diff_combine_phase(const Args& a, int vcu, int G, int wave, int lane) {
    unsigned char* ws = a.ws;
    const float* OA0 = (const float*)(ws + WS_OA); const float* OA1 = OA0 + (size_t)MR * DM; bf16* HA = (bf16*)(ws + WS_HA);
    const float lam = ((const float*)(ws + WS_SMALL))[SM_LAM];
    const int gw = vcu * NWAVES + wave, NGW = G * NWAVES;
    for (int it = gw; it < MR * 8; it += NGW) {
        const size_t off = (size_t)it * 256 + lane * 4;
        const f32x4 x0 = *(const f32x4*)(OA0 + off), x1 = *(const f32x4*)(OA1 + off);
        const f32x4 o = x0 - x1 * lam;
        const float s = wave_sum((o.x * o.x + o.y * o.y) + (o.z * o.z + o.w * o.w));
        const float rn = __builtin_amdgcn_rsqf(s * (1.f / 256.f) + EPS);
        v2u w; w.x = cvtpk(o.x * rn, o.y * rn); w.y = cvtpk(o.z * rn, o.w * rn);
        *(v2u*)(HA + off) = w;
    }
}

#ifndef ATT_NS
#define ATT_NS 8
#endif
__device__ __forceinline__ void attention_phase(const Args& a, char* lds, gu32* qctr, const int wv) {
    unsigned char* ws = a.ws;
    const att::bf16* QN = (const att::bf16*)(ws + WS_QH); const att::bf16* KN = (const att::bf16*)(ws + WS_KH); const att::bf16* VBn = (const att::bf16*)(ws + WS_VH);
    float* OA0 = (float*)(ws + WS_OA); float* OA1 = OA0 + (size_t)MR * DM;
    const int wid = wv; const bool t0 = (wv == 0 && lane_id() == 0);
    volatile unsigned* slot = (volatile unsigned*)(lds + SCR_OFF + 4096);
    const int x0 = (int)(xb_xcc_id() & 7u);
    bool conv_left = true;
    for (int dq = 0; dq < 8; ++dq) {
        const int x = (x0 + dq) & 7;
        for (;;) {
            __syncthreads();
            if (t0) *slot = __hip_atomic_fetch_add(qctr + 64 * x, 1u, __ATOMIC_RELAXED, __HIP_MEMORY_SCOPE_AGENT);
            __syncthreads();
            const int u = __builtin_amdgcn_readfirstlane((int)*slot);
            if (u >= 16 + 64) break;
            const bool smp = u < 8 || (u >= 32 && u < 40);
            if (smp) {
#ifndef NO_SAMPLE
                const int su = u < 8 ? u : u - 24;
                att::attn_sample_unit(QN, KN, VBn, a.in[3], a.in[4], OA0, OA1, 2 * x + (su >> 3), su & 7, lds, wv);
#endif
            } else {
#ifndef NO_PROMPT
                const int v = u < 32 ? u - 8 : u - 16, qb = 31 - (v >> 1), h = x, c = v & 1;
                const size_t qoff = (size_t)qb * 256 * DM + h * 256;
                att::attn_wide_body<0>(QN + qoff + c * 128, KN + h * 256 + c * 128, VBn + h * 256, (c ? OA1 : OA0) + qoff, 4 * qb + 4, 4 * qb + (wid >> 1), lds, wv);
#endif
            }
            if (conv_left) {
                __syncthreads();
                if (t0) *slot = __hip_atomic_fetch_add(qctr + 64 * 8, 1u, __ATOMIC_RELAXED, __HIP_MEMORY_SCOPE_AGENT);
                __syncthreads();
                const int cu_ = __builtin_amdgcn_readfirstlane((int)*slot);
                if (cu_ * 64 >= TR_GRP2_ITEMS) conv_left = false;
                else { const int last = (cu_ * 64 + 64 < TR_GRP2_ITEMS) ? cu_ * 64 + 64 : TR_GRP2_ITEMS; tr_run(a, 2, cu_ * 64 + wid, NWAVES, last, (LAS unsigned*)(lds + wid * 16384), lane_id()); }
            }
        }
    }
    while (conv_left) {
        __syncthreads();
        if (t0) *slot = __hip_atomic_fetch_add(qctr + 64 * 8, 1u, __ATOMIC_RELAXED, __HIP_MEMORY_SCOPE_AGENT);
        __syncthreads();
        const int u = __builtin_amdgcn_readfirstlane((int)*slot);
        if (u * 64 >= TR_GRP2_ITEMS) break;
        const int last = (u * 64 + 64 < TR_GRP2_ITEMS) ? u * 64 + 64 : TR_GRP2_ITEMS;
        tr_run(a, 2, u * 64 + wid, NWAVES, last, (LAS unsigned*)(lds + wid * 16384), lane_id());
    }
}

constexpr int NPH = 17;
#ifndef G1_CUS
#define G1_CUS 224
#endif
constexpr int SPLIT_0 = 7, SPLIT_1 = 8, SPLIT_2 = 8, SPLIT_3 = 8, SPLIT_4 = 8, SPLIT_5 = 8, SPLIT_6 = 8, SPLIT_7 = 8;
__global__ void __launch_bounds__(NWAVES * 64, 2) fwd_kernel(Args args) {
    extern __shared__ __attribute__((aligned(16))) unsigned char lds[];
    LAS unsigned char* L = (LAS unsigned char*)lds;
    volatile LAS unsigned* MISC = (volatile LAS unsigned*)(L + MISC_OFF);
#if defined(__HIP_DEVICE_COMPILE__)
#define ARGSL const __attribute__((address_space(4))) Args* ap__ = (const __attribute__((address_space(4))) Args*)__builtin_amdgcn_kernarg_segment_ptr(); asm volatile("" : "+s"(ap__)); \
    Args A; { _Pragma("unroll") for (int i_ = 0; i_ < 25; ++i_) A.in[i_] = ap__->in[i_]; A.out = ap__->out; A.ws = ap__->ws; A.ph_lo = ap__->ph_lo; A.ph_hi = ap__->ph_hi; }
#else
#define ARGSL const Args A = args
#endif
#define TIDS int t__ = wv * 64 + lane_id(); asm volatile("" : "+v"(t__)); const int tid = t__, lane = t__ & 63; (void)tid; (void)lane
#define ENV int bx = blockIdx.x; int G = gridDim.x; asm volatile("" : "+s"(bx), "+s"(G)); const int vcu = (G % 8 == 0) ? (bx % 8) * (G / 8) + bx / 8 : bx; \
    const int wave = wv; (void)vcu; (void)wave
    const int wv = __builtin_amdgcn_readfirstlane((int)threadIdx.x >> 6);
    for (int u = threadIdx.x; u < (LDS_BYTES - LDSCTL_OFF) / 4; u += NWAVES * 64) ((LAS unsigned*)(L + LDSCTL_OFF))[u] = 0u;
    __syncthreads();
    const int lo = args.ph_lo, hi = args.ph_hi;
#define BAROBJ XcdBarrier bar; bar.wv = wv; ARGSL; bar.bar = (unsigned*)((gu32*)(A.ws + WS_CTL) + CW_BAR); bar.x = xb_xcc_id(); bar.st = MISC + 8
    if (hi - lo > 1) { BAROBJ; (void)xcd_barrier_post(bar.bar, MISC + 8, wv); }
#ifndef PHMASK
#define PHMASK 0x1ffff
#endif
#define IN(k) ((((PHMASK) >> (k)) & 1) && lo <= (k) && (k) < hi)
#ifndef PROBE_MASK
#define PROBE_MASK 0
#endif
#define PR_WORDS ((volatile LAS unsigned long long*)(L + MISC_OFF + 64))
    if (PROBE_MASK && blockIdx.x == 0 && wv == 0 && lane_id() == 0) { PR_WORDS[0] = __builtin_amdgcn_s_memrealtime(); PR_WORDS[1] = 0ull; }
#define SEAM(k) do { if (IN(k) && IN((k) + 1)) { BAROBJ; xcd_barrier(bar); } \
    if (PROBE_MASK && blockIdx.x == 0 && wv == 0 && lane_id() == 0) { const unsigned long long t_ = __builtin_amdgcn_s_memrealtime(); if ((PROBE_MASK >> (k)) & 1) PR_WORDS[1] += t_ - PR_WORDS[0]; PR_WORDS[0] = t_; } } while (0)
#define PTRS ARGSL; unsigned char* ws = A.ws; float* out = A.out; asm volatile("" : "+s"(ws), "+s"(out)); gu32* ctl = (gu32*)(ws + WS_CTL); (void)ctl; (void)out; \
    float* sm = (float*)(ws + WS_SMALL); float* ss1 = (float*)(ctl + CW_SS1); float* ss2 = (float*)(ctl + CW_SS2); float* ss3 = (float*)(ctl + CW_SS3); (void)sm; (void)ss1; (void)ss2; (void)ss3; \
    bf16* XB = (bf16*)(ws + WS_XB); bf16* HA = (bf16*)(ws + WS_HA); float* X1 = (float*)(ws + WS_X1); bf16* GU = (bf16*)(ws + WS_GU); bf16* ACT = (bf16*)(ws + WS_ACT); (void)XB; (void)HA; (void)X1; (void)GU; (void)ACT

    if (IN(0)) { TIDS; ENV; ARGSL; p0_prologue(A, L, vcu, G, wave, lane); }
    SEAM(0);
    if (IN(1)) {
        PTRS; ENV;
        const bool spare = (G == 256);
        if (spare && bx >= G1_CUS) {
            TIDS; tr_run(A, 1, (bx - G1_CUS) * NWAVES + wave, (256 - G1_CUS) * NWAVES, 1 << 30, (LAS unsigned*)(L + RING_OFF + wave * 16384), lane);
        } else {
            const int Gg = spare ? G1_CUS : G, vcg = spare ? (bx % 8) * (G1_CUS / 8) + bx / 8 : vcu;
            pg8::Gemm g{XB, (const bf16*)(ws + WS_W_HIN), MR, NHG, DM}; pg8::SplitOrder S; S.init(MR, NHG, g.K, Gg, bx, vcg, (float*)(ws + WS_SLAB), (unsigned*)(ctl + CW_SKF + 0 * 4096), SPLIT_0, wv);
            EpiHgrnIn E{ws};
            pg8::gemm_phase<EpiHgrnIn, pg8::SplitOrder, true, true>(L + RING_OFF, g, S, E);
        }
    }
    SEAM(1);
    if (IN(2)) { TIDS; ENV; ARGSL; scan_run_phase<false>(A, L, vcu, G, tid, wave, lane); }
    SEAM(2);
    if (IN(3)) { TIDS; ENV; ARGSL; scan_runcarry_phase(A, vcu, G, tid); }
    SEAM(3);
    if (IN(4)) { TIDS; ENV; ARGSL; scan_run_phase<true>(A, L, vcu, G, tid, wave, lane); }
    SEAM(4);
    if (IN(5)) {
        PTRS; ENV;
        pg8::Gemm g{HA, (const bf16*)(ws + WS_W_HOUT), MR, DM, DM}; pg8::SplitOrder S; S.init(MR, DM, g.K, G, bx, vcu, (float*)(ws + WS_SLAB), (unsigned*)(ctl + CW_SKF + 1 * 4096), SPLIT_1, wv);
        EpiResid<true> E{A.in[0], A.in[1] - (size_t)MP * DM, X1, XB, ss1};
        pg8::gemm_phase<EpiResid<true>, pg8::SplitOrder, true, true>(L + RING_OFF, g, S, E);
    }
    SEAM(5);
    if (IN(6)) {
        PTRS; ENV;
        pg8::Gemm g{XB, (const bf16*)(ws + WS_W_UP0), MR, NUP, DM}; pg8::SplitOrder S; S.init(MR, NUP, g.K, G, bx, vcu, (float*)(ws + WS_SLAB), (unsigned*)(ctl + CW_SKF + 2 * 4096), SPLIT_2, wv);
        EpiUp E{ws, ss1, out + O_CP, out + O_CS, A.in[22], A.in[23]};
        pg8::gemm_phase<EpiUp, pg8::SplitOrder, true, true>(L + RING_OFF, g, S, E);
    }
    SEAM(6);
    if (IN(7)) { TIDS; ENV; ARGSL; conv_fix_phase(A, 0, vcu, G, tid); }
    SEAM(7);
    if (IN(8)) {
        PTRS; ENV;
        pg8::Gemm g{ACT, (const bf16*)(ws + WS_W_DN0), MR, DM, DFF}; pg8::SplitOrder S; S.init(MR, DM, g.K, G, bx, vcu, (float*)(ws + WS_SLAB), (unsigned*)(ctl + CW_SKF + 3 * 4096), SPLIT_3, wv);
        EpiResid<true> E{X1, X1, X1, XB, ss2};
        pg8::gemm_phase<EpiResid<true>, pg8::SplitOrder, true, true>(L + RING_OFF, g, S, E);
    }
    SEAM(8);
    if (IN(9)) {
        PTRS; ENV;
        pg8::Gemm g{XB, (const bf16*)(ws + WS_W_DIN), MR, NDI, DM}; pg8::SplitOrderT<16> S; S.init(MR, NDI, g.K, G, bx, vcu, (float*)(ws + WS_SLAB), (unsigned*)(ctl + CW_SKF + 4 * 4096), SPLIT_4, wv);
        EpiDiffIn E{ws, out, A.in[14], A.in[15], (LAS float*)(L + SCR_OFF)};
        pg8::gemm_phase<EpiDiffIn, pg8::SplitOrderT<16>, true, true>(L + RING_OFF, g, S, E);
    }
    SEAM(9);
    if (IN(11)) { PTRS; attention_phase(A, (char*)lds, ctl + CW_ATTQ, wv); }
    SEAM(11);
    if (IN(12)) { TIDS; ENV; ARGSL; diff_combine_phase(A, vcu, G, wave, lane); }
    SEAM(12);
    if (IN(13)) {
        PTRS; ENV;
        pg8::Gemm g{HA, (const bf16*)(ws + WS_W_DOUT), MR, DM, DM}; pg8::SplitOrder S; S.init(MR, DM, g.K, G, bx, vcu, (float*)(ws + WS_SLAB), (unsigned*)(ctl + CW_SKF + 5 * 4096), SPLIT_5, wv);
        EpiResid<true> E{X1, X1, X1, XB, ss3};
        pg8::gemm_phase<EpiResid<true>, pg8::SplitOrder, true, true>(L + RING_OFF, g, S, E);
    }
    SEAM(13);
    if (IN(14)) {
        PTRS; ENV;
        pg8::Gemm g{XB, (const bf16*)(ws + WS_W_UP1), MR, NUP, DM}; pg8::SplitOrder S; S.init(MR, NUP, g.K, G, bx, vcu, (float*)(ws + WS_SLAB), (unsigned*)(ctl + CW_SKF + 6 * 4096), SPLIT_6, wv);
        EpiUp E{ws, ss3, out + O_CP + 2 * DFF, out + O_CS + (size_t)16 * 2 * DFF, A.in[22] + 3 * DFF, A.in[23] + DFF};
        pg8::gemm_phase<EpiUp, pg8::SplitOrder, true, true>(L + RING_OFF, g, S, E);
    }
    SEAM(14);
    if (IN(15)) { TIDS; ENV; ARGSL; conv_fix_phase(A, 1, vcu, G, tid); }
    SEAM(15);
    if (IN(16)) {
        PTRS; ENV;
        pg8::Gemm g{ACT, (const bf16*)(ws + WS_W_DN1), MR, DM, DFF}; pg8::SplitOrder S; S.init(MR, DM, g.K, G, bx, vcu, (float*)(ws + WS_SLAB), (unsigned*)(ctl + CW_SKF + 7 * 4096), SPLIT_7, wv);
        EpiResid<false> E{X1, X1, out + O_Y, nullptr, nullptr};
        pg8::gemm_phase<EpiResid<false>, pg8::SplitOrder, true, true>(L + RING_OFF, g, S, E);
    }
#if defined(XPROBE)
    {
        { BAROBJ; xcd_barrier(bar); }
        unsigned long long tx0 = __builtin_amdgcn_s_memrealtime();
        { PTRS; ENV;
          const att::bf16* QN = (const att::bf16*)(ws + WS_QH); const att::bf16* KN = (const att::bf16*)(ws + WS_KH); const att::bf16* VBn = (const att::bf16*)(ws + WS_VH);
          float* OA0 = (float*)(ws + WS_OA); float* OA1 = OA0 + (size_t)MR * DM;
#if XPROBE_VAR >= 9
          {
            constexpr int K_ = XPROBE_VAR >= 20 ? 0 : XPROBE_VAR - 10; constexpr int SV_ = XPROBE_VAR >= 20 ? XPROBE_VAR - 20 : 0;     const int li = (int)(blockIdx.x >> 3), x = (int)(blockIdx.x & 7);
            if (XPROBE_VAR == 13) { const int u = li & 15; att::attn_sample_unit(QN, KN, VBn, A.in[3], A.in[4], OA0, OA1, 2 * x + (u >> 3), u & 7, (char*)lds, wv); }
            else if (XPROBE_VAR >= 10 && li < (16 >> K_)) {
#pragma unroll 1
              for (int r = 0; r < (1 << K_); ++r) { const int u = li + r * (16 >> K_); att::attn_sample_unit<SV_>(QN, KN, VBn, A.in[3], A.in[4], OA0, OA1, 2 * x + (u >> 3), u & 7, (char*)lds, wv); }
            }
          }
#else
          for (int p = vcu; p < 256; p += G) {
#pragma unroll 1
            for (int half = 0; half < 2; ++half) { const int hc = p >> 4, pr = p & 15, h = hc >> 1, c = hc & 1, qb = half ? 31 - pr : pr; const size_t qoff = (size_t)qb * 256 * DM + h * 256;
              att::attn_wide_body<XPROBE_VAR>(QN + qoff + c * 128, KN + h * 256 + c * 128, VBn + h * 256, (c ? OA1 : OA0) + qoff, 4 * qb + 4, 4 * qb + (wv >> 1), (char*)lds, wv); } }
#endif
        }
        { BAROBJ; xcd_barrier(bar); }
        if (blockIdx.x == 0 && wv == 0 && lane_id() == 0) { const unsigned long long w_ = __builtin_amdgcn_s_memrealtime() - tx0, t0_ = __builtin_amdgcn_s_memrealtime(); while (__builtin_amdgcn_s_memrealtime() - t0_ < w_) __builtin_amdgcn_s_sleep(32); }
    }
#endif
    if (PROBE_MASK && blockIdx.x == 0 && wv == 0 && lane_id() == 0) { if ((PROBE_MASK >> 16) & 1) PR_WORDS[1] += __builtin_amdgcn_s_memrealtime() - PR_WORDS[0];
        const unsigned long long t0_ = __builtin_amdgcn_s_memrealtime(), w_ = PR_WORDS[1]; while (__builtin_amdgcn_s_memrealtime() - t0_ < w_) __builtin_amdgcn_s_sleep(32); }
#undef IN
#undef SEAM
}

#ifndef MK_PER_PHASE
#define MK_PER_PHASE 0
#endif
extern "C" void kernel_launch(void* const* d_in, const int* in_sizes, int n_in, void* d_out, int out_size, void* d_ws, size_t ws_size, hipStream_t stream) {
    static int grid = 0;
    if (grid == 0) {
        if (n_in != 25 || out_size != (int)O_END || ws_size < WS_END) { fprintf(stderr, "kernel_launch: built for 25 inputs, %zu outputs, >= %zu bytes of workspace; got n_in %d, out %d, ws %zu; nothing launched\n", (size_t)O_END, (size_t)WS_END, n_in, out_size, ws_size); grid = -1; return; }
        int dev = 0, cus = 0, per_cu = 0;
        if (hipGetDevice(&dev) != hipSuccess || hipDeviceGetAttribute(&cus, hipDeviceAttributeMultiprocessorCount, dev) != hipSuccess) { fprintf(stderr, "kernel_launch: device query failed\n"); grid = -1; return; }
        if (hipFuncSetAttribute((const void*)fwd_kernel, hipFuncAttributeMaxDynamicSharedMemorySize, LDS_BYTES) != hipSuccess) { fprintf(stderr, "kernel_launch: hipFuncSetAttribute failed\n"); grid = -1; return; }
        if (hipOccupancyMaxActiveBlocksPerMultiprocessor(&per_cu, (const void*)fwd_kernel, NWAVES * 64, LDS_BYTES) != hipSuccess || per_cu < 1)
            fprintf(stderr, "kernel_launch: note: occupancy query reports %d workgroups per CU\n", per_cu);
        (void)hipGetLastError();
        grid = cus;
    }
    if (grid < 0) return;
    if (hipMemsetAsync((char*)d_ws + WS_CTL, 0, CTL_ZERO_BYTES, stream) != hipSuccess) { fprintf(stderr, "kernel_launch: memset failed\n"); return; }
    Args a{};
    for (int i = 0; i < 25; ++i) a.in[i] = (const float*)d_in[i];
    a.out = (float*)d_out; a.ws = (unsigned char*)d_ws;
#if MK_PER_PHASE
    for (int ph = 0; ph < NPH; ++ph) { a.ph_lo = ph; a.ph_hi = ph + 1; hipLaunchKernelGGL(fwd_kernel, dim3(grid), dim3(NWAVES * 64), LDS_BYTES, stream, a); }
#else
    a.ph_lo = 0; a.ph_hi = NPH; hipLaunchKernelGGL(fwd_kernel, dim3(grid), dim3(NWAVES * 64), LDS_BYTES, stream, a);
#endif
    const hipError_t le = hipPeekAtLastError();
    if (le != hipSuccess) fprintf(stderr, "kernel_launch: launch failed: %s\n", hipGetErrorName(le));
}
```

```cpp
#include <hip/hip_runtime.h>
#include <hip/hip_bf16.h>
#include <cstdio>
#include <cstdint>
#include <cmath>

constexpr int DM = 2048;
constexpr int MP = 8192, MS = 1024;
constexpr int MR = MP + MS;
constexpr int DFF = 5632, NUP = 2 * DFF;
constexpr int NHG = 4 * DM;
constexpr int NDI = 3 * DM;
constexpr int NCH = MR / 64;
constexpr int NCHP = MP / 64;
constexpr int PAST = 4096;
constexpr float EPS = 1e-6f;
constexpr float LAM_INIT = 0.35550906759f;

constexpr size_t O_Y = 0;
constexpr size_t O_HP = (size_t)MR * DM;
constexpr size_t O_HS = O_HP + 16 * 128 * 128;
constexpr size_t O_KP = O_HS + (size_t)16 * 16 * 128 * 128;
constexpr size_t O_VP = O_KP + (size_t)MP * DM;
constexpr size_t O_KS = O_VP + (size_t)MP * DM;
constexpr size_t O_VS = O_KS + (size_t)MS * DM;
constexpr size_t O_CP = O_VS + (size_t)MS * DM;
constexpr size_t O_CS = O_CP + 2 * 2 * DFF;
constexpr size_t O_END = O_CS + (size_t)2 * 16 * 2 * DFF;
static_assert(O_END == 61462528, "output size");

constexpr size_t MiB = 1u << 20;
constexpr size_t WS_CTL = 0, CTL_ZERO_BYTES = 1 * MiB;
constexpr size_t WS_SMALL = 1 * MiB;
constexpr size_t WS_W_HIN = 2 * MiB, WS_W_HOUT = 34 * MiB, WS_W_UP0 = 42 * MiB, WS_W_DN0 = 86 * MiB, WS_W_DIN = 108 * MiB, WS_W_DOUT = 132 * MiB, WS_W_UP1 = 140 * MiB, WS_W_DN1 = 184 * MiB;
constexpr size_t WS_XB = 206 * MiB, WS_QH = 242 * MiB, WS_KH = 278 * MiB, WS_VH = 314 * MiB, WS_SG = 350 * MiB, WS_G = 386 * MiB;
constexpr size_t WS_LST = 458 * MiB, WS_DC = 602 * MiB, WS_SIN = 604 * MiB, WS_HA = 676 * MiB, WS_X1 = 712 * MiB, WS_GU = 784 * MiB, WS_ACT = 982 * MiB;
constexpr size_t WS_QKR = 1081 * MiB, WS_OA = 1153 * MiB, WS_SLAB = 1297 * MiB, WS_END = 1329 * MiB;
constexpr int CW_TMO = 0;
constexpr int CW_ATTQ = 2048;
constexpr int CW_BAR = 4096;
constexpr int CW_SKF = 131072;
constexpr int CW_SS1 = 65536, CW_SS2 = 65536 + 16384, CW_SS3 = 65536 + 2 * 16384;
constexpr int SM_RINV0 = 0, SM_LB = 16384, SM_LAM = 16384 + 4096;

constexpr int RING_OFF = 0, RING_BYTES = 131072;
constexpr int SCR_OFF = RING_BYTES;
constexpr int LDSCTL_OFF = RING_BYTES + 8192, MISC_OFF = LDSCTL_OFF + 320;
constexpr int LDS_BYTES = 147456;
constexpr int NWAVES = 8;

#define GAS __attribute__((address_space(1)))
#define LAS __attribute__((address_space(3)))
typedef unsigned short bf16;
typedef unsigned v4u __attribute__((ext_vector_type(4)));
typedef unsigned v2u __attribute__((ext_vector_type(2)));
typedef float f32x4 __attribute__((ext_vector_type(4)));
typedef float f32x2 __attribute__((ext_vector_type(2)));
typedef float f32x16 __attribute__((ext_vector_type(16)));
typedef short bf16x8 __attribute__((ext_vector_type(8)));
typedef short s16x4 __attribute__((ext_vector_type(4)));
typedef GAS unsigned gu32;
#define RLX_AGENT __ATOMIC_RELAXED, __HIP_MEMORY_SCOPE_AGENT
#define LDS_WAIT() asm volatile("s_waitcnt lgkmcnt(0)" ::: "memory")
#define VM_WAIT() asm volatile("s_waitcnt vmcnt(0)" ::: "memory")
__device__ __forceinline__ unsigned f2bf(float f) { unsigned u = __builtin_bit_cast(unsigned, f); return (u + 0x7fffu + ((u >> 16) & 1u)) >> 16; }
__device__ __forceinline__ unsigned pk2(float lo, float hi) { return f2bf(lo) | (f2bf(hi) << 16); }
__device__ __forceinline__ unsigned cvtpk(float lo, float hi) { unsigned r; asm volatile("v_cvt_pk_bf16_f32 %0, %1, %2" : "=v"(r) : "v"(lo), "v"(hi)); return r; }
__device__ __forceinline__ float bflo(unsigned w) { return __uint_as_float(w << 16); }
__device__ __forceinline__ float bfhi(unsigned w) { return __uint_as_float(w & 0xffff0000u); }
__device__ __forceinline__ float wave_sum(float v) {
#pragma unroll
    for (int o = 1; o < 64; o <<= 1) v += __shfl_xor(v, o);
    return v;
}
__device__ __forceinline__ int lane_id() { int r; asm volatile("v_mbcnt_lo_u32_b32 %0, -1, 0\n\tv_mbcnt_hi_u32_b32 %0, -1, %0" : "=v"(r)); return r; }
__device__ __forceinline__ float sigmoidf_(float z) { return __builtin_amdgcn_rcpf(1.f + __expf(-z)); }
namespace pg8 {
#define PG8_LAS __attribute__((address_space(3)))
typedef unsigned short bf16_t;
typedef short bf16x8 __attribute__((ext_vector_type(8)));
typedef float f32x4 __attribute__((ext_vector_type(4)));
typedef unsigned u32x4 __attribute__((ext_vector_type(4)));
constexpr int BM = 256, BK = 64, HALF = 128, HTB = HALF * BK * 2  , STAGE_BYTES = 8 * HTB, NXCD = 8, WGM = 8;

__host__ __device__ __forceinline__ int lds_byte(int r, int c) { const int st = (r >> 4) * 2 + (c >> 5), rr = r & 15, cc = c & 31, ob = rr * 64 + cc * 2; return st * 1024 + (ob ^ (((ob >> 9) & 1) << 5)); }
__host__ __device__ __forceinline__ void stage_rc(int b, int& R, int& C) { const int st = b / 1024, sb = b % 1024, swz = sb ^ (((sb >> 9) & 1) << 5); R = (st >> 1) * 16 + swz / 64; C = (st & 1) * 32 + (swz % 64) / 2; }
__host__ __device__ __forceinline__ int perm32(int rho) { const int n = rho >> 4, i = rho & 15; return 8 * (i >> 2) + 4 * n + (i & 3); }

struct Unit { int pm, pn; int k0, nk, mode, tt, sj, ss; };
struct Gemm { const bf16_t* A; const bf16_t* Bt; int M, N, K; };

struct StaticOrder {
    int nM, nN, nwg, G, c;
    __host__ __device__ void init(int M, int N, int G_, int c_) { nM = M / BM; nN = N / BM; nwg = nM * nN; G = G_; c = c_; }
    __host__ __device__ bool next(int i, Unit& u) const {
        const long L = (long)i * G + c; if (L >= nwg) return false;
        int wgid = (int)L; { const int q = nwg / NXCD, r = nwg % NXCD, xcd = wgid % NXCD, off = wgid / NXCD; wgid = (xcd < r ? xcd * (q + 1) : r * (q + 1) + (xcd - r) * q) + off; }
        const int nig = WGM * nN, gid = wgid / nig, fm = gid * WGM, gsz = (nM - fm) < WGM ? (nM - fm) : WGM;
        u.pm = fm + ((wgid % nig) % gsz); u.pn = (wgid % nig) / gsz; return true;
    }
    __device__ __forceinline__ void a_ready(const Unit&) const {}
    __device__ __forceinline__ void done(const Unit&) const {}
};

__device__ __forceinline__ unsigned cvt_pk_bf16(float lo, float hi) { unsigned r; asm volatile("v_cvt_pk_bf16_f32 %0, %1, %2" : "=v"(r) : "v"(lo), "v"(hi)); return r; }
typedef float f32x2 __attribute__((ext_vector_type(2)));
template <int nN1>
struct SplitOrderT {
    int nM, nN, nwg, G, c, vc, R, r, s, npairs, wv; float* slab; unsigned* flags;
    __device__ __forceinline__ void init(int M, int N, int K, int G_, int c_, int vc_, float* slab_, unsigned* flags_, int smax, int wv_) { wv = wv_;
        nM = M / BM; nN = N / BM; nwg = nM * nN; G = __builtin_amdgcn_readfirstlane(G_); c = __builtin_amdgcn_readfirstlane(c_); vc = __builtin_amdgcn_readfirstlane(vc_); R = nwg / G;
        r = nwg - R * G; s = r ? G / r : 1; if (s > smax) s = smax; if (nN1 > 0 && !(r == 96 && G == 256 && s == 2)) s = 0; npairs = K / (2 * BK); slab = slab_; flags = flags_; }
    __device__ __forceinline__ void tile(int L, Unit& u) const {
        int nNg = nN, nwgg = nwg, pn0 = 0;
        if (nN1 > 0) { if (L >= nM * nN1) { L -= nM * nN1; nNg = nN - nN1; pn0 = nN1; } else nNg = nN1; nwgg = nM * nNg; }
        int wgid = L; { const int q = nwgg / NXCD, rr = nwgg % NXCD, xcd = wgid % NXCD, off = wgid / NXCD; wgid = (xcd < rr ? xcd * (q + 1) : rr * (q + 1) + (xcd - rr) * q) + off; }
        const int nig = WGM * nNg, gid = wgid / nig, fm = gid * WGM, gsz = (nM - fm) < WGM ? (nM - fm) : WGM;
        u.pm = fm + ((wgid % nig) % gsz); u.pn = pn0 + (wgid % nig) / gsz; }
    static constexpr int MIX3 = 64;
    __device__ __forceinline__ bool mixed() const { return nN1 > 0; }
    __device__ __forceinline__ bool has_slice() const { return s > 0 && vc < (mixed() ? 256 : r * s); }
    __device__ __forceinline__ void slice(Unit& u) const {
        int tt = vc / s, j = vc - tt * s, sl = s;
        if (mixed()) { const int hi3 = vc < 3 * MIX3; tt = __builtin_amdgcn_readfirstlane(hi3 ? (vc & 63) : MIX3 + (vc & 31)); j = __builtin_amdgcn_readfirstlane(hi3 ? (vc >> 6) : ((vc >> 5) & 1)); sl = __builtin_amdgcn_readfirstlane(hi3 ? 3 : 2); }
        tile(R * G + tt, u);
        const int p0 = (j * npairs) / sl, p1 = ((j + 1) * npairs) / sl; u.k0 = 2 * p0; u.nk = 2 * (p1 - p0); u.mode = 3; u.tt = tt; u.sj = j; u.ss = sl; }
    __device__ __forceinline__ bool next(int i_, Unit& u) const {
        int i = __builtin_amdgcn_readfirstlane(i_);
        if (has_slice()) { if (i == 0) { slice(u); return true; } --i; }
        if (i < R) { tile(i * G + c, u); u.k0 = 0; u.nk = 2 * npairs; u.mode = 0; u.tt = 0; u.sj = 0; u.ss = 1; return true; }
        if (i > R || s > 0 || c >= r) return false;
        tile(R * G + c, u); u.k0 = 0; u.nk = 2 * npairs; u.mode = 0; u.tt = 0; u.sj = 0; u.ss = 1; return true;
    }
    __device__ __forceinline__ void a_ready(const Unit&) const {}
    __device__ __forceinline__ void done(const Unit&) const {}
    template <class Epi>
    __device__ __forceinline__ bool pre(f32x4 (&acc)[2][2][4][2], const Unit& u, int wid, int lane, const Epi& E) const {
        if (u.mode == 0) return true;
        const __amdgpu_buffer_rsrc_t rs = __builtin_amdgcn_make_buffer_rsrc((void*)slab, (short)0, 256 * 131072, 0x00020000);
        {
            unsigned off = (unsigned)vc * 131072u + (unsigned)wid * 16384u + (unsigned)lane * 16u;
#pragma unroll
            for (int ai = 0; ai < 2; ++ai)
#pragma unroll
                for (int m = 0; m < 4; ++m)
#pragma unroll
                    for (int bj = 0; bj < 2; ++bj) { const f32x4 a = acc[ai][bj][m][0], b = acc[ai][bj][m][1];
                        u32x4 w; w.x = cvt_pk_bf16(a[0], a[1]); w.y = cvt_pk_bf16(a[2], a[3]); w.z = cvt_pk_bf16(b[0], b[1]); w.w = cvt_pk_bf16(b[2], b[3]);
                        __builtin_amdgcn_raw_buffer_store_b128(w, rs, off + (unsigned)(((ai * 4 + m) * 2 + bj) * 1024), 0, 16); }
            asm volatile("s_waitcnt vmcnt(0)" ::: "memory");
        }
        __builtin_amdgcn_s_barrier();
        if (wid == 0 && lane == 0) __hip_atomic_fetch_add(flags + 32 * u.tt, 1u, __ATOMIC_RELAXED, __HIP_MEMORY_SCOPE_AGENT);
        return false;
    }
    template <class Epi>
    __device__ __forceinline__ void post(const Epi& E, int wid, int lane) const {
        if (!has_slice()) return;
        Unit u; slice(u);
        const __amdgpu_buffer_rsrc_t rs = __builtin_amdgcn_make_buffer_rsrc((void*)slab, (short)0, 256 * 131072, 0x00020000);
        if (wid == 0) {
            const unsigned* fl = flags + 32 * u.tt; const unsigned want = (unsigned)u.ss; unsigned spins = 0;
            while ((unsigned)__builtin_amdgcn_readfirstlane(__hip_atomic_load(fl, __ATOMIC_RELAXED, __HIP_MEMORY_SCOPE_AGENT)) < want) { __builtin_amdgcn_s_sleep(16); if (++spins > (1u << 20)) break; }
        }
        __builtin_amdgcn_s_barrier();
        asm volatile("" ::: "memory");
        const int fr = lane & 15, fq = lane >> 4;
        const int sbase = !mixed() ? u.tt * u.ss : (u.ss == 3 ? u.tt : 192 + (u.tt - MIX3)); const unsigned sstr = !mixed() ? 131072u : (u.ss == 3 ? 64u * 131072u : 32u * 131072u);
        for (int p = u.sj; p < 8; p += u.ss) {
            f32x4 vv[2][2];
#pragma unroll
            for (int gg = 0; gg < 2; ++gg) {
                const int g = 2 * wid + gg;
                const unsigned off = (unsigned)sbase * 131072u + (unsigned)p * 16384u + (unsigned)g * 1024u + (unsigned)lane * 16u;
                u32x4 t[8];
#pragma unroll
                for (int jp = 0; jp < 8; ++jp) if (jp < u.ss) t[jp] = __builtin_amdgcn_raw_buffer_load_b128(rs, off + (unsigned)jp * sstr, 0, 16);
                f32x4 v0 = {0.f, 0.f, 0.f, 0.f}, v1 = {0.f, 0.f, 0.f, 0.f};
#pragma unroll
                for (int jp = 0; jp < 8; ++jp) if (jp < u.ss) {
                    v0 += (f32x4){__uint_as_float(t[jp].x << 16), __uint_as_float(t[jp].x & 0xffff0000u), __uint_as_float(t[jp].y << 16), __uint_as_float(t[jp].y & 0xffff0000u)};
                    v1 += (f32x4){__uint_as_float(t[jp].z << 16), __uint_as_float(t[jp].z & 0xffff0000u), __uint_as_float(t[jp].w << 16), __uint_as_float(t[jp].w & 0xffff0000u)}; }
                vv[gg][0] = v0; vv[gg][1] = v1;
                if constexpr (!Epi::PAIR) E.group(u, p >> 2, p & 3, fr, fq, g >> 3, (g >> 1) & 3, g & 1, v0, v1);
            }
            if constexpr (Epi::PAIR) E.group2(u, p >> 2, p & 3, fr, fq, wid >> 2, wid & 3, vv[0][0], vv[0][1], vv[1][0], vv[1][1]);
        }
    }
};
typedef SplitOrderT<0> SplitOrder;
template <class Epi, class Sched, bool ALIGN_EPI = false, bool SP2 = false>
__device__ __forceinline__ void gemm_phase(PG8_LAS unsigned char* lds, const Gemm g, const Sched& S, const Epi& E) {
    const int wid = S.wv, lane = lane_id(), tid = wid * 64 + lane, wr = wid >> 2, wc = wid & 3, fr = lane & 15, fq = lane >> 4;
    const int K = g.K;
    unsigned voffA[2], voffB[2];
#pragma unroll
    for (int i = 0; i < 2; ++i) { int R, C; stage_rc(tid * 16 + i * 8192, R, C); const int Rb = Epi::PERM ? ((R & ~31) + perm32(R & 31)) : R;
        voffA[i] = (unsigned)(R * K + C) * 2u; voffB[i] = (unsigned)(Rb * K + C) * 2u; }
    const size_t kstep = (size_t)(BK * 2);
    const size_t hstep = (size_t)HALF * K * 2;
    const size_t tstep = 2 * hstep;
    const unsigned ldsw = (unsigned)wid * 1024u;
    const int aoff = lds_byte(wr * 64 + fr, fq * 8), boff = lds_byte(wc * 32 + fr, fq * 8);
#define PG8_SA(b, h) (((b) * 2 + (h)) * HTB)
#define PG8_SB(b, h) ((4 + (b) * 2 + (h)) * HTB)
#define PG8_STAGE(bufoff, gbase, voff) do { _Pragma("unroll") for (int _i = 0; _i < 2; ++_i) \
        __builtin_amdgcn_global_load_lds((const unsigned*)((const char*)(gbase) + (voff)[_i]), (PG8_LAS unsigned*)(lds + (bufoff) + ldsw + _i * 8192), 16, 0, 0); } while (0)
#define PG8_LDA(dst, b, h) do { _Pragma("unroll") for (int m = 0; m < 4; ++m) _Pragma("unroll") for (int k = 0; k < 2; ++k) dst[m][k] = *(const PG8_LAS bf16x8*)(lds + PG8_SA(b, h) + aoff + m * 2048 + k * 1024); } while (0)
#define PG8_LDB(dst, b, h) do { _Pragma("unroll") for (int n = 0; n < 2; ++n) _Pragma("unroll") for (int k = 0; k < 2; ++k) dst[n][k] = *(const PG8_LAS bf16x8*)(lds + PG8_SB(b, h) + boff + n * 2048 + k * 1024); } while (0)
#define PG8_MMA(ai, bj, At, Bt) do { __builtin_amdgcn_s_setprio(1); _Pragma("unroll") for (int m = 0; m < 4; ++m) _Pragma("unroll") for (int n = 0; n < 2; ++n) _Pragma("unroll") for (int k = 0; k < 2; ++k) \
        acc[ai][bj][m][n] = __builtin_amdgcn_mfma_f32_16x16x32_bf16(Bt[n][k], At[m][k], acc[ai][bj][m][n], 0, 0, 0); __builtin_amdgcn_s_setprio(0); } while (0)
#define PG8_WAIT_V(n) asm volatile("s_waitcnt vmcnt(" #n ")" ::: "memory")
#define PG8_WAIT_L(n) asm volatile("s_waitcnt lgkmcnt(" #n ")" ::: "memory")
#define PG8_BAR __builtin_amdgcn_s_barrier()
#define PG8_SCHED __builtin_amdgcn_sched_barrier(0)
    Unit cur, nxt; int ui = 0;
    if (!S.next(0, cur)) return;
    f32x4 acc[2][2][4][2];
#pragma unroll
    for (int a = 0; a < 2; ++a)
#pragma unroll
        for (int b = 0; b < 2; ++b)
#pragma unroll
            for (int m = 0; m < 4; ++m)
#pragma unroll
                for (int n = 0; n < 2; ++n) acc[a][b][m][n] = (f32x4){0.f, 0.f, 0.f, 0.f};
    bf16x8 At[4][2], B0[2][2], B1[2][2];
    const char* cA = (const char*)g.A + (size_t)cur.pm * tstep + (size_t)cur.k0 * kstep; const char* cB = (const char*)g.Bt + (size_t)cur.pn * tstep + (size_t)cur.k0 * kstep;
    S.a_ready(cur);
    if constexpr (SP2) {
        PG8_STAGE(PG8_SB(0, 0), cB, voffB); PG8_STAGE(PG8_SB(0, 1), cB + hstep, voffB); PG8_STAGE(PG8_SA(0, 0), cA, voffA); PG8_STAGE(PG8_SA(0, 1), cA + hstep, voffA);
        if (wr == 1) PG8_BAR;
        PG8_WAIT_V(2); PG8_BAR;
        PG8_STAGE(PG8_SB(1, 0), cB + kstep, voffB); PG8_STAGE(PG8_SA(1, 0), cA + kstep, voffA); PG8_STAGE(PG8_SB(1, 1), cB + hstep + kstep, voffB);
        PG8_WAIT_V(6); PG8_BAR;
    } else {
        PG8_STAGE(PG8_SB(0, 0), cB, voffB); PG8_STAGE(PG8_SA(0, 0), cA, voffA); PG8_STAGE(PG8_SB(0, 1), cB + hstep, voffB); PG8_STAGE(PG8_SA(0, 1), cA + hstep, voffA);
        if (wr == 1) PG8_BAR;
        PG8_WAIT_V(4); PG8_BAR;
        PG8_STAGE(PG8_SB(1, 0), cB + kstep, voffB); PG8_STAGE(PG8_SA(1, 0), cA + kstep, voffA); PG8_STAGE(PG8_SB(1, 1), cB + hstep + kstep, voffB);
        PG8_WAIT_V(6); PG8_BAR;
    }
    for (;;) {
        const bool has_next = S.next(ui + 1, nxt);
        const char* nA = has_next ? (const char*)g.A + (size_t)nxt.pm * tstep + (size_t)nxt.k0 * kstep : cA; const char* nB = has_next ? (const char*)g.Bt + (size_t)nxt.pn * tstep + (size_t)nxt.k0 * kstep : cB;
        const int nt = cur.nk;
        for (int t = 0; t < nt; t += 2) {
            const bool last = (t == nt - 2);
            const char* a1 = cA + (size_t)(t + 1) * kstep;
            const char* a2 = last ? nA : cA + (size_t)(t + 2) * kstep; const char* b2 = last ? nB : cB + (size_t)(t + 2) * kstep;
            const char* a3 = a2 + kstep; const char* b3 = b2 + kstep;
            if (last && has_next) S.a_ready(nxt);
            if constexpr (SP2) {
            PG8_LDB(B0, 0, 0); PG8_LDB(B1, 0, 1); PG8_SCHED; PG8_LDA(At, 0, 0); PG8_STAGE(PG8_SA(1, 1), a1 + hstep, voffA);
            PG8_WAIT_V(8); PG8_WAIT_L(0); PG8_BAR; PG8_MMA(0, 0, At, B0); PG8_MMA(0, 1, At, B1); PG8_BAR; PG8_SCHED;
            PG8_LDA(At, 0, 1); PG8_STAGE(PG8_SB(0, 0), b2, voffB); PG8_STAGE(PG8_SB(0, 1), b2 + hstep, voffB); PG8_STAGE(PG8_SA(0, 0), a2, voffA);
            PG8_WAIT_V(8); PG8_WAIT_L(0); PG8_BAR; PG8_MMA(1, 0, At, B0); PG8_MMA(1, 1, At, B1); PG8_BAR; PG8_SCHED;
            PG8_LDB(B0, 1, 0); PG8_LDB(B1, 1, 1); PG8_SCHED; PG8_LDA(At, 1, 0); PG8_STAGE(PG8_SA(0, 1), a2 + hstep, voffA);
            PG8_WAIT_V(8); PG8_WAIT_L(0); PG8_BAR; PG8_MMA(0, 0, At, B0); PG8_MMA(0, 1, At, B1); PG8_BAR; PG8_SCHED;
            PG8_LDA(At, 1, 1); PG8_STAGE(PG8_SB(1, 0), b3, voffB); PG8_STAGE(PG8_SB(1, 1), b3 + hstep, voffB); PG8_STAGE(PG8_SA(1, 0), a3, voffA);
            PG8_WAIT_V(8); PG8_WAIT_L(0); PG8_BAR; PG8_MMA(1, 0, At, B0); PG8_MMA(1, 1, At, B1); PG8_BAR; PG8_SCHED;
            } else {
            PG8_LDB(B0, 0, 0); PG8_SCHED; PG8_LDA(At, 0, 0); PG8_STAGE(PG8_SA(1, 1), a1 + hstep, voffA);
            PG8_WAIT_L(8); PG8_BAR; PG8_WAIT_L(0); PG8_MMA(0, 0, At, B0); PG8_BAR; PG8_SCHED;
            PG8_LDB(B1, 0, 1); PG8_STAGE(PG8_SB(0, 0), b2, voffB);
            PG8_BAR; PG8_WAIT_L(0); PG8_MMA(0, 1, At, B1); PG8_BAR;
            PG8_LDA(At, 0, 1); PG8_STAGE(PG8_SA(0, 0), a2, voffA);
            PG8_BAR; PG8_WAIT_L(0); PG8_MMA(1, 0, At, B0); PG8_BAR; PG8_SCHED;
            PG8_STAGE(PG8_SB(0, 1), b2 + hstep, voffB);
            PG8_WAIT_V(6); PG8_BAR; PG8_MMA(1, 1, At, B1); PG8_BAR;
            PG8_LDB(B0, 1, 0); PG8_SCHED; PG8_LDA(At, 1, 0); PG8_STAGE(PG8_SA(0, 1), a2 + hstep, voffA);
            PG8_WAIT_L(8); PG8_BAR; PG8_WAIT_L(0); PG8_MMA(0, 0, At, B0); PG8_BAR; PG8_SCHED;
            PG8_LDB(B1, 1, 1); PG8_STAGE(PG8_SB(1, 0), b3, voffB);
            PG8_BAR; PG8_WAIT_L(0); PG8_MMA(0, 1, At, B1); PG8_BAR;
            PG8_LDA(At, 1, 1); PG8_STAGE(PG8_SA(1, 0), a3, voffA);
            PG8_BAR; PG8_WAIT_L(0); PG8_MMA(1, 0, At, B0); PG8_BAR; PG8_SCHED;
            PG8_STAGE(PG8_SB(1, 1), b3 + hstep, voffB);
            PG8_WAIT_V(6); PG8_BAR; PG8_MMA(1, 1, At, B1); PG8_BAR;
            }
        }
        if constexpr (ALIGN_EPI) { if (wr == 0) PG8_BAR; }
        if constexpr (!Epi::AFTER_DRAIN) { if (S.pre(acc, cur, wid, lane, E)) E(acc, cur, wr, wc, fr, fq); S.done(cur); }
        if (!has_next) break;
#pragma unroll
        for (int a = 0; a < 2; ++a)
#pragma unroll
            for (int b = 0; b < 2; ++b)
#pragma unroll
                for (int m = 0; m < 4; ++m)
#pragma unroll
                    for (int n = 0; n < 2; ++n) acc[a][b][m][n] = (f32x4){0.f, 0.f, 0.f, 0.f};
        cur = nxt; cA = nA; cB = nB; ++ui;
        if constexpr (ALIGN_EPI) { if (wr == 1) PG8_BAR; }
    }
    PG8_WAIT_V(0);
    if constexpr (!ALIGN_EPI) { if (wr == 0) PG8_BAR; }
    PG8_BAR;
    S.post(E, wid, lane);
    if constexpr (Epi::AFTER_DRAIN) { E.fused(acc, cur, wr, wc, fr, fq, lds, wid, lane); S.done(cur); }
#undef PG8_SA
#undef PG8_SB
#undef PG8_STAGE
#undef PG8_LDA
#undef PG8_LDB
#undef PG8_MMA
#undef PG8_WAIT_V
#undef PG8_WAIT_L
#undef PG8_BAR
#undef PG8_SCHED
}
}

#define EPI_ARGS const pg8::f32x4 (&acc)[2][2][4][2], const pg8::Unit& u, int wr, int wc, int fr, int fq
#define EPI_GARGS const pg8::Unit& u, int wr, int wc, int fr, int fq, int ai, int m, int bj, f32x4 v0, f32x4 v1
#define EPI_WALK _Pragma("unroll") for (int ai = 0; ai < 2; ++ai) _Pragma("unroll") for (int m = 0; m < 4; ++m) _Pragma("unroll") for (int bj = 0; bj < 2; ++bj) group(u, wr, wc, fr, fq, ai, m, bj, acc[ai][bj][m][0], acc[ai][bj][m][1]);
__device__ __forceinline__ void st8bf(bf16* p, f32x4 a, f32x4 b) {
    v4u w; w.x = cvtpk(a[0], a[1]); w.y = cvtpk(a[2], a[3]); w.z = cvtpk(b[0], b[1]); w.w = cvtpk(b[2], b[3]); *(v4u*)p = w;
}
__device__ __forceinline__ void st8f(float* p, f32x4 a, f32x4 b) { *(f32x4*)p = a; *(f32x4*)(p + 4) = b; }

struct EpiHgrnIn {
    static constexpr bool PERM = true, AFTER_DRAIN = false, PAIR = false;
    unsigned char* ws;
    __device__ __forceinline__ void group(EPI_GARGS) const {
        bf16* Q = (bf16*)(ws + WS_QH); bf16* V = (bf16*)(ws + WS_VH); bf16* SG = (bf16*)(ws + WS_SG); float* G = (float*)(ws + WS_G);
        const float* rinv = (const float*)(ws + WS_SMALL) + SM_RINV0; const float* lb = (const float*)(ws + WS_SMALL) + SM_LB;
        const int sec = u.pn >> 3, lc = (u.pn & 7) * 256 + bj * 128 + wc * 32 + 8 * fq;
        const int row = u.pm * 256 + ai * 128 + wr * 64 + m * 16 + fr; const float r = rinv[row];
        const size_t off = (size_t)row * DM + lc;
        f32x4 a = v0 * r, b = v1 * r;
        if (sec == 0) st8bf(Q + off, a, b);
        else if (sec == 2) st8bf(V + off, a, b);
        else if (sec == 3) {
#pragma unroll
            for (int i = 0; i < 4; ++i) { a[i] = a[i] * sigmoidf_(a[i]); b[i] = b[i] * sigmoidf_(b[i]); }
            st8bf(SG + off, a, b);
        } else {
            const f32x4 l0 = *(const f32x4*)(lb + lc), l1 = *(const f32x4*)(lb + lc + 4);
            f32x4 ga, gb;
#pragma unroll
            for (int i = 0; i < 4; ++i) {
                const float f0 = l0[i] + (1.f - l0[i]) * sigmoidf_(a[i]), f1 = l1[i] + (1.f - l1[i]) * sigmoidf_(b[i]);
                ga[i] = __logf(f0); gb[i] = __logf(f1);
            }
            st8f(G + off, ga, gb);
        }
    }
    __device__ __forceinline__ void operator()(EPI_ARGS) const { EPI_WALK }
};

template <bool NEXT> struct EpiResid {
    static constexpr bool PERM = true, AFTER_DRAIN = false, PAIR = false;
    const float* xin_p; const float* xin_s;
    float* Xout; bf16* XB; float* ss;
    __device__ __forceinline__ void group(EPI_GARGS) const {
        const float* xin = (u.pm < 32) ? xin_p : xin_s;
        const int row = u.pm * 256 + ai * 128 + wr * 64 + m * 16 + fr;
        const size_t off = (size_t)row * DM + u.pn * 256 + bj * 128 + wc * 32 + 8 * fq;
        const f32x4 a = v0 + *(const f32x4*)(xin + off), b = v1 + *(const f32x4*)(xin + off + 4);
        st8f(Xout + off, a, b);
        if (NEXT) { st8bf(XB + off, a, b);
            float s = (a[0] * a[0] + a[1] * a[1]) + (a[2] * a[2] + a[3] * a[3]) + (b[0] * b[0] + b[1] * b[1]) + (b[2] * b[2] + b[3] * b[3]);
            s += __shfl_xor(s, 16); s += __shfl_xor(s, 32); if (fq == 0) atomicAdd(ss + row, s); }
    }
    __device__ __forceinline__ void operator()(EPI_ARGS) const { EPI_WALK }
};

__device__ __forceinline__ float dpp_shr1(float v) { return __int_as_float(__builtin_amdgcn_update_dpp(0, __float_as_int(v), 0x111, 0xf, 0xf, true)); }
__device__ __forceinline__ float dpp_shr2(float v) { return __int_as_float(__builtin_amdgcn_update_dpp(0, __float_as_int(v), 0x112, 0xf, 0xf, true)); }
struct EpiUp {
    static constexpr bool PERM = true, AFTER_DRAIN = false, PAIR = true;
    unsigned char* ws; const float* ss; float* conv_p; float* conv_s; const float* cw; const float* cb;
    __device__ __forceinline__ void group(EPI_GARGS) const {}
    __device__ __forceinline__ void group2(const pg8::Unit& u, int wr, int wc, int fr, int fq, int ai, int m, f32x4 ga, f32x4 gb, f32x4 ua, f32x4 ub) const {
        bf16* ACT = (bf16*)(ws + WS_ACT); bf16* SGF = (bf16*)(ws + WS_GU); bf16* SGL = SGF + (size_t)(MR / 16) * 4 * DFF;
        int row = u.pm * 256 + ai * 128 + wr * 64 + m * 16 + fr; asm volatile("" : "+v"(row)); const float r = __builtin_amdgcn_rsqf(ss[row] * (1.f / DM) + EPS);
        const int col = u.pn * 128 + wc * 32 + 8 * fq;
        ga = ga * r; gb = gb * r; ua = ua * r; ub = ub * r;
        if (m == 3 && fr >= 14) {
            if (row >= MP) { const int sb = (row - MP) >> 6; st8f(conv_s + ((size_t)sb * 2 + (fr - 14)) * DFF + col, ga, gb); }
            else if (row >= MP - 2) st8f(conv_p + (size_t)(row - (MP - 2)) * DFF + col, ga, gb);
        }
        const int grp = row >> 4;
#define UP_HALF(g_, u_, cofs) do { f32x4 p1_, p2_; _Pragma("unroll") for (int i = 0; i < 4; ++i) { p1_[i] = dpp_shr1(g_[i]); p2_[i] = dpp_shr2(g_[i]); } \
        if (fr >= 2) { const float* wp_ = cw + col + (cofs); asm volatile("" : "+v"(wp_)); \
            f32x4 x_ = *(const f32x4*)(cb + col + (cofs)) + *(const f32x4*)(wp_ + 2 * DFF) * g_ + *(const f32x4*)(wp_ + DFF) * p1_ + *(const f32x4*)(wp_) * p2_; \
            _Pragma("unroll") for (int i = 0; i < 4; ++i) x_[i] = x_[i] * sigmoidf_(x_[i]) * u_[i]; g_##x = x_; } } while (0)
        f32x4 gax = ga, gbx = gb;
        UP_HALF(ga, ua, 0); UP_HALF(gb, ub, 4);
        if (fr >= 2) {
            st8bf(ACT + (size_t)row * DFF + col, gax, gbx);
            if (fr >= 14) st8bf(SGL + ((size_t)grp * 2 + (fr - 14)) * DFF + col, ga, gb);
        } else {
            st8bf(SGF + (((size_t)grp * 2 + fr) * 2 + 0) * DFF + col, ga, gb); st8bf(SGF + (((size_t)grp * 2 + fr) * 2 + 1) * DFF + col, ua, ub);
        }
#undef UP_HALF
    }
    __device__ __forceinline__ void operator()(EPI_ARGS) const {
#pragma unroll
        for (int ai = 0; ai < 2; ++ai)
#pragma unroll
            for (int m = 0; m < 4; ++m) group2(u, wr, wc, fr, fq, ai, m, acc[ai][0][m][0], acc[ai][0][m][1], acc[ai][1][m][0], acc[ai][1][m][1]);
    }
};

struct EpiDiffIn {
    static constexpr bool PERM = true, AFTER_DRAIN = false, PAIR = false;
    unsigned char* ws; float* out; const float* gq; const float* gk; LAS float* P;
    __device__ __forceinline__ void group(EPI_GARGS) const {
        bf16* VB = (bf16*)(ws + WS_VH); const float* ss = (const float*)(ws + WS_CTL) + CW_SS2;
        float* vout = (u.pm < 32) ? out + O_VP : out + O_VS - (size_t)MP * DM;
        int row = u.pm * 256 + ai * 128 + wr * 64 + m * 16 + fr; asm volatile("" : "+v"(row));
        const size_t off = (size_t)row * DM + (u.pn * 256 + wc * 32 + 8 * fq + bj * 128 - 4096);
        const float r_ = __builtin_amdgcn_rsqf(ss[row] * (1.f / DM) + EPS); const f32x4 a = v0 * r_, b = v1 * r_; st8bf(VB + off, a, b); st8f(vout + off, a, b);
    }
    __device__ __forceinline__ void operator()(const pg8::f32x4 (&acc)[2][2][4][2], const pg8::Unit& u, int wr, int wc, int fr_, int fq_) const {
        int t_ = lane_id(); asm volatile("" : "+v"(t_)); const int fr = t_ & 15, fq = (t_ >> 4) & 3; (void)fr_; (void)fq_;
        bf16* QN = (bf16*)(ws + WS_QH); bf16* KN = (bf16*)(ws + WS_KH); bf16* VB = (bf16*)(ws + WS_VH); const float* ss = (const float*)(ws + WS_CTL) + CW_SS2;
        float* vout_p = out + O_VP; float* vout_s = out + O_VS - (size_t)MP * DM; float* kout_p = out + O_KP; float* kout_s = out + O_KS - (size_t)MP * DM;
        const int c0 = u.pn * 256 + wc * 32 + 8 * fq;
#define RS_(ai, m) __builtin_amdgcn_rsqf(ss[u.pm * 256 + (ai) * 128 + wr * 64 + (m) * 16 + fr] * (1.f / DM) + EPS)
        if (u.pn >= 16) {
            float* vout = (u.pm < 32) ? vout_p : vout_s;
#pragma unroll
            for (int ai = 0; ai < 2; ++ai)
#pragma unroll
                for (int m = 0; m < 4; ++m)
#pragma unroll
                    for (int bj = 0; bj < 2; ++bj) { int row = u.pm * 256 + ai * 128 + wr * 64 + m * 16 + fr; asm volatile("" : "+v"(row)); const size_t off = (size_t)row * DM + (c0 + bj * 128 - 4096);
                        const float r_ = __builtin_amdgcn_rsqf(ss[row] * (1.f / DM) + EPS); const f32x4 a = acc[ai][bj][m][0] * r_, b = acc[ai][bj][m][1] * r_; st8bf(VB + off, a, b); st8f(vout + off, a, b); }
            return;
        }
#pragma unroll
        for (int ai = 0; ai < 2; ++ai)
#pragma unroll
            for (int m = 0; m < 4; ++m)
#pragma unroll
                for (int bj = 0; bj < 2; ++bj) { int rl = ai * 128 + wr * 64 + m * 16 + fr; asm volatile("" : "+v"(rl));
                    const float r_ = __builtin_amdgcn_rsqf(ss[u.pm * 256 + rl] * (1.f / DM) + EPS); const f32x4 a = acc[ai][bj][m][0], b = acc[ai][bj][m][1];
                    float q = ((a[0] * a[0] + a[1] * a[1]) + (a[2] * a[2] + a[3] * a[3]) + (b[0] * b[0] + b[1] * b[1]) + (b[2] * b[2] + b[3] * b[3])) * (r_ * r_);
                    q += __shfl_xor(q, 16); q += __shfl_xor(q, 32);
                    if (fq == 0) P[(rl * 2 + bj) * 4 + wc] = q; }
        asm volatile("s_waitcnt lgkmcnt(0)" ::: "memory"); __builtin_amdgcn_s_barrier(); asm volatile("" ::: "memory");
        const bool isk = u.pn >= 8; const float* gn = isk ? gk : gq; bf16* dst = isk ? KN : QN;
        float* kout = (u.pm < 32) ? kout_p : kout_s;
#pragma unroll
        for (int ai = 0; ai < 2; ++ai)
#pragma unroll
            for (int m = 0; m < 4; ++m)
#pragma unroll
                for (int bj = 0; bj < 2; ++bj) { int rl = ai * 128 + wr * 64 + m * 16 + fr; asm volatile("" : "+v"(rl)); const f32x4 pq = *(const LAS f32x4*)(P + (rl * 2 + bj) * 4);
                    const float rn = __builtin_amdgcn_rsqf(((pq[0] + pq[1]) + (pq[2] + pq[3])) * (1.f / 128.f) + EPS) * __builtin_amdgcn_rsqf(ss[u.pm * 256 + rl] * (1.f / DM) + EPS);
                    const float* gp = gn + wc * 32 + 8 * fq; asm volatile("" : "+v"(gp));
                    const f32x4 g0 = *(const f32x4*)gp, g1 = *(const f32x4*)(gp + 4);
                    const f32x4 a = acc[ai][bj][m][0] * rn * g0, b = acc[ai][bj][m][1] * rn * g1;
                    const size_t off = (size_t)(u.pm * 256 + rl) * DM + ((c0 + bj * 128) & 2047);
                    st8bf(dst + off, a, b); if (isk) st8f(kout + off, a, b); }
        asm volatile("s_waitcnt lgkmcnt(0)" ::: "memory"); __builtin_amdgcn_s_barrier(); asm volatile("" ::: "memory");
#undef RS_
    }
};
#define XB_TMO      128
#define XB_XCNT(j)  (256  + 64 * (j))
#define XB_XSUB(j)  (1280 + 64 * (j))
#define XB_XGEN(j)  (2304 + 64 * (j))
#define XB_TOP      3328
#define XB_TOPGEN   3392
#define XCD_BAR_WORDS 3456
#define XB_SPIN_CAP (1u << 18)

__device__ __forceinline__ unsigned xb_ld(unsigned* p)              { return __hip_atomic_load(p, __ATOMIC_RELAXED, __HIP_MEMORY_SCOPE_AGENT); }
__device__ __forceinline__ unsigned xb_add(unsigned* p, unsigned v) { return __hip_atomic_fetch_add(p, v, __ATOMIC_RELAXED, __HIP_MEMORY_SCOPE_AGENT); }
__device__ __forceinline__ unsigned xb_xcc_id() { return (unsigned)__builtin_amdgcn_s_getreg((3 << 11) | 20) & 0xFu; }
#define XB_SPIN(cond, bar) do { unsigned _sp = 0; while (cond) { __builtin_amdgcn_s_sleep(1); \
    if ((++_sp & 255u) == 0u) { if (xb_ld(&(bar)[XB_TMO])) break; if (_sp > XB_SPIN_CAP) { atomicAdd(&(bar)[XB_TMO], 1u); break; } } } } while (0)

#define XB_T0(b) ((b).wv == 0 && lane_id() == 0)
struct XcdBarrier {
    int wv;
    unsigned* bar; unsigned x;
    volatile LAS unsigned* st;
};

__device__ __forceinline__ XcdBarrier xcd_barrier_post(unsigned* bar, volatile LAS unsigned* st, int wv) {
    XcdBarrier b; b.wv = wv; b.bar = bar; b.x = xb_xcc_id(); b.st = st;
    if (XB_T0(b)) (void)xb_add(&bar[XB_XCNT(b.x)], 1u);
    return b;
}
__device__ __forceinline__ void xcd_barrier_complete(unsigned* bar, unsigned x, unsigned& nloc, unsigned& nx) {
    const unsigned G = gridDim.x * gridDim.y * gridDim.z;
    unsigned sum, cnt, mine, sp = 0u;
    for (;;) {
        sum = 0u; cnt = 0u; mine = 0u;
#pragma unroll
        for (unsigned j = 0; j < 16; ++j) { const unsigned c = xb_ld(&bar[XB_XCNT(j)]); sum += c; cnt += (c > 0u) ? 1u : 0u; mine = (j == x) ? c : mine; }
        if (sum == G) break;
        __builtin_amdgcn_s_sleep(1);
        if ((++sp & 255u) == 0u) { if (xb_ld(&bar[XB_TMO])) break; if (sp > XB_SPIN_CAP) { atomicAdd(&bar[XB_TMO], 1u); break; } }
    }
    nloc = mine > 0u ? mine : 1u; nx = cnt > 0u ? cnt : 1u;
}

__device__ __forceinline__ void xcd_barrier(const XcdBarrier& b) {
    asm volatile("s_waitcnt vmcnt(0)" ::: "memory");
    __syncthreads();
    if (XB_T0(b)) {
        unsigned* bar = b.bar;
        __builtin_amdgcn_s_waitcnt(0);
        unsigned nloc = b.st[0], nx = b.st[1];
        if (nloc == 0u) { xcd_barrier_complete(bar, b.x, nloc, nx); b.st[0] = nloc; b.st[1] = nx; }
        const unsigned old = xb_add(&bar[XB_XSUB(b.x)], 1u);
        const unsigned gen = old / nloc;
        if (old + 1u == (gen + 1u) * nloc) {
            __builtin_amdgcn_fence(__ATOMIC_RELEASE, "agent");
            asm volatile("s_waitcnt vmcnt(0)" ::: "memory");
            const unsigned og = xb_add(&bar[XB_TOP], 1u);
            const unsigned tg = og / nx;
            if (og + 1u == (tg + 1u) * nx) xb_add(&bar[XB_TOPGEN], 1u);
            else XB_SPIN(xb_ld(&bar[XB_TOPGEN]) == tg, bar);
            __builtin_amdgcn_fence(__ATOMIC_ACQUIRE, "agent");
            xb_add(&bar[XB_XGEN(b.x)], 1u);
            asm volatile("s_waitcnt vmcnt(0)" ::: "memory");
        } else {
            XB_SPIN(xb_ld(&bar[XB_XGEN(b.x)]) == gen, bar);
            __builtin_amdgcn_fence(__ATOMIC_ACQUIRE, "agent");
            asm volatile("s_waitcnt vmcnt(0)" ::: "memory");
        }
    }
    __syncthreads();
}

namespace att {
using bf16 = __hip_bfloat16;
constexpr int   D = 128, NW = 8, QBLK = 32, KVBLK = 64;
constexpr float SCALE = 0.088388347648318440f;
constexpr float THR = 8.f;
constexpr int SDEPTH = 2;
constexpr int LDQ = 2048, LDK = 2048, LDO = 2048;
constexpr size_t SHM_V = KVBLK * D * 2, SHM_K = KVBLK * D * 2;
#define MASKALL(P0, P1) do { _Pragma("unroll") for (int r_ = 0; r_ < 16; ++r_) { P0[r_] = -INFINITY; P1[r_] = -INFINITY; } } while (0)
using bf16x8 = __attribute__((ext_vector_type(8))) short;
using s16x4  = __attribute__((ext_vector_type(4))) short;
using f32x16 = __attribute__((ext_vector_type(16))) float;
using f32x8  = __attribute__((ext_vector_type(8))) float;
using u32x4  = __attribute__((ext_vector_type(4))) unsigned;
#define KSWZ(row, colB) ((row) * 256 + ((colB) ^ (((row) & 7) << 4)))
#define SBAR() __builtin_amdgcn_sched_barrier(0)
__device__ __forceinline__ int crow(int r, int hi) { return (r & 3) + 8 * (r >> 2) + 4 * hi; }
__device__ __forceinline__ unsigned cvtpk(float lo, float hi) {
  unsigned r; asm volatile("v_cvt_pk_bf16_f32 %0, %1, %2" : "=v"(r) : "v"(lo), "v"(hi)); return r;
}
template <typename TIn> struct Stage;
template <> struct Stage<bf16>  { using T = bf16x8;
  __device__ static __forceinline__ T ld8(const bf16* p) { return *reinterpret_cast<const bf16x8*>(p); }
  __device__ static __forceinline__ bf16x8 tobf(T x) { return x; } };
template <> struct Stage<float> { using T = f32x8;
  __device__ static __forceinline__ T ld8(const float* p) { return *reinterpret_cast<const f32x8*>(p); }
  __device__ static __forceinline__ bf16x8 tobf(T x) {
    u32x4 w = {cvtpk(x[0], x[1]), cvtpk(x[2], x[3]), cvtpk(x[4], x[5]), cvtpk(x[6], x[7])}; return *reinterpret_cast<bf16x8*>(&w); } };

__device__ __forceinline__ void partialSM(f32x16& p0, f32x16& p1, float& m_reg, float& mn, float& alpha) {
  constexpr float C = SCALE * 1.4426950408889634f;
  float pmax = p0[0]; for (int r = 1; r < 16; ++r) pmax = fmaxf(pmax, p0[r]); for (int r = 0; r < 16; ++r) pmax = fmaxf(pmax, p1[r]);
  { auto rr = __builtin_amdgcn_permlane32_swap(__float_as_uint(pmax), __float_as_uint(pmax), false, false);
    pmax = fmaxf(__uint_as_float(rr[0]), __uint_as_float(rr[1])); }
  if (__builtin_expect(__all(pmax - m_reg <= THR / SCALE), 1)) { mn = m_reg; alpha = 1.f; }
  else { mn = fmaxf(m_reg, pmax); alpha = __builtin_amdgcn_exp2f((m_reg - mn) * C); m_reg = mn; }
  float mnC = -mn * C;
  for (int r = 0; r < 16; ++r) p0[r] = fmaf(p0[r], C, mnC); for (int r = 0; r < 16; ++r) p1[r] = fmaf(p1[r], C, mnC);
  for (int r = 0; r < 16; ++r) p0[r] = __builtin_amdgcn_exp2f(p0[r]);
}
__device__ __forceinline__ void finishSM(f32x16& p0, f32x16& p1, float alpha, float& l_reg, bf16x8& pa0, bf16x8& pa1, bf16x8& pa2, bf16x8& pa3) {
  for (int r = 0; r < 16; ++r) p1[r] = __builtin_amdgcn_exp2f(p1[r]);
  float ps = 0; for (int r = 0; r < 16; ++r) ps += p0[r]; for (int r = 0; r < 16; ++r) ps += p1[r];
  { auto rr = __builtin_amdgcn_permlane32_swap(__float_as_uint(ps), __float_as_uint(ps), false, false);
    ps = __uint_as_float(rr[0]) + __uint_as_float(rr[1]); }
  l_reg = l_reg * alpha + ps;
#define PK4(P, BASE, OUT) do { unsigned a0 = cvtpk(P[BASE + 0], P[BASE + 1]), a1 = cvtpk(P[BASE + 2], P[BASE + 3]);   \
    unsigned b0 = cvtpk(P[BASE + 4], P[BASE + 5]), b1 = cvtpk(P[BASE + 6], P[BASE + 7]);                              \
    auto r0 = __builtin_amdgcn_permlane32_swap(a0, b0, false, false); auto r1 = __builtin_amdgcn_permlane32_swap(a1, b1, false, false); \
    u32x4 w = {r0[0], r1[0], r0[1], r1[1]}; OUT = *reinterpret_cast<bf16x8*>(&w); } while (0)
  PK4(p0, 0, pa0); PK4(p0, 8, pa1); PK4(p1, 0, pa2); PK4(p1, 8, pa3);
#undef PK4
}
__device__ __forceinline__ void qkt(f32x16& p0, f32x16& p1, const bf16* Ks, const bf16x8* qr, int r32, int hi) {
  p0 = f32x16{}; p1 = f32x16{};
  for (int d0 = 0; d0 < 8; ++d0) { int cb = (d0 * 16 + hi * 8) * 2;
    bf16x8 b0 = *reinterpret_cast<const bf16x8*>((const char*)Ks + KSWZ(r32, cb));
    bf16x8 b1 = *reinterpret_cast<const bf16x8*>((const char*)Ks + KSWZ(32 + r32, cb));
    p0 = __builtin_amdgcn_mfma_f32_32x32x16_bf16(b0, qr[d0], p0, 0, 0, 0);
    p1 = __builtin_amdgcn_mfma_f32_32x32x16_bf16(b1, qr[d0], p1, 0, 0, 0); }
}
__device__ __forceinline__ int v_st(int k, int c) { const int kk = (k & ~0xC) | ((k & 4) << 1) | ((k & 8) >> 1); return ((kk >> 3) * 4 + (c >> 5)) * 512 + ((kk & 7) * 32 + (c & 31)) * 2; }
__device__ __forceinline__ int v_rd_base(int lane) { return ((lane & 3) << 3) | (((lane >> 2) & 3) << 6) | (((lane >> 4) & 1) << 5) | (((lane >> 5) & 1) << 8); }
constexpr int v_rd_off(int d0, int ks, int half) { return d0 * 512 + ks * 4096 + half * 2048; }
template <int OFF> __device__ __forceinline__ s16x4 tr_read(int vb) {
  s16x4 r; asm volatile("ds_read_b64_tr_b16 %0, %1 offset:%2" : "=&v"(r) : "v"(vb), "i"(OFF) : "memory"); return r;
}
template <int D0> __device__ __forceinline__ void pv_one(f32x16& od, int vb, bf16x8 pa0, bf16x8 pa1, bf16x8 pa2, bf16x8 pa3) {
  const s16x4 l0 = tr_read<v_rd_off(D0, 0, 0)>(vb), h0 = tr_read<v_rd_off(D0, 0, 1)>(vb), l1 = tr_read<v_rd_off(D0, 1, 0)>(vb), h1 = tr_read<v_rd_off(D0, 1, 1)>(vb);
  const s16x4 l2 = tr_read<v_rd_off(D0, 2, 0)>(vb), h2 = tr_read<v_rd_off(D0, 2, 1)>(vb), l3 = tr_read<v_rd_off(D0, 3, 0)>(vb), h3 = tr_read<v_rd_off(D0, 3, 1)>(vb);
  asm volatile("s_waitcnt lgkmcnt(0)" ::: "memory"); SBAR();
#define PK(L, H) (bf16x8){L[0], L[1], L[2], L[3], H[0], H[1], H[2], H[3]}
  od = __builtin_amdgcn_mfma_f32_32x32x16_bf16(pa0, PK(l0, h0), od, 0, 0, 0);
  od = __builtin_amdgcn_mfma_f32_32x32x16_bf16(pa1, PK(l1, h1), od, 0, 0, 0);
  od = __builtin_amdgcn_mfma_f32_32x32x16_bf16(pa2, PK(l2, h2), od, 0, 0, 0);
  od = __builtin_amdgcn_mfma_f32_32x32x16_bf16(pa3, PK(l3, h3), od, 0, 0, 0);
#undef PK
}
__device__ __forceinline__ void pv_d0(f32x16* o, int vb, bf16x8 pa0, bf16x8 pa1, bf16x8 pa2, bf16x8 pa3) {
  pv_one<0>(o[0], vb, pa0, pa1, pa2, pa3); pv_one<1>(o[1], vb, pa0, pa1, pa2, pa3); pv_one<2>(o[2], vb, pa0, pa1, pa2, pa3); pv_one<3>(o[3], vb, pa0, pa1, pa2, pa3);
}


template <int U> __device__ __forceinline__ void pvp_issue(int vb, s16x4& lo, s16x4& hi) {
  constexpr int b = U >> 2, s = U & 3; lo = tr_read<v_rd_off(b & 3, s, 0) + (b >> 2) * 16384>(vb); hi = tr_read<v_rd_off(b & 3, s, 1) + (b >> 2) * 16384>(vb); }
#define PVP_PK(L, H) (bf16x8){L[0], L[1], L[2], L[3], H[0], H[1], H[2], H[3]}
__device__ __forceinline__ void pv_pipe(f32x16* o, int vb, bf16x8 pa0, bf16x8 pa1, bf16x8 pa2, bf16x8 pa3) {
  s16x4 L0, H0, L1, H1, L2, H2, L3, H3, L4, H4, L5, H5;
  asm volatile("s_waitcnt lgkmcnt(0)" ::: "memory"); SBAR();
  pvp_issue<0>(vb, L0, H0); pvp_issue<1>(vb, L1, H1); pvp_issue<2>(vb, L2, H2); pvp_issue<3>(vb, L3, H3); pvp_issue<4>(vb, L4, H4);
  pvp_issue<5>(vb, L5, H5); asm volatile("s_waitcnt lgkmcnt(10)" ::: "memory"); SBAR(); o[0] = __builtin_amdgcn_mfma_f32_32x32x16_bf16(pa0, PVP_PK(L0, H0), o[0], 0, 0, 0);
  pvp_issue<6>(vb, L0, H0); asm volatile("s_waitcnt lgkmcnt(10)" ::: "memory"); SBAR(); o[0] = __builtin_amdgcn_mfma_f32_32x32x16_bf16(pa1, PVP_PK(L1, H1), o[0], 0, 0, 0);
  pvp_issue<7>(vb, L1, H1); asm volatile("s_waitcnt lgkmcnt(10)" ::: "memory"); SBAR(); o[0] = __builtin_amdgcn_mfma_f32_32x32x16_bf16(pa2, PVP_PK(L2, H2), o[0], 0, 0, 0);
  pvp_issue<8>(vb, L2, H2); asm volatile("s_waitcnt lgkmcnt(10)" ::: "memory"); SBAR(); o[0] = __builtin_amdgcn_mfma_f32_32x32x16_bf16(pa3, PVP_PK(L3, H3), o[0], 0, 0, 0);
  pvp_issue<9>(vb, L3, H3); asm volatile("s_waitcnt lgkmcnt(10)" ::: "memory"); SBAR(); o[1] = __builtin_amdgcn_mfma_f32_32x32x16_bf16(pa0, PVP_PK(L4, H4), o[1], 0, 0, 0);
  pvp_issue<10>(vb, L4, H4); asm volatile("s_waitcnt lgkmcnt(10)" ::: "memory"); SBAR(); o[1] = __builtin_amdgcn_mfma_f32_32x32x16_bf16(pa1, PVP_PK(L5, H5), o[1], 0, 0, 0);
  pvp_issue<11>(vb, L5, H5); asm volatile("s_waitcnt lgkmcnt(10)" ::: "memory"); SBAR(); o[1] = __builtin_amdgcn_mfma_f32_32x32x16_bf16(pa2, PVP_PK(L0, H0), o[1], 0, 0, 0);
  pvp_issue<12>(vb, L0, H0); asm volatile("s_waitcnt lgkmcnt(10)" ::: "memory"); SBAR(); o[1] = __builtin_amdgcn_mfma_f32_32x32x16_bf16(pa3, PVP_PK(L1, H1), o[1], 0, 0, 0);
  pvp_issue<13>(vb, L1, H1); asm volatile("s_waitcnt lgkmcnt(10)" ::: "memory"); SBAR(); o[2] = __builtin_amdgcn_mfma_f32_32x32x16_bf16(pa0, PVP_PK(L2, H2), o[2], 0, 0, 0);
  pvp_issue<14>(vb, L2, H2); asm volatile("s_waitcnt lgkmcnt(10)" ::: "memory"); SBAR(); o[2] = __builtin_amdgcn_mfma_f32_32x32x16_bf16(pa1, PVP_PK(L3, H3), o[2], 0, 0, 0);
  pvp_issue<15>(vb, L3, H3); asm volatile("s_waitcnt lgkmcnt(10)" ::: "memory"); SBAR(); o[2] = __builtin_amdgcn_mfma_f32_32x32x16_bf16(pa2, PVP_PK(L4, H4), o[2], 0, 0, 0);
  pvp_issue<16>(vb, L4, H4); asm volatile("s_waitcnt lgkmcnt(10)" ::: "memory"); SBAR(); o[2] = __builtin_amdgcn_mfma_f32_32x32x16_bf16(pa3, PVP_PK(L5, H5), o[2], 0, 0, 0);
  pvp_issue<17>(vb, L5, H5); asm volatile("s_waitcnt lgkmcnt(10)" ::: "memory"); SBAR(); o[3] = __builtin_amdgcn_mfma_f32_32x32x16_bf16(pa0, PVP_PK(L0, H0), o[3], 0, 0, 0);
  pvp_issue<18>(vb, L0, H0); asm volatile("s_waitcnt lgkmcnt(10)" ::: "memory"); SBAR(); o[3] = __builtin_amdgcn_mfma_f32_32x32x16_bf16(pa1, PVP_PK(L1, H1), o[3], 0, 0, 0);
  pvp_issue<19>(vb, L1, H1); asm volatile("s_waitcnt lgkmcnt(10)" ::: "memory"); SBAR(); o[3] = __builtin_amdgcn_mfma_f32_32x32x16_bf16(pa2, PVP_PK(L2, H2), o[3], 0, 0, 0);
  pvp_issue<20>(vb, L2, H2); asm volatile("s_waitcnt lgkmcnt(10)" ::: "memory"); SBAR(); o[3] = __builtin_amdgcn_mfma_f32_32x32x16_bf16(pa3, PVP_PK(L3, H3), o[3], 0, 0, 0);
  pvp_issue<21>(vb, L3, H3); asm volatile("s_waitcnt lgkmcnt(10)" ::: "memory"); SBAR(); o[4] = __builtin_amdgcn_mfma_f32_32x32x16_bf16(pa0, PVP_PK(L4, H4), o[4], 0, 0, 0);
  pvp_issue<22>(vb, L4, H4); asm volatile("s_waitcnt lgkmcnt(10)" ::: "memory"); SBAR(); o[4] = __builtin_amdgcn_mfma_f32_32x32x16_bf16(pa1, PVP_PK(L5, H5), o[4], 0, 0, 0);
  pvp_issue<23>(vb, L5, H5); asm volatile("s_waitcnt lgkmcnt(10)" ::: "memory"); SBAR(); o[4] = __builtin_amdgcn_mfma_f32_32x32x16_bf16(pa2, PVP_PK(L0, H0), o[4], 0, 0, 0);
  pvp_issue<24>(vb, L0, H0); asm volatile("s_waitcnt lgkmcnt(10)" ::: "memory"); SBAR(); o[4] = __builtin_amdgcn_mfma_f32_32x32x16_bf16(pa3, PVP_PK(L1, H1), o[4], 0, 0, 0);
  pvp_issue<25>(vb, L1, H1); asm volatile("s_waitcnt lgkmcnt(10)" ::: "memory"); SBAR(); o[5] = __builtin_amdgcn_mfma_f32_32x32x16_bf16(pa0, PVP_PK(L2, H2), o[5], 0, 0, 0);
  pvp_issue<26>(vb, L2, H2); asm volatile("s_waitcnt lgkmcnt(10)" ::: "memory"); SBAR(); o[5] = __builtin_amdgcn_mfma_f32_32x32x16_bf16(pa1, PVP_PK(L3, H3), o[5], 0, 0, 0);
  pvp_issue<27>(vb, L3, H3); asm volatile("s_waitcnt lgkmcnt(10)" ::: "memory"); SBAR(); o[5] = __builtin_amdgcn_mfma_f32_32x32x16_bf16(pa2, PVP_PK(L4, H4), o[5], 0, 0, 0);
  pvp_issue<28>(vb, L4, H4); asm volatile("s_waitcnt lgkmcnt(10)" ::: "memory"); SBAR(); o[5] = __builtin_amdgcn_mfma_f32_32x32x16_bf16(pa3, PVP_PK(L5, H5), o[5], 0, 0, 0);
  pvp_issue<29>(vb, L5, H5); asm volatile("s_waitcnt lgkmcnt(10)" ::: "memory"); SBAR(); o[6] = __builtin_amdgcn_mfma_f32_32x32x16_bf16(pa0, PVP_PK(L0, H0), o[6], 0, 0, 0);
  pvp_issue<30>(vb, L0, H0); asm volatile("s_waitcnt lgkmcnt(10)" ::: "memory"); SBAR(); o[6] = __builtin_amdgcn_mfma_f32_32x32x16_bf16(pa1, PVP_PK(L1, H1), o[6], 0, 0, 0);
  pvp_issue<31>(vb, L1, H1); asm volatile("s_waitcnt lgkmcnt(10)" ::: "memory"); SBAR(); o[6] = __builtin_amdgcn_mfma_f32_32x32x16_bf16(pa2, PVP_PK(L2, H2), o[6], 0, 0, 0);
  asm volatile("s_waitcnt lgkmcnt(8)" ::: "memory"); SBAR(); o[6] = __builtin_amdgcn_mfma_f32_32x32x16_bf16(pa3, PVP_PK(L3, H3), o[6], 0, 0, 0);
  asm volatile("s_waitcnt lgkmcnt(6)" ::: "memory"); SBAR(); o[7] = __builtin_amdgcn_mfma_f32_32x32x16_bf16(pa0, PVP_PK(L4, H4), o[7], 0, 0, 0);
  asm volatile("s_waitcnt lgkmcnt(4)" ::: "memory"); SBAR(); o[7] = __builtin_amdgcn_mfma_f32_32x32x16_bf16(pa1, PVP_PK(L5, H5), o[7], 0, 0, 0);
  asm volatile("s_waitcnt lgkmcnt(2)" ::: "memory"); SBAR(); o[7] = __builtin_amdgcn_mfma_f32_32x32x16_bf16(pa2, PVP_PK(L0, H0), o[7], 0, 0, 0);
  asm volatile("s_waitcnt lgkmcnt(0)" ::: "memory"); SBAR(); o[7] = __builtin_amdgcn_mfma_f32_32x32x16_bf16(pa3, PVP_PK(L1, H1), o[7], 0, 0, 0);
}

__device__ __forceinline__ void pv_pipe4(f32x16* o, int vb, bf16x8 pa0, bf16x8 pa1, bf16x8 pa2, bf16x8 pa3) {
  s16x4 L0, H0, L1, H1, L2, H2, L3, H3;
  asm volatile("s_waitcnt lgkmcnt(0)" ::: "memory"); SBAR();
  pvp_issue<0>(vb, L0, H0); pvp_issue<1>(vb, L1, H1); pvp_issue<2>(vb, L2, H2);
  pvp_issue<3>(vb, L3, H3); asm volatile("s_waitcnt lgkmcnt(6)" ::: "memory"); SBAR(); o[0] = __builtin_amdgcn_mfma_f32_32x32x16_bf16(pa0, PVP_PK(L0, H0), o[0], 0, 0, 0);
  pvp_issue<4>(vb, L0, H0); asm volatile("s_waitcnt lgkmcnt(6)" ::: "memory"); SBAR(); o[0] = __builtin_amdgcn_mfma_f32_32x32x16_bf16(pa1, PVP_PK(L1, H1), o[0], 0, 0, 0);
  pvp_issue<5>(vb, L1, H1); asm volatile("s_waitcnt lgkmcnt(6)" ::: "memory"); SBAR(); o[0] = __builtin_amdgcn_mfma_f32_32x32x16_bf16(pa2, PVP_PK(L2, H2), o[0], 0, 0, 0);
  pvp_issue<6>(vb, L2, H2); asm volatile("s_waitcnt lgkmcnt(6)" ::: "memory"); SBAR(); o[0] = __builtin_amdgcn_mfma_f32_32x32x16_bf16(pa3, PVP_PK(L3, H3), o[0], 0, 0, 0);
  pvp_issue<7>(vb, L3, H3); asm volatile("s_waitcnt lgkmcnt(6)" ::: "memory"); SBAR(); o[1] = __builtin_amdgcn_mfma_f32_32x32x16_bf16(pa0, PVP_PK(L0, H0), o[1], 0, 0, 0);
  pvp_issue<8>(vb, L0, H0); asm volatile("s_waitcnt lgkmcnt(6)" ::: "memory"); SBAR(); o[1] = __builtin_amdgcn_mfma_f32_32x32x16_bf16(pa1, PVP_PK(L1, H1), o[1], 0, 0, 0);
  pvp_issue<9>(vb, L1, H1); asm volatile("s_waitcnt lgkmcnt(6)" ::: "memory"); SBAR(); o[1] = __builtin_amdgcn_mfma_f32_32x32x16_bf16(pa2, PVP_PK(L2, H2), o[1], 0, 0, 0);
  pvp_issue<10>(vb, L2, H2); asm volatile("s_waitcnt lgkmcnt(6)" ::: "memory"); SBAR(); o[1] = __builtin_amdgcn_mfma_f32_32x32x16_bf16(pa3, PVP_PK(L3, H3), o[1], 0, 0, 0);
  pvp_issue<11>(vb, L3, H3); asm volatile("s_waitcnt lgkmcnt(6)" ::: "memory"); SBAR(); o[2] = __builtin_amdgcn_mfma_f32_32x32x16_bf16(pa0, PVP_PK(L0, H0), o[2], 0, 0, 0);
  pvp_issue<12>(vb, L0, H0); asm volatile("s_waitcnt lgkmcnt(6)" ::: "memory"); SBAR(); o[2] = __builtin_amdgcn_mfma_f32_32x32x16_bf16(pa1, PVP_PK(L1, H1), o[2], 0, 0, 0);
  pvp_issue<13>(vb, L1, H1); asm volatile("s_waitcnt lgkmcnt(6)" ::: "memory"); SBAR(); o[2] = __builtin_amdgcn_mfma_f32_32x32x16_bf16(pa2, PVP_PK(L2, H2), o[2], 0, 0, 0);
  pvp_issue<14>(vb, L2, H2); asm volatile("s_waitcnt lgkmcnt(6)" ::: "memory"); SBAR(); o[2] = __builtin_amdgcn_mfma_f32_32x32x16_bf16(pa3, PVP_PK(L3, H3), o[2], 0, 0, 0);
  pvp_issue<15>(vb, L3, H3); asm volatile("s_waitcnt lgkmcnt(6)" ::: "memory"); SBAR(); o[3] = __builtin_amdgcn_mfma_f32_32x32x16_bf16(pa0, PVP_PK(L0, H0), o[3], 0, 0, 0);
  asm volatile("s_waitcnt lgkmcnt(4)" ::: "memory"); SBAR(); o[3] = __builtin_amdgcn_mfma_f32_32x32x16_bf16(pa1, PVP_PK(L1, H1), o[3], 0, 0, 0);
  asm volatile("s_waitcnt lgkmcnt(2)" ::: "memory"); SBAR(); o[3] = __builtin_amdgcn_mfma_f32_32x32x16_bf16(pa2, PVP_PK(L2, H2), o[3], 0, 0, 0);
  asm volatile("s_waitcnt lgkmcnt(0)" ::: "memory"); SBAR(); o[3] = __builtin_amdgcn_mfma_f32_32x32x16_bf16(pa3, PVP_PK(L3, H3), o[3], 0, 0, 0);
}

template <int OFF> __device__ __forceinline__ bf16x8 k_read(int a) { bf16x8 r; asm volatile("ds_read_b128 %0, %1 offset:%2" : "=&v"(r) : "v"(a), "i"(OFF) : "memory"); return r; }
__device__ __forceinline__ void qk_pipe(f32x16& p0, f32x16& p1, const int kb  , const bf16x8* qr, const int r32, const int hi) {
  const int rb = kb + r32 * 256, c0 = (hi << 4) ^ ((r32 & 7) << 4);
  bf16x8 K0, K1, K2, K3;
  p0 = f32x16{}; p1 = f32x16{};
  asm volatile("s_waitcnt lgkmcnt(0)" ::: "memory"); SBAR();
  K0 = k_read<0>(rb + ((0 << 5) ^ c0)); K1 = k_read<8192>(rb + ((0 << 5) ^ c0)); K2 = k_read<0>(rb + ((1 << 5) ^ c0));
  K3 = k_read<8192>(rb + ((1 << 5) ^ c0)); asm volatile("s_waitcnt lgkmcnt(3)" ::: "memory"); SBAR(); p0 = __builtin_amdgcn_mfma_f32_32x32x16_bf16(K0, qr[0], p0, 0, 0, 0);
  K0 = k_read<0>(rb + ((2 << 5) ^ c0)); asm volatile("s_waitcnt lgkmcnt(3)" ::: "memory"); SBAR(); p1 = __builtin_amdgcn_mfma_f32_32x32x16_bf16(K1, qr[0], p1, 0, 0, 0);
  K1 = k_read<8192>(rb + ((2 << 5) ^ c0)); asm volatile("s_waitcnt lgkmcnt(3)" ::: "memory"); SBAR(); p0 = __builtin_amdgcn_mfma_f32_32x32x16_bf16(K2, qr[1], p0, 0, 0, 0);
  K2 = k_read<0>(rb + ((3 << 5) ^ c0)); asm volatile("s_waitcnt lgkmcnt(3)" ::: "memory"); SBAR(); p1 = __builtin_amdgcn_mfma_f32_32x32x16_bf16(K3, qr[1], p1, 0, 0, 0);
  K3 = k_read<8192>(rb + ((3 << 5) ^ c0)); asm volatile("s_waitcnt lgkmcnt(3)" ::: "memory"); SBAR(); p0 = __builtin_amdgcn_mfma_f32_32x32x16_bf16(K0, qr[2], p0, 0, 0, 0);
  K0 = k_read<0>(rb + ((4 << 5) ^ c0)); asm volatile("s_waitcnt lgkmcnt(3)" ::: "memory"); SBAR(); p1 = __builtin_amdgcn_mfma_f32_32x32x16_bf16(K1, qr[2], p1, 0, 0, 0);
  K1 = k_read<8192>(rb + ((4 << 5) ^ c0)); asm volatile("s_waitcnt lgkmcnt(3)" ::: "memory"); SBAR(); p0 = __builtin_amdgcn_mfma_f32_32x32x16_bf16(K2, qr[3], p0, 0, 0, 0);
  K2 = k_read<0>(rb + ((5 << 5) ^ c0)); asm volatile("s_waitcnt lgkmcnt(3)" ::: "memory"); SBAR(); p1 = __builtin_amdgcn_mfma_f32_32x32x16_bf16(K3, qr[3], p1, 0, 0, 0);
  K3 = k_read<8192>(rb + ((5 << 5) ^ c0)); asm volatile("s_waitcnt lgkmcnt(3)" ::: "memory"); SBAR(); p0 = __builtin_amdgcn_mfma_f32_32x32x16_bf16(K0, qr[4], p0, 0, 0, 0);
  K0 = k_read<0>(rb + ((6 << 5) ^ c0)); asm volatile("s_waitcnt lgkmcnt(3)" ::: "memory"); SBAR(); p1 = __builtin_amdgcn_mfma_f32_32x32x16_bf16(K1, qr[4], p1, 0, 0, 0);
  K1 = k_read<8192>(rb + ((6 << 5) ^ c0)); asm volatile("s_waitcnt lgkmcnt(3)" ::: "memory"); SBAR(); p0 = __builtin_amdgcn_mfma_f32_32x32x16_bf16(K2, qr[5], p0, 0, 0, 0);
  K2 = k_read<0>(rb + ((7 << 5) ^ c0)); asm volatile("s_waitcnt lgkmcnt(3)" ::: "memory"); SBAR(); p1 = __builtin_amdgcn_mfma_f32_32x32x16_bf16(K3, qr[5], p1, 0, 0, 0);
  K3 = k_read<8192>(rb + ((7 << 5) ^ c0)); asm volatile("s_waitcnt lgkmcnt(3)" ::: "memory"); SBAR(); p0 = __builtin_amdgcn_mfma_f32_32x32x16_bf16(K0, qr[6], p0, 0, 0, 0);
  asm volatile("s_waitcnt lgkmcnt(2)" ::: "memory"); SBAR(); p1 = __builtin_amdgcn_mfma_f32_32x32x16_bf16(K1, qr[6], p1, 0, 0, 0);
  asm volatile("s_waitcnt lgkmcnt(1)" ::: "memory"); SBAR(); p0 = __builtin_amdgcn_mfma_f32_32x32x16_bf16(K2, qr[7], p0, 0, 0, 0);
  asm volatile("s_waitcnt lgkmcnt(0)" ::: "memory"); SBAR(); p1 = __builtin_amdgcn_mfma_f32_32x32x16_bf16(K3, qr[7], p1, 0, 0, 0);
}
__device__ __forceinline__ void qk_pipe_lq(f32x16& p0, f32x16& p1, const int kb, const int qa  , const int r32, const int hi) {
  const int rb = kb + r32 * 256, c0 = (hi << 4) ^ ((r32 & 7) << 4);
  bf16x8 QA, KA0, KA1, QB, KB0, KB1;
  p0 = f32x16{}; p1 = f32x16{};
  asm volatile("s_waitcnt lgkmcnt(0)" ::: "memory"); SBAR();
  QA = k_read<0>(qa); KA0 = k_read<0>(rb + ((0 << 5) ^ c0)); KA1 = k_read<8192>(rb + ((0 << 5) ^ c0)); QB = k_read<1024>(qa); KB0 = k_read<0>(rb + ((1 << 5) ^ c0)); KB1 = k_read<8192>(rb + ((1 << 5) ^ c0));
  asm volatile("s_waitcnt lgkmcnt(3)" ::: "memory"); SBAR(); p0 = __builtin_amdgcn_mfma_f32_32x32x16_bf16(KA0, QA, p0, 0, 0, 0); p1 = __builtin_amdgcn_mfma_f32_32x32x16_bf16(KA1, QA, p1, 0, 0, 0); SBAR(); QA = k_read<2048>(qa); KA0 = k_read<0>(rb + ((2 << 5) ^ c0)); KA1 = k_read<8192>(rb + ((2 << 5) ^ c0));
  asm volatile("s_waitcnt lgkmcnt(3)" ::: "memory"); SBAR(); p0 = __builtin_amdgcn_mfma_f32_32x32x16_bf16(KB0, QB, p0, 0, 0, 0); p1 = __builtin_amdgcn_mfma_f32_32x32x16_bf16(KB1, QB, p1, 0, 0, 0); SBAR(); QB = k_read<3072>(qa); KB0 = k_read<0>(rb + ((3 << 5) ^ c0)); KB1 = k_read<8192>(rb + ((3 << 5) ^ c0));
  asm volatile("s_waitcnt lgkmcnt(3)" ::: "memory"); SBAR(); p0 = __builtin_amdgcn_mfma_f32_32x32x16_bf16(KA0, QA, p0, 0, 0, 0); p1 = __builtin_amdgcn_mfma_f32_32x32x16_bf16(KA1, QA, p1, 0, 0, 0); SBAR(); QA = k_read<4096>(qa); KA0 = k_read<0>(rb + ((4 << 5) ^ c0)); KA1 = k_read<8192>(rb + ((4 << 5) ^ c0));
  asm volatile("s_waitcnt lgkmcnt(3)" ::: "memory"); SBAR(); p0 = __builtin_amdgcn_mfma_f32_32x32x16_bf16(KB0, QB, p0, 0, 0, 0); p1 = __builtin_amdgcn_mfma_f32_32x32x16_bf16(KB1, QB, p1, 0, 0, 0); SBAR(); QB = k_read<5120>(qa); KB0 = k_read<0>(rb + ((5 << 5) ^ c0)); KB1 = k_read<8192>(rb + ((5 << 5) ^ c0));
  asm volatile("s_waitcnt lgkmcnt(3)" ::: "memory"); SBAR(); p0 = __builtin_amdgcn_mfma_f32_32x32x16_bf16(KA0, QA, p0, 0, 0, 0); p1 = __builtin_amdgcn_mfma_f32_32x32x16_bf16(KA1, QA, p1, 0, 0, 0); SBAR(); QA = k_read<6144>(qa); KA0 = k_read<0>(rb + ((6 << 5) ^ c0)); KA1 = k_read<8192>(rb + ((6 << 5) ^ c0));
  asm volatile("s_waitcnt lgkmcnt(3)" ::: "memory"); SBAR(); p0 = __builtin_amdgcn_mfma_f32_32x32x16_bf16(KB0, QB, p0, 0, 0, 0); p1 = __builtin_amdgcn_mfma_f32_32x32x16_bf16(KB1, QB, p1, 0, 0, 0); SBAR(); QB = k_read<7168>(qa); KB0 = k_read<0>(rb + ((7 << 5) ^ c0)); KB1 = k_read<8192>(rb + ((7 << 5) ^ c0));
  asm volatile("s_waitcnt lgkmcnt(3)" ::: "memory"); SBAR(); p0 = __builtin_amdgcn_mfma_f32_32x32x16_bf16(KA0, QA, p0, 0, 0, 0); p1 = __builtin_amdgcn_mfma_f32_32x32x16_bf16(KA1, QA, p1, 0, 0, 0);
  asm volatile("s_waitcnt lgkmcnt(0)" ::: "memory"); SBAR(); p0 = __builtin_amdgcn_mfma_f32_32x32x16_bf16(KB0, QB, p0, 0, 0, 0); p1 = __builtin_amdgcn_mfma_f32_32x32x16_bf16(KB1, QB, p1, 0, 0, 0);
}

constexpr size_t SBUF = 65536;
template <int SV = 0>
__device__ __forceinline__ void attn_sample_unit(const bf16* __restrict__ QN, const bf16* __restrict__ KN, const bf16* __restrict__ VBn,
                                                 const float* __restrict__ ck, const float* __restrict__ cv, float* __restrict__ OA0, float* __restrict__ OA1,
                                                 const int b, const int h, char* lds, const int wv) {
  int tid_ = wv * 64 + lane_id(); asm volatile("" : "+v"(tid_));
  const int tid = tid_, wid = tid >> 6, lane = tid & 63, r32 = lane & 31, hi = lane >> 5;
  const int c = wid & 1, e = (wid >> 1) & 1, th = wid >> 2;
  float* wsf = (float*)(lds + 2 * SBUF) + wid * 64; float* li_l = wsf; float* al_l = wsf + 32;
  float m_reg = -1e30f, l_reg = 0; f32x16 o[4] = {};
  const long qrow = (long)MP + 64 * b + 32 * th + r32;
  const bf16* Qw = QN + qrow * 2048 + h * 256 + c * 128 + hi * 8;
  char* qlds = lds + SBUF + wid * 8192 + lane * 16;
#pragma unroll
  for (int d0 = 0; d0 < 8; ++d0) *reinterpret_cast<bf16x8*>(qlds + d0 * 1024) = *reinterpret_cast<const bf16x8*>(Qw + d0 * 16);
  const int kb0 = (int)(uintptr_t)lds + c * 16384, qa0 = (int)(uintptr_t)qlds;
  const int vb0 = (int)(uintptr_t)lds + 2 * 16384 + e * 16384 + v_rd_base(lane);
  f32x8 skA[4], skB[4], sv[4];
  const float* ckb = ck + ((long)b * PAST * 8 + h) * 256;
  const float* cvb = cv + ((long)b * PAST * 8 + h) * 256;
#define SS_TID int ts_ = wv * 64 + lane_id(); asm volatile("" : "+v"(ts_))
#define SS_LOADK(sk, k0) do { SS_TID; _Pragma("unroll") for (int i = 0; i < 4; ++i) { const int n = ts_ + 512 * i; \
      sk[i] = *reinterpret_cast<const f32x8*>(ckb + (unsigned)(((k0) + ((n >> 4) & 63)) * 2048 + (n >> 10) * 128 + (n & 15) * 8)); } } while (0)
#define SS_LOADV(k0) do { SS_TID; _Pragma("unroll") for (int i = 0; i < 4; ++i) { const int n = ts_ + 512 * i; \
      sv[i] = *reinterpret_cast<const f32x8*>(cvb + (unsigned)(((k0) + (n >> 5)) * 2048 + (n & 31) * 8)); } } while (0)
#define SS_WRITEK(sk, bufp) do { SS_TID; _Pragma("unroll") for (int i = 0; i < 4; ++i) { const int n = ts_ + 512 * i; \
      *(bf16x8*)((bufp) + (n >> 10) * 16384 + KSWZ((n >> 4) & 63, (n & 15) * 16)) = Stage<float>::tobf(sk[i]); } } while (0)
#define SS_WRITEV(bufp) do { SS_TID; _Pragma("unroll") for (int i = 0; i < 4; ++i) { const int n = ts_ + 512 * i; \
      *(bf16x8*)((bufp) + 32768 + ((n & 31) >> 4) * 16384 + v_st(n >> 5, (n & 15) * 8)) = Stage<float>::tobf(sv[i]); } } while (0)
#define SS_BAR() do { asm volatile("s_waitcnt lgkmcnt(0)" ::: "memory"); __builtin_amdgcn_s_barrier(); asm volatile("" ::: "memory"); } while (0)
#define SS_RESC(a) do { if (__any((a) < 1.f)) { if (hi == 0) al_l[r32] = (a); asm volatile("s_waitcnt lgkmcnt(0)" ::: "memory"); \
    for (int d = 0; d < 4; ++d) for (int r = 0; r < 16; ++r) o[d][r] *= al_l[crow(r, hi)]; } } while (0)
#define SS_QK(bufp) do { qk_pipe_lq(p0, p1, kb0, qa0, r32, hi); \
      partialSM(p0, p1, m_reg, mn, al); SS_RESC(al); finishSM(p0, p1, al, l_reg, pa0, pa1, pa2, pa3); } while (0)
#define SS_PV(vbase) do { pv_pipe4(o, (vbase), pa0, pa1, pa2, pa3); } while (0)
  constexpr int NTC = PAST / 64;
  SS_LOADK(skA, 0); SS_LOADV(0); SS_LOADK(skB, 64);
#define LD_ON (SV != 2)
#define CP_ON (SV != 1)
  for (int j = 0; j < NTC; j += 2) {
    {
      f32x16 p0, p1; float mn, al; bf16x8 pa0, pa1, pa2, pa3;
      SS_WRITEK(skA, lds); SS_BAR();
      if (LD_ON && j + 2 < NTC) SS_LOADK(skA, (j + 2) * 64);
      if (CP_ON) SS_QK(lds);
      SS_WRITEV(lds); SS_BAR();
      if (LD_ON) SS_LOADV((j + 1) * 64);
      if (CP_ON) SS_PV(vb0);
    }
    {
      f32x16 p0, p1; float mn, al; bf16x8 pa0, pa1, pa2, pa3;
      SS_WRITEK(skB, lds); SS_BAR();
      if (LD_ON && j + 3 < NTC) SS_LOADK(skB, (j + 3) * 64);
      if (CP_ON) SS_QK(lds);
      SS_WRITEV(lds); SS_BAR();
      if (LD_ON && j + 2 < NTC) SS_LOADV((j + 2) * 64);
      if (CP_ON) SS_PV(vb0);
    }
  }
  {
    bf16x8 nk[4], nv[4];
    const long nrow0 = (long)MP + 64 * b;
#pragma unroll
    for (int i = 0; i < 4; ++i) { const int n = tid + 512 * i;
      nk[i] = *reinterpret_cast<const bf16x8*>(KN + (nrow0 + ((n >> 4) & 63)) * 2048 + h * 256 + (n >> 10) * 128 + (n & 15) * 8);
      nv[i] = *reinterpret_cast<const bf16x8*>(VBn + (nrow0 + (n >> 5)) * 2048 + h * 256 + (n & 31) * 8); }
    __syncthreads();
#pragma unroll
    for (int i = 0; i < 4; ++i) { const int n = tid + 512 * i;
      *(bf16x8*)(lds + (n >> 10) * 16384 + KSWZ((n >> 4) & 63, (n & 15) * 16)) = nk[i];
      *(bf16x8*)(lds + 32768 + ((n & 31) >> 4) * 16384 + v_st(n >> 5, (n & 15) * 8)) = nv[i]; }
    __syncthreads();
    f32x16 p0, p1; float mn, al; bf16x8 pa0, pa1, pa2, pa3;
    SS_QK(lds); SS_PV(vb0);
  }
  if (hi == 0) li_l[r32] = l_reg; asm volatile("s_waitcnt lgkmcnt(0)" ::: "memory");
  float rli[16];
#pragma unroll
  for (int r = 0; r < 16; ++r) rli[r] = __builtin_amdgcn_rcpf(li_l[crow(r, hi)]);
  float* Ow = (c ? OA1 : OA0) + ((long)MP + 64 * b + 32 * th) * 2048 + h * 256 + e * 128;
#pragma unroll
  for (int r = 0; r < 16; ++r) { const int orow = crow(r, hi);
    for (int d0 = 0; d0 < 4; ++d0) Ow[(long)orow * 2048 + d0 * 32 + r32] = o[d0][r] * rli[r]; }
  __syncthreads();
#undef LD_ON
#undef CP_ON
#undef SS_TID
#undef SS_LOADK
#undef SS_LOADV
#undef SS_WRITEK
#undef SS_WRITEV
#undef SS_BAR
#undef SS_RESC
#undef SS_QK
#undef SS_PV
}


__device__ __forceinline__ void qk_half(f32x16& p, const char* Ks, const int half, const bf16x8* qr, int r32, int hi) {
  p = f32x16{};
#pragma unroll
  for (int d0 = 0; d0 < 8; ++d0) { const int cb = (d0 * 16 + hi * 8) * 2;
    const bf16x8 b = *reinterpret_cast<const bf16x8*>(Ks + KSWZ(32 * half + r32, cb));
    p = __builtin_amdgcn_mfma_f32_32x32x16_bf16(b, qr[d0], p, 0, 0, 0); }
}
__device__ __forceinline__ void sm_half(f32x16& p, float& m_reg, float& l_reg, float& alpha, bf16x8& paX, bf16x8& paY, const bool msk) {
  constexpr float C = SCALE * 1.4426950408889634f;
  float pmax = p[0]; for (int r = 1; r < 16; ++r) pmax = fmaxf(pmax, p[r]);
  { auto rr = __builtin_amdgcn_permlane32_swap(__float_as_uint(pmax), __float_as_uint(pmax), false, false); pmax = fmaxf(__uint_as_float(rr[0]), __uint_as_float(rr[1])); }
  if (msk) pmax = -INFINITY;
  float mn;
  if (__builtin_expect(__all(pmax - m_reg <= THR / SCALE), 1)) { mn = m_reg; alpha = 1.f; }
  else { mn = fmaxf(m_reg, pmax); alpha = __builtin_amdgcn_exp2f((m_reg - mn) * C); m_reg = mn; }
  const float mnC = msk ? -INFINITY : -mn * C;
  for (int r = 0; r < 16; ++r) p[r] = __builtin_amdgcn_exp2f(fmaf(p[r], C, mnC));
  float ps = 0; for (int r = 0; r < 16; ++r) ps += p[r];
  { auto rr = __builtin_amdgcn_permlane32_swap(__float_as_uint(ps), __float_as_uint(ps), false, false); ps = __uint_as_float(rr[0]) + __uint_as_float(rr[1]); }
  l_reg = l_reg * alpha + ps;
#define PK4H(P, BASE, OUT) do { unsigned a0 = cvtpk(P[BASE + 0], P[BASE + 1]), a1 = cvtpk(P[BASE + 2], P[BASE + 3]);   \
    unsigned b0 = cvtpk(P[BASE + 4], P[BASE + 5]), b1 = cvtpk(P[BASE + 6], P[BASE + 7]);                              \
    auto r0 = __builtin_amdgcn_permlane32_swap(a0, b0, false, false); auto r1 = __builtin_amdgcn_permlane32_swap(a1, b1, false, false); \
    u32x4 w = {r0[0], r1[0], r0[1], r1[1]}; OUT = *reinterpret_cast<bf16x8*>(&w); } while (0)
  PK4H(p, 0, paX); PK4H(p, 8, paY);
#undef PK4H
}
template <int D0, int H> __device__ __forceinline__ void pv_half_one(f32x16& od, int vb, bf16x8 paX, bf16x8 paY) {
  const s16x4 l0 = tr_read<v_rd_off(D0, 2 * H, 0)>(vb), h0 = tr_read<v_rd_off(D0, 2 * H, 1)>(vb), l1 = tr_read<v_rd_off(D0, 2 * H + 1, 0)>(vb), h1 = tr_read<v_rd_off(D0, 2 * H + 1, 1)>(vb);
  asm volatile("s_waitcnt lgkmcnt(0)" ::: "memory"); SBAR();
#define PKH(L, Hh) (bf16x8){L[0], L[1], L[2], L[3], Hh[0], Hh[1], Hh[2], Hh[3]}
  od = __builtin_amdgcn_mfma_f32_32x32x16_bf16(paX, PKH(l0, h0), od, 0, 0, 0);
  od = __builtin_amdgcn_mfma_f32_32x32x16_bf16(paY, PKH(l1, h1), od, 0, 0, 0);
#undef PKH
}
template <int H> __device__ __forceinline__ void pv_half(f32x16* o, int vb, bf16x8 paX, bf16x8 paY) {
  pv_half_one<0, H>(o[0], vb, paX, paY); pv_half_one<1, H>(o[1], vb, paX, paY); pv_half_one<2, H>(o[2], vb, paX, paY); pv_half_one<3, H>(o[3], vb, paX, paY);
  pv_half_one<0, H>(o[4], vb + 16384, paX, paY); pv_half_one<1, H>(o[5], vb + 16384, paX, paY); pv_half_one<2, H>(o[6], vb + 16384, paX, paY); pv_half_one<3, H>(o[7], vb + 16384, paX, paY);
}

constexpr size_t WBUF = 49152;
template <int VAR>
__device__ __forceinline__ void attn_wide_body(const bf16* __restrict__ Qb, const bf16* __restrict__ Kh, const bf16* __restrict__ Vh, float* __restrict__ Ob, const int NT, const int wlast, char* lds, const int wv) {
  int tid_ = wv * 64 + lane_id(); asm volatile("" : "+v"(tid_));
  const int tid = tid_, wid = tid >> 6, lane = tid & 63, r32 = lane & 31, hi = lane >> 5;
  float* wsf = (float*)(lds + 2 * WBUF) + wid * 64; float* li_l = wsf; float* al_l = wsf + 32;
  float m_reg = -1e30f, l_reg = 0; f32x16 o[8] = {}; bf16x8 qr[8];
  const bf16* Qw = Qb + (long)(wid * QBLK + r32) * 2048 + hi * 8;
#pragma unroll
  for (int d0 = 0; d0 < 8; ++d0) qr[d0] = *reinterpret_cast<const bf16x8*>(Qw + d0 * 16);
  unsigned doff[6];
  { int t2_ = lane_id(); asm volatile("" : "+v"(t2_));
#pragma unroll
    for (int i_ = 0; i_ < 6; ++i_) { const int I_ = i_ * 8 + wv, img_ = I_ >> 4, P_ = (I_ & 15) * 64 + t2_;
      if (img_ == 0) { const int row_ = P_ >> 4, sl_ = P_ & 15; doff[i_] = (unsigned)(row_ * 2048 + ((sl_ ^ (row_ & 7)) << 3)); }
      else { const int st_ = P_ >> 5, q_ = P_ & 31, kk_ = ((st_ >> 2) << 3) + (q_ >> 2), k_ = (kk_ & ~0xC) | ((kk_ & 4) << 1) | ((kk_ & 8) >> 1);
             doff[i_] = (unsigned)(k_ * 2048 + (img_ - 1) * 128 + (st_ & 3) * 32 + (q_ & 3) * 8); } } }
#define W_DMA(k0, bufp) do { const bf16* kt_ = Kh + (size_t)(k0) * 2048; const bf16* vt_ = Vh + (size_t)(k0) * 2048; _Pragma("unroll") for (int i_ = 0; i_ < 6; ++i_) { const int I_ = i_ * 8 + wv; \
      __builtin_amdgcn_global_load_lds((const unsigned*)((i_ < 2 ? kt_ : vt_) + doff[i_]), (LAS unsigned*)((bufp) + I_ * 1024), 16, 0, 0); } } while (0)
#define W_RESC(a) do { if (__any((a) < 1.f)) { if (hi == 0) al_l[r32] = (a); asm volatile("s_waitcnt lgkmcnt(0)" ::: "memory"); \
    for (int d = 0; d < 8; ++d) for (int r = 0; r < 16; ++r) o[d][r] *= al_l[crow(r, hi)]; } } while (0)
  W_DMA(0, lds); if (1 < NT) W_DMA(KVBLK, lds + WBUF);
  asm volatile("s_waitcnt vmcnt(0)" ::: "memory"); __syncthreads();
  for (int j = 0; j < NT; ++j) {
    char* bp = lds + (j & 1) * WBUF;
    f32x16 p0, p1; float mn, al; bf16x8 pa0, pa1, pa2, pa3;
    if constexpr (VAR == 3) { p0 = f32x16{}; p1 = f32x16{}; for (int r = 0; r < 16; ++r) { p0[r] = (float)(r + j); p1[r] = (float)(r - j); } } else qk_pipe(p0, p1, (int)(uintptr_t)bp, qr, r32, hi);
    {
      constexpr float C = SCALE * 1.4426950408889634f; const bool msk = j > wlast;
      float pmax = p0[0]; for (int r = 1; r < 16; ++r) pmax = fmaxf(pmax, p0[r]); for (int r = 0; r < 16; ++r) pmax = fmaxf(pmax, p1[r]);
      { auto rr = __builtin_amdgcn_permlane32_swap(__float_as_uint(pmax), __float_as_uint(pmax), false, false); pmax = fmaxf(__uint_as_float(rr[0]), __uint_as_float(rr[1])); }
      if (msk) pmax = -INFINITY;
      if (__builtin_expect(__all(pmax - m_reg <= THR / SCALE), 1)) { mn = m_reg; al = 1.f; }
      else { mn = fmaxf(m_reg, pmax); al = __builtin_amdgcn_exp2f((m_reg - mn) * C); m_reg = mn; }
      const float mnC = msk ? -INFINITY : -mn * C;
      for (int r = 0; r < 16; ++r) p0[r] = fmaf(p0[r], C, mnC); for (int r = 0; r < 16; ++r) p1[r] = fmaf(p1[r], C, mnC);
      if constexpr (VAR != 1 && VAR != 4) { for (int r = 0; r < 16; ++r) p0[r] = __builtin_amdgcn_exp2f(p0[r]); }
    }
    W_RESC(al);
    if constexpr (VAR == 1) { float ps = 0; for (int r = 0; r < 16; ++r) ps += p0[r] + p1[r]; l_reg = l_reg * al + ps;
        v4u w0 = {cvtpk(p0[0], p0[1]), cvtpk(p0[2], p0[3]), cvtpk(p0[4], p0[5]), cvtpk(p0[6], p0[7])}, w1 = {cvtpk(p0[8], p0[9]), cvtpk(p0[10], p0[11]), cvtpk(p0[12], p0[13]), cvtpk(p0[14], p0[15])};
        v4u w2 = {cvtpk(p1[0], p1[1]), cvtpk(p1[2], p1[3]), cvtpk(p1[4], p1[5]), cvtpk(p1[6], p1[7])}, w3 = {cvtpk(p1[8], p1[9]), cvtpk(p1[10], p1[11]), cvtpk(p1[12], p1[13]), cvtpk(p1[14], p1[15])};
        pa0 = __builtin_bit_cast(bf16x8, w0); pa1 = __builtin_bit_cast(bf16x8, w1); pa2 = __builtin_bit_cast(bf16x8, w2); pa3 = __builtin_bit_cast(bf16x8, w3); }
    else if constexpr (VAR == 4) { l_reg += p0[0];
        v4u w0 = {__float_as_uint(p0[0]), __float_as_uint(p0[1]), __float_as_uint(p0[2]), __float_as_uint(p0[3])}, w1 = {__float_as_uint(p0[4]), __float_as_uint(p0[5]), __float_as_uint(p0[6]), __float_as_uint(p0[7])};
        v4u w2 = {__float_as_uint(p1[0]), __float_as_uint(p1[1]), __float_as_uint(p1[2]), __float_as_uint(p1[3])}, w3 = {__float_as_uint(p1[4]), __float_as_uint(p1[5]), __float_as_uint(p1[6]), __float_as_uint(p1[7])};
        pa0 = __builtin_bit_cast(bf16x8, w0); pa1 = __builtin_bit_cast(bf16x8, w1); pa2 = __builtin_bit_cast(bf16x8, w2); pa3 = __builtin_bit_cast(bf16x8, w3); }
    else finishSM(p0, p1, al, l_reg, pa0, pa1, pa2, pa3);
    SBAR();
    { int t3_ = lane_id(); asm volatile("" : "+v"(t3_)); const int vb0 = (int)(uintptr_t)bp + 16384 + v_rd_base(t3_ & 63);
      if constexpr (VAR == 2) { o[0][0] += __builtin_bit_cast(float, pa0[0] | (pa1[1] << 16)) + __builtin_bit_cast(float, pa2[0] | (pa3[1] << 16)) + (float)vb0; } else pv_pipe(o, vb0, pa0, pa1, pa2, pa3); }
    asm volatile("s_waitcnt vmcnt(0)" ::: "memory"); __syncthreads();
    if (j + 2 < NT) W_DMA((j + 2) * KVBLK, bp);
  }
  {
    int t4_ = lane_id(); asm volatile("" : "+v"(t4_)); const int r32e = t4_ & 31, hie = t4_ >> 5;
    float* lil = (float*)(lds + 2 * WBUF) + wv * 64;
    if (hie == 0) lil[r32e] = l_reg; asm volatile("s_waitcnt lgkmcnt(0)" ::: "memory");
    float rli[16];
#pragma unroll
    for (int r = 0; r < 16; ++r) rli[r] = __builtin_amdgcn_rcpf(lil[crow(r, hie)]);
    float* Ow = Ob + (long)(wv * QBLK) * 2048;
#pragma unroll
    for (int r = 0; r < 16; ++r) { const int orow = crow(r, hie);
      for (int d0 = 0; d0 < 8; ++d0) Ow[(long)orow * 2048 + d0 * 32 + r32e] = o[d0][r] * rli[r]; }
  }
  __syncthreads();
#undef W_DMA
#undef W_RESC
}
}

struct Args { const float* in[25]; float* out; unsigned char* ws; int ph_lo, ph_hi; };

struct TrItem { const float* W; bf16* WT; const float* gain; int K, N, gmask, k0, n0, n0d; float gscale; };
__device__ __forceinline__ bool p0_item(const Args& a, int grp, int it, TrItem& t) {
    unsigned char* ws = a.ws;
    constexpr int I_HIN = (DM / 64) * (NHG / 64), I_SQ = (DM / 64) * (DM / 64), I_UP = (DM / 64) * (NUP / 64), I_DN = (DFF / 64) * (DM / 64), I_DIN = (DM / 64) * (NDI / 64);
    int r = it; t.gscale = 1.f;
    if (grp == 0) {
        if (r >= I_HIN) return false;
        t.W = a.in[9]; t.K = DM; t.N = NHG; t.WT = (bf16*)(ws + WS_W_HIN); t.gain = a.in[6]; t.gmask = DM - 1;
    } else if (grp == 1) {
        if (r >= I_SQ + I_UP + I_DN + I_DIN) return false;
        if (r < I_SQ) { t.W = a.in[10]; t.K = DM; t.N = DM; t.WT = (bf16*)(ws + WS_W_HOUT); t.gain = a.in[11]; t.gmask = 127; }
        else if ((r -= I_SQ) < I_UP) { t.W = a.in[21]; t.K = DM; t.N = NUP; t.WT = (bf16*)(ws + WS_W_UP0); t.gain = a.in[7]; t.gmask = DM - 1; }
        else if ((r -= I_UP) < I_DN) { t.W = a.in[24]; t.K = DFF; t.N = DM; t.WT = (bf16*)(ws + WS_W_DN0); t.gain = nullptr; t.gmask = 0; }
        else { r -= I_DN; t.W = a.in[12]; t.K = DM; t.N = NDI; t.WT = (bf16*)(ws + WS_W_DIN); t.gain = a.in[6] + DM; t.gmask = DM - 1; }
    } else {
        if (r >= I_SQ + I_UP + I_DN) return false;
        if (r < I_SQ) { t.W = a.in[13]; t.K = DM; t.N = DM; t.WT = (bf16*)(ws + WS_W_DOUT); t.gain = a.in[20]; t.gmask = 255; t.gscale = 1.f - LAM_INIT; }
        else if ((r -= I_SQ) < I_UP) { t.W = a.in[21] + (size_t)DM * NUP; t.K = DM; t.N = NUP; t.WT = (bf16*)(ws + WS_W_UP1); t.gain = a.in[7] + DM; t.gmask = DM - 1; }
        else { r -= I_UP; t.W = a.in[24] + (size_t)DFF * DM; t.K = DFF; t.N = DM; t.WT = (bf16*)(ws + WS_W_DN1); t.gain = nullptr; t.gmask = 0; }
    }
    const int nblk = t.N / 64; t.k0 = 64 * (r / nblk); t.n0 = 64 * (r % nblk);
    t.n0d = (t.N == NUP) ? ((t.n0 < DFF) ? 256 * (t.n0 >> 7) + (t.n0 & 127) : 256 * ((t.n0 - DFF) >> 7) + 128 + ((t.n0 - DFF) & 127)) : t.n0;
    return true;
}
constexpr int TR_GRP2_ITEMS = (DM / 64) * (DM / 64) + (DM / 64) * (NUP / 64) + (DFF / 64) * (DM / 64);
#define TR_LOAD(v, gk, t) do { _Pragma("unroll") for (int i = 0; i < 16; ++i) { const int k = 8 * (i >> 1) + 2 * kr + (i & 1); \
        v[i] = *(const GAS f32x4*)((t).W + (size_t)((t).k0 + k) * (t).N + (t).n0 + 4 * n4); gk[i] = (t).gain ? (t).gain[((t).k0 + k) & (t).gmask] * (t).gscale : 1.f; } } while (0)
#define TR_STORE(v, gk, t) do { _Pragma("unroll") for (int j = 0; j < 8; ++j) { const f32x4 a_ = v[2 * j] * gk[2 * j], b_ = v[2 * j + 1] * gk[2 * j + 1]; \
            _Pragma("unroll") for (int c = 0; c < 4; ++c) scr[(4 * n4 + c) * 33 + 4 * j + kr] = cvtpk(a_[c], b_[c]); } \
        LDS_WAIT(); asm volatile("" ::: "memory"); \
        _Pragma("unroll") for (int m = 0; m < 8; ++m) { const int n = (lane >> 3) + 8 * m; const LAS unsigned* sp = scr + n * 33 + 4 * (lane & 7); \
            v4u o_; o_.x = sp[0]; o_.y = sp[1]; o_.z = sp[2]; o_.w = sp[3]; *(GAS v4u*)((t).WT + (size_t)((t).n0d + n) * (t).K + (t).k0 + 8 * (lane & 7)) = o_; } \
        LDS_WAIT(); asm volatile("" ::: "memory"); } while (0)
__device__ __forceinline__ void tr_run(const Args& a, int grp, int first, int step, int last, LAS unsigned* scr, int lane) {
    const int n4 = lane & 15, kr = lane >> 4;
    f32x4 vA[16], vB[16]; float gA[16], gB[16]; TrItem tA, tB;
    int it = first; bool hA = it < last && p0_item(a, grp, it, tA), hB = false;
    if (hA) TR_LOAD(vA, gA, tA);
    while (hA) {
        hB = it + step < last && p0_item(a, grp, it + step, tB); if (hB) TR_LOAD(vB, gB, tB);
        TR_STORE(vA, gA, tA);
        if (!hB) break;
        it += 2 * step; hA = it < last && p0_item(a, grp, it, tA); if (hA) TR_LOAD(vA, gA, tA);
        TR_STORE(vB, gB, tB);
    }
}
__device__ __forceinline__ void p0_prologue(const Args& a, LAS unsigned char* lds, int vcu, int G, int wave, int lane) {
    LAS unsigned* scr = (LAS unsigned*)(lds + RING_OFF + wave * 16384);
    const int gw = vcu * NWAVES + wave, NGW = G * NWAVES;
    unsigned char* ws = a.ws;
    tr_run(a, 0, gw, NGW, 1 << 30, scr, lane);
    if (G != 256) tr_run(a, 1, gw, NGW, 1 << 30, scr, lane);
    float* sm = (float*)(ws + WS_SMALL); bf16* XB = (bf16*)(ws + WS_XB);
    for (int m = gw; m < MR; m += NGW) {
        const float* xrow = (m < MP) ? a.in[0] + (size_t)m * DM : a.in[1] + (size_t)(m - MP) * DM;
        const GAS f32x4* xr = (const GAS f32x4*)xrow + lane;
        f32x4 v[8]; float s = 0.f;
#pragma unroll
        for (int j = 0; j < 8; ++j) { v[j] = xr[64 * j]; s += (v[j].x * v[j].x + v[j].y * v[j].y) + (v[j].z * v[j].z + v[j].w * v[j].w); }
        s = wave_sum(s);
        GAS v2u* o8 = (GAS v2u*)(XB + (size_t)m * DM) + lane;
#pragma unroll
        for (int j = 0; j < 8; ++j) { v2u w; w.x = cvtpk(v[j].x, v[j].y); w.y = cvtpk(v[j].z, v[j].w); o8[64 * j] = w; }
        if (lane == 0) sm[SM_RINV0 + m] = 1.f / sqrtf(s * (1.f / DM) + EPS);
    }
    for (int i = gw * 64 + lane; i < DM; i += NGW * 64) {
        const float z0 = a.in[8][i], z1 = a.in[8][DM + i], z2 = a.in[8][2 * DM + i], mx = fmaxf(z0, fmaxf(z1, z2));
        const float e0 = expf(z0 - mx), e1 = expf(z1 - mx), e2 = expf(z2 - mx);
        sm[SM_LB + i] = e0 / (e0 + e1 + e2);
    }
    if (gw == 0) {
        const float s1 = wave_sum(a.in[16][lane] * a.in[17][lane] + a.in[16][lane + 64] * a.in[17][lane + 64]);
        const float s2 = wave_sum(a.in[18][lane] * a.in[19][lane] + a.in[18][lane + 64] * a.in[19][lane + 64]);
        if (lane == 0) sm[SM_LAM] = expf(s1) - expf(s2) + LAM_INIT;
    }
}

__device__ __forceinline__ unsigned img_off(unsigned row, unsigned ch) { return 256u * row + 16u * (ch ^ (((row & 3u) << 2) | ((row >> 2) & 3u))); }
__device__ __forceinline__ bf16x8 img_rowread(const LAS unsigned char* img, int rowbase, int ks, int lane) {
    return *(const LAS bf16x8*)(img + img_off(rowbase + (lane & 31), 2 * ks + (lane >> 5)));
}
__device__ __forceinline__ s16x4 vtr(const LAS unsigned char* p) { typedef short v4i16_t __attribute__((ext_vector_type(4)));
    return __builtin_bit_cast(s16x4, __builtin_amdgcn_ds_read_tr16_b64_v4i16((LAS v4i16_t*)p)); }
__device__ __forceinline__ bf16x8 img_trread_nat(const LAS unsigned char* img, int R0, int c, int lane) {
    const unsigned h = lane >> 5, blk = (lane >> 4) & 1, q = (lane & 15) >> 2, p = lane & 3;
    const s16x4 lo = vtr(img + img_off(R0 + 8 * h + q, 4 * c + 2 * blk + (p >> 1)) + 8 * (p & 1));
    const s16x4 hi = vtr(img + img_off(R0 + 8 * h + 4 + q, 4 * c + 2 * blk + (p >> 1)) + 8 * (p & 1));
    return (bf16x8){lo[0], lo[1], lo[2], lo[3], hi[0], hi[1], hi[2], hi[3]};
}
__device__ __forceinline__ bf16x8 img_trread_acc(const LAS unsigned char* img, int R0, int c, int lane) {
    const unsigned h = lane >> 5, blk = (lane >> 4) & 1, q = (lane & 15) >> 2, p = lane & 3;
    const s16x4 lo = vtr(img + img_off(R0 + 4 * h + q, 4 * c + 2 * blk + (p >> 1)) + 8 * (p & 1));
    const s16x4 hi = vtr(img + img_off(R0 + 8 + 4 * h + q, 4 * c + 2 * blk + (p >> 1)) + 8 * (p & 1));
    return (bf16x8){lo[0], lo[1], lo[2], lo[3], hi[0], hi[1], hi[2], hi[3]};
}
__device__ __forceinline__ int crow_(int r, int hi) { return (r & 3) + 8 * (r >> 2) + 4 * hi; }
#define MFMA32(a, b, c) __builtin_amdgcn_mfma_f32_32x32x16_bf16((a), (b), (c), 0, 0, 0)

#define RAW_BAR() do { asm volatile("s_waitcnt lgkmcnt(0)" ::: "memory"); __builtin_amdgcn_s_barrier(); asm volatile("" ::: "memory"); } while (0)
constexpr int SC_QT = 0, SC_KT = 16384, SC_QH = 32768, SC_VI = 49152, SC_SI = 65536, SC_PART = 98304, SC_RED = 102400;

constexpr int SR_KH = 98304, SR_PART = 114688, SR_RED = 118784, SR_DV = 119808;
constexpr size_t WS_RB = WS_LST, WS_RE = WS_LST + 32 * MiB;
__device__ __forceinline__ void sr_state_image(LAS unsigned char* lds, const f32x16& acc0, const f32x16& acc1, int db, int eb0, int hi_, int r32_) {
    int lz = lane_id(); asm volatile("" : "+v"(lz)); const int hi = lz >> 5, r32 = lz & 31; (void)hi_; (void)r32_;
#pragma unroll
    for (int r = 0; r < 16; ++r) { const int d = 32 * db + crow_(r, hi);
        { const int e = 32 * eb0 + r32; *(LAS unsigned short*)(lds + SC_SI + img_off(d, e >> 3) + (e & 7) * 2) = (unsigned short)cvtpk(acc0[r], acc0[r]); }
        { const int e = 32 * (eb0 + 1) + r32; *(LAS unsigned short*)(lds + SC_SI + img_off(d, e >> 3) + (e & 7) * 2) = (unsigned short)cvtpk(acc1[r], acc1[r]); } }
}
template <bool OUT>
__device__ __forceinline__ void scan_run_phase(const Args& a, LAS unsigned char* lds, int vcu, int G, int tid, int wave, int lane) {
    unsigned char* ws = a.ws;
    const bf16* QH = (const bf16*)(ws + WS_QH); const bf16* VH = (const bf16*)(ws + WS_VH); const bf16* SG = (const bf16*)(ws + WS_SG);
    const float* GG = (const float*)(ws + WS_G); bf16* HA = (bf16*)(ws + WS_HA);
    float* RB = (float*)(ws + WS_RB); const float* RE = (const float*)(ws + WS_RE); float* RA = (float*)(ws + WS_DC);
    LAS float* part = (LAS float*)(lds + SR_PART); LAS float* red = (LAS float*)(lds + SR_RED); LAS float* dvl = (LAS float*)(lds + SR_DV);
    const int hi = lane >> 5, r32 = lane & 31, db = wave & 3, eb0 = 2 * (wave >> 2);
    for (int unitid = vcu; unitid < 256; unitid += G) {
#pragma unroll 1
      for (int seq = 0; seq < (OUT ? 2 : 1); ++seq) {
        const int hh = seq == 0 ? (unitid >> 4) : (unitid & 15);
        const int c0 = seq == 0 ? 8 * (unitid & 15) : NCHP + (unitid >> 4);
        const int nck = seq == 0 ? 8 : 1;
        f32x16 acc0 = {}, acc1 = {}; f32x2 aprod = {1.f, 1.f};
        if (OUT) {
            const float* E = seq == 0 ? RE + (size_t)unitid * 16384 : a.in[2] + (size_t)unitid * 16384;
#pragma unroll
            for (int r = 0; r < 16; ++r) { int lz = lane_id(); asm volatile("" : "+v"(lz)); const int d = 32 * db + crow_(r, lz >> 5); acc0[r] = E[d * 128 + 32 * eb0 + (lz & 31)]; acc1[r] = E[d * 128 + 32 * (eb0 + 1) + (lz & 31)]; }
            sr_state_image(lds, acc0, acc1, db, eb0, hi, r32);
        }
        f32x2 g[8]; unsigned qv[8]; v4u vch[2];
#define SR_LOAD(cc) do { const size_t rb_ = (size_t)(cc) * 64; \
            _Pragma("unroll") for (int i = 0; i < 8; ++i) { const size_t off = (rb_ + wave * 8 + i) * DM + hh * 128 + 2 * lane; g[i] = *(const f32x2*)(GG + off); if (OUT) qv[i] = *(const unsigned*)(QH + off); } \
            _Pragma("unroll") for (int j = 0; j < 2; ++j) { const int n = tid + 512 * j; vch[j] = *(const v4u*)(VH + (rb_ + (n >> 4)) * DM + hh * 128 + (n & 15) * 8); } } while (0)
        SR_LOAD(c0);
#pragma unroll 1
        for (int k = 0; k < nck; ++k) {
            const int c = c0 + k; const size_t rb = (size_t)c * 64;
#pragma unroll
            for (int i = 1; i < 8; ++i) g[i] += g[i - 1];
            *(LAS f32x2*)(part + wave * 128 + 2 * lane) = g[7];
            RAW_BAR();
            f32x2 offv = {0.f, 0.f}, bmid = {0.f, 0.f}, blast = {0.f, 0.f};
#pragma unroll
            for (int s = 0; s < 8; ++s) { const f32x2 p = *(const LAS f32x2*)(part + s * 128 + 2 * lane); if (s < wave) offv += p; if (s < 4) bmid += p; blast += p; }
#pragma unroll
            for (int i = 0; i < 8; ++i) { const f32x2 b = offv + g[i];
                const f32x2 gr = i ? g[i] - g[i - 1] : g[0];
                const float k0 = 1.f - __expf(gr.x), k1 = 1.f - __expf(gr.y);
                const unsigned o = img_off(wave * 8 + i, lane >> 2) + (lane & 3) * 4;
                *(LAS unsigned*)(lds + SR_KH + o) = cvtpk(k0 * __expf(blast.x - b.x), k1 * __expf(blast.y - b.y));
                if (OUT) { const float q0 = bflo(qv[i]), q1 = bfhi(qv[i]);
                    *(LAS unsigned*)(lds + SC_QH + o) = cvtpk(q0 * __expf(b.x), q1 * __expf(b.y));
                    *(LAS unsigned*)(lds + SC_QT + o) = cvtpk(q0 * __expf(fminf(b.x - bmid.x, 80.f)), q1 * __expf(fminf(b.y - bmid.y, 80.f)));
                    *(LAS unsigned*)(lds + SC_KT + o) = cvtpk(k0 * __expf(fminf(bmid.x - b.x, 80.f)), k1 * __expf(fminf(bmid.y - b.y, 80.f))); } }
#pragma unroll
            for (int j = 0; j < 2; ++j) { const int n = tid + 512 * j; *(LAS v4u*)(lds + SC_VI + img_off(n >> 4, n & 15)) = vch[j]; }
            if (wave == 0) { const f32x2 ev = {__expf(blast.x), __expf(blast.y)}; *(LAS f32x2*)(dvl + 2 * lane) = ev; aprod = aprod * ev; }
            const int eb = wave & 3, tb = wave >> 2;
            const size_t orow = (rb + 32 * tb + r32) * DM + hh * 128 + 32 * eb + 4 * hi;
            v2u sgv[4];
            if (OUT) {
#pragma unroll
                for (int g4 = 0; g4 < 4; ++g4) sgv[g4] = *(const v2u*)(SG + orow + 8 * g4);
            }
            if (k + 1 < nck) SR_LOAD(c + 1);
            RAW_BAR();
            if (OUT) {
                f32x16 o = {};
                {
                    f32x16 X = {};
#pragma unroll
                    for (int ks = 0; ks < 8; ++ks) X = MFMA32(img_rowread(lds + SC_KT, 0, ks, lane), img_rowread(lds + SC_QT, 32 * tb, ks, lane), X);
                    if (tb == 0) {
#pragma unroll
                        for (int r = 0; r < 16; ++r) if (crow_(r, hi) > r32) X[r] = 0.f;
                    }
#pragma unroll
                    for (int s2 = 0; s2 < 2; ++s2) {
                        v4u w; w.x = cvtpk(X[8 * s2 + 0], X[8 * s2 + 1]); w.y = cvtpk(X[8 * s2 + 2], X[8 * s2 + 3]); w.z = cvtpk(X[8 * s2 + 4], X[8 * s2 + 5]); w.w = cvtpk(X[8 * s2 + 6], X[8 * s2 + 7]);
                        o = MFMA32(img_trread_acc(lds + SC_VI, 16 * s2, eb, lane), __builtin_bit_cast(bf16x8, w), o);
                    }
                }
                if (tb == 1) {
                    f32x16 X = {};
#pragma unroll
                    for (int ks = 0; ks < 8; ++ks) X = MFMA32(img_rowread(lds + SC_KT, 32, ks, lane), img_rowread(lds + SC_QT, 32, ks, lane), X);
#pragma unroll
                    for (int r = 0; r < 16; ++r) if (crow_(r, hi) > r32) X[r] = 0.f;
#pragma unroll
                    for (int s2 = 0; s2 < 2; ++s2) {
                        v4u w; w.x = cvtpk(X[8 * s2 + 0], X[8 * s2 + 1]); w.y = cvtpk(X[8 * s2 + 2], X[8 * s2 + 3]); w.z = cvtpk(X[8 * s2 + 4], X[8 * s2 + 5]); w.w = cvtpk(X[8 * s2 + 6], X[8 * s2 + 7]);
                        o = MFMA32(img_trread_acc(lds + SC_VI, 32 + 16 * s2, eb, lane), __builtin_bit_cast(bf16x8, w), o);
                    }
                }
#pragma unroll
                for (int ks = 0; ks < 8; ++ks) o = MFMA32(img_trread_nat(lds + SC_SI, 16 * ks, eb, lane), img_rowread(lds + SC_QH, 32 * tb, ks, lane), o);
                float ss = 0.f;
#pragma unroll
                for (int r = 0; r < 16; ++r) ss += o[r] * o[r];
                ss += __shfl_xor(ss, 32);
                if (lane < 32) red[(tb * 4 + eb) * 32 + lane] = ss;
                RAW_BAR();
                const float tot = (red[(tb * 4 + 0) * 32 + r32] + red[(tb * 4 + 1) * 32 + r32]) + (red[(tb * 4 + 2) * 32 + r32] + red[(tb * 4 + 3) * 32 + r32]);
                const float rn = __builtin_amdgcn_rsqf(tot * (1.f / 128.f) + EPS);
#pragma unroll
                for (int g4 = 0; g4 < 4; ++g4) {
                    const v2u sg = sgv[g4];
                    v2u w; w.x = cvtpk(o[4 * g4 + 0] * rn * bflo(sg.x), o[4 * g4 + 1] * rn * bfhi(sg.x)); w.y = cvtpk(o[4 * g4 + 2] * rn * bflo(sg.y), o[4 * g4 + 3] * rn * bfhi(sg.y));
                    *(v2u*)(HA + orow + 8 * g4) = w;
                }
            }
            { int lz = lane_id(); asm volatile("" : "+v"(lz)); const LAS float* dp = dvl + 32 * db + 4 * (lz >> 5);
#pragma unroll
              for (int r = 0; r < 16; ++r) { const float dv = dp[(r & 3) + 8 * (r >> 2)]; acc0[r] *= dv; acc1[r] *= dv; } }
#pragma unroll
            for (int ks = 0; ks < 4; ++ks) {
                const bf16x8 Af = img_trread_nat(lds + SR_KH, 16 * ks, db, lane);
                const bf16x8 B0 = img_trread_nat(lds + SC_VI, 16 * ks, eb0, lane), B1 = img_trread_nat(lds + SC_VI, 16 * ks, eb0 + 1, lane);
                acc0 = MFMA32(Af, B0, acc0); acc1 = MFMA32(Af, B1, acc1);
            }
            if (OUT && k + 1 < nck) sr_state_image(lds, acc0, acc1, db, eb0, hi, r32);
        }
        if (!OUT) {
            float* Bu = RB + (size_t)unitid * 16384;
#pragma unroll
            for (int r = 0; r < 16; ++r) { int lz = lane_id(); asm volatile("" : "+v"(lz)); const int d = 32 * db + crow_(r, lz >> 5); Bu[d * 128 + 32 * eb0 + (lz & 31)] = acc0[r]; Bu[d * 128 + 32 * (eb0 + 1) + (lz & 31)] = acc1[r]; }
            if (wave == 0) *(f32x2*)(RA + (size_t)unitid * 128 + 2 * lane) = aprod;
        } else if (seq == 1) {
            float* Su = a.out + O_HS + (size_t)unitid * 16384;
#pragma unroll
            for (int r = 0; r < 16; ++r) { int lz = lane_id(); asm volatile("" : "+v"(lz)); const int d = 32 * db + crow_(r, lz >> 5); Su[d * 128 + 32 * eb0 + (lz & 31)] = acc0[r]; Su[d * 128 + 32 * (eb0 + 1) + (lz & 31)] = acc1[r]; }
        }
        __syncthreads();
#undef SR_LOAD
      }
    }
}
__device__ __forceinline__ void scan_runcarry_phase(const Args& a, int vcu, int G, int tid) {
    unsigned char* ws = a.ws;
    const float* RB = (const float*)(ws + WS_RB); float* RE = (float*)(ws + WS_RE); const float* RA = (const float*)(ws + WS_DC);
    for (int p = vcu * 512 + tid; p < 131072; p += G * 512) {
        const int idx = 2 * p, hh = idx >> 14, d = (idx >> 7) & 127, e = idx & 127;
        f32x2 Bv[16]; float Av[16];
#pragma unroll
        for (int r = 0; r < 16; ++r) { const size_t run = (size_t)hh * 16 + r; Bv[r] = *(const f32x2*)(RB + run * 16384 + d * 128 + e); Av[r] = RA[run * 128 + d]; }
        f32x2 E = {0.f, 0.f};
#pragma unroll
        for (int r = 0; r < 16; ++r) { const size_t run = (size_t)hh * 16 + r; *(f32x2*)(RE + run * 16384 + d * 128 + e) = E; E = E * Av[r] + Bv[r]; }
        *(f32x2*)(a.out + O_HP + idx) = E;
    }
}

__device__ __forceinline__ void conv_fix_phase(const Args& a, int layer, int vcu, int G, int tid) {
    unsigned char* ws = a.ws;
    const bf16* SGF = (const bf16*)(ws + WS_GU); const bf16* SGL = SGF + (size_t)(MR / 16) * 4 * DFF; bf16* ACT = (bf16*)(ws + WS_ACT);
    const float* cw = a.in[22] + (size_t)layer * 3 * DFF; const float* cb = a.in[23] + (size_t)layer * DFF; const float* st = a.in[5] + (size_t)layer * 16 * 2 * DFF;
    constexpr int NCC = DFF / 8, NGRP = MR / 16;
    for (int it = vcu * 512 + tid; it < NCC * NGRP; it += G * 512) {
        const int cc = it % NCC, grp = it / NCC, c0 = cc * 8, t0 = grp * 16;
        float w0[8], w1[8], w2[8], bb[8], g1[8], g2[8];
#pragma unroll
        for (int j = 0; j < 8; ++j) { w0[j] = cw[c0 + j]; w1[j] = cw[DFF + c0 + j]; w2[j] = cw[2 * DFF + c0 + j]; bb[j] = cb[c0 + j]; }
        if (t0 == 0) {
#pragma unroll
            for (int j = 0; j < 8; ++j) { g1[j] = 0.f; g2[j] = 0.f; }
        } else if (t0 >= MP && (t0 & 63) == 0) {
            const float* sp = st + (size_t)((t0 - MP) >> 6) * 2 * DFF + c0;
#pragma unroll
            for (int j = 0; j < 8; ++j) { g2[j] = sp[j]; g1[j] = sp[DFF + j]; }
        } else {
            const v4u p2 = *(const v4u*)(SGL + ((size_t)(grp - 1) * 2 + 0) * DFF + c0), p1 = *(const v4u*)(SGL + ((size_t)(grp - 1) * 2 + 1) * DFF + c0);
            g2[0] = bflo(p2.x); g2[1] = bfhi(p2.x); g2[2] = bflo(p2.y); g2[3] = bfhi(p2.y); g2[4] = bflo(p2.z); g2[5] = bfhi(p2.z); g2[6] = bflo(p2.w); g2[7] = bfhi(p2.w);
            g1[0] = bflo(p1.x); g1[1] = bfhi(p1.x); g1[2] = bflo(p1.y); g1[3] = bfhi(p1.y); g1[4] = bflo(p1.z); g1[5] = bfhi(p1.z); g1[6] = bflo(p1.w); g1[7] = bfhi(p1.w);
        }
#pragma unroll
        for (int j2 = 0; j2 < 2; ++j2) {
            const v4u pg = *(const v4u*)(SGF + (((size_t)grp * 2 + j2) * 2 + 0) * DFF + c0), pu = *(const v4u*)(SGF + (((size_t)grp * 2 + j2) * 2 + 1) * DFF + c0);
            float g0[8], up[8], r[8];
            g0[0] = bflo(pg.x); g0[1] = bfhi(pg.x); g0[2] = bflo(pg.y); g0[3] = bfhi(pg.y); g0[4] = bflo(pg.z); g0[5] = bfhi(pg.z); g0[6] = bflo(pg.w); g0[7] = bfhi(pg.w);
            up[0] = bflo(pu.x); up[1] = bfhi(pu.x); up[2] = bflo(pu.y); up[3] = bfhi(pu.y); up[4] = bflo(pu.z); up[5] = bfhi(pu.z); up[6] = bflo(pu.w); up[7] = bfhi(pu.w);
#pragma unroll
            for (int j = 0; j < 8; ++j) { const float cv = bb[j] + w2[j] * g0[j] + w1[j] * g1[j] + w0[j] * g2[j]; r[j] = cv * sigmoidf_(cv) * up[j]; g2[j] = g1[j]; g1[j] = g0[j]; }
            v4u w; w.x = cvtpk(r[0], r[1]); w.y = cvtpk(r[2], r[3]); w.z = cvtpk(r[4], r[5]); w.w = cvtpk(r[6], r[7]);
            *(v4u*)(ACT + (size_t)(t0 + j2) * DFF + c0) = w;
        }
    }
}

__device__ __forceinline__ void diff_combine_phase(const Args& a, int vcu, int G, int wave, int lane) {
    unsigned char* ws = a.ws;
    const float* OA0 = (const float*)(ws + WS_OA); const float* OA1 = OA0 + (size_t)MR * DM; bf16* HA = (bf16*)(ws + WS_HA);
    const float lam = ((const float*)(ws + WS_SMALL))[SM_LAM];
    const int gw = vcu * NWAVES + wave, NGW = G * NWAVES;
    constexpr int CU_ = 4;
    for (int it = gw; it < MR * 8; it += CU_ * NGW) {
        f32x4 o[CU_]; float s[CU_];
#pragma unroll
        for (int u = 0; u < CU_; ++u) { int iu = it + u * NGW; if (iu >= MR * 8) iu = it;
            const size_t off = (size_t)iu * 256 + lane * 4;
            const f32x4 x0 = *(const f32x4*)(OA0 + off), x1 = *(const f32x4*)(OA1 + off); o[u] = x0 - x1 * lam; }
#pragma unroll
        for (int u = 0; u < CU_; ++u) s[u] = (o[u].x * o[u].x + o[u].y * o[u].y) + (o[u].z * o[u].z + o[u].w * o[u].w);
#pragma unroll
        for (int sh = 1; sh < 64; sh <<= 1) {
#pragma unroll
            for (int u = 0; u < CU_; ++u) s[u] += __shfl_xor(s[u], sh); }
#pragma unroll
        for (int u = 0; u < CU_; ++u) { const int iu = it + u * NGW; if (iu < MR * 8) {
            const float rn = __builtin_amdgcn_rsqf(s[u] * (1.f / 256.f) + EPS);
            v2u w; w.x = cvtpk(o[u].x * rn, o[u].y * rn); w.y = cvtpk(o[u].z * rn, o[u].w * rn);
            *(v2u*)(HA + (size_t)iu * 256 + lane * 4) = w; } }
    }
}

#ifndef ATT_NS
#define ATT_NS 8
#endif
__device__ __forceinline__ void attention_phase(const Args& a, char* lds, gu32* qctr, const int wv) {
    unsigned char* ws = a.ws;
    const att::bf16* QN = (const att::bf16*)(ws + WS_QH); const att::bf16* KN = (const att::bf16*)(ws + WS_KH); const att::bf16* VBn = (const att::bf16*)(ws + WS_VH);
    float* OA0 = (float*)(ws + WS_OA); float* OA1 = OA0 + (size_t)MR * DM;
    const int wid = wv; const bool t0 = (wv == 0 && lane_id() == 0);
    volatile unsigned* slot = (volatile unsigned*)(lds + SCR_OFF + 4096);
    const int x0 = (int)(xb_xcc_id() & 7u);
    bool conv_left = true;
    for (int dq = 0; dq < 8; ++dq) {
        const int x = (x0 + dq) & 7;
        for (;;) {
            __syncthreads();
            if (t0) *slot = __hip_atomic_fetch_add(qctr + 64 * x, 1u, __ATOMIC_RELAXED, __HIP_MEMORY_SCOPE_AGENT);
            __syncthreads();
            const int u = __builtin_amdgcn_readfirstlane((int)*slot);
            if (u >= 16 + 64) break;
            const bool smp = u < 8 || (u >= 32 && u < 40);
            if (smp) {
#ifndef NO_SAMPLE
                const int su = u < 8 ? u : u - 24;
                att::attn_sample_unit(QN, KN, VBn, a.in[3], a.in[4], OA0, OA1, 2 * x + (su >> 3), su & 7, lds, wv);
#endif
            } else {
#ifndef NO_PROMPT
                const int v = u < 32 ? u - 8 : u - 16, qb = 31 - (v >> 1), h = x, c = v & 1;
                const size_t qoff = (size_t)qb * 256 * DM + h * 256;
                att::attn_wide_body<0>(QN + qoff + c * 128, KN + h * 256 + c * 128, VBn + h * 256, (c ? OA1 : OA0) + qoff, 4 * qb + 4, 4 * qb + (wid >> 1), lds, wv);
#endif
            }
            if (conv_left) {
                __syncthreads();
                if (t0) *slot = __hip_atomic_fetch_add(qctr + 64 * 8, 1u, __ATOMIC_RELAXED, __HIP_MEMORY_SCOPE_AGENT);
                __syncthreads();
                const int cu_ = __builtin_amdgcn_readfirstlane((int)*slot);
                if (cu_ * 64 >= TR_GRP2_ITEMS) conv_left = false;
                else { const int last = (cu_ * 64 + 64 < TR_GRP2_ITEMS) ? cu_ * 64 + 64 : TR_GRP2_ITEMS; tr_run(a, 2, cu_ * 64 + wid, NWAVES, last, (LAS unsigned*)(lds + wid * 16384), lane_id()); }
            }
        }
    }
    while (conv_left) {
        __syncthreads();
        if (t0) *slot = __hip_atomic_fetch_add(qctr + 64 * 8, 1u, __ATOMIC_RELAXED, __HIP_MEMORY_SCOPE_AGENT);
        __syncthreads();
        const int u = __builtin_amdgcn_readfirstlane((int)*slot);
        if (u * 64 >= TR_GRP2_ITEMS) break;
        const int last = (u * 64 + 64 < TR_GRP2_ITEMS) ? u * 64 + 64 : TR_GRP2_ITEMS;
        tr_run(a, 2, u * 64 + wid, NWAVES, last, (LAS unsigned*)(lds + wid * 16384), lane_id());
    }
}

constexpr int NPH = 17;
#ifndef G1_CUS
#define G1_CUS 224
#endif
constexpr int SPLIT_0 = 7, SPLIT_1 = 8, SPLIT_2 = 8, SPLIT_3 = 8, SPLIT_4 = 0, SPLIT_5 = 8, SPLIT_6 = 8, SPLIT_7 = 8;
__global__ void __launch_bounds__(NWAVES * 64, 2) fwd_kernel(Args args) {
    extern __shared__ __attribute__((aligned(16))) unsigned char lds[];
    LAS unsigned char* L = (LAS unsigned char*)lds;
    volatile LAS unsigned* MISC = (volatile LAS unsigned*)(L + MISC_OFF);
#if defined(__HIP_DEVICE_COMPILE__)
#define ARGSL const __attribute__((address_space(4))) Args* ap__ = (const __attribute__((address_space(4))) Args*)__builtin_amdgcn_kernarg_segment_ptr(); asm volatile("" : "+s"(ap__)); \
    Args A; { _Pragma("unroll") for (int i_ = 0; i_ < 25; ++i_) A.in[i_] = ap__->in[i_]; A.out = ap__->out; A.ws = ap__->ws; A.ph_lo = ap__->ph_lo; A.ph_hi = ap__->ph_hi; }
#else
#define ARGSL const Args A = args
#endif
#define TIDS int t__ = wv * 64 + lane_id(); asm volatile("" : "+v"(t__)); const int tid = t__, lane = t__ & 63; (void)tid; (void)lane
#define ENV int bx = blockIdx.x; int G = gridDim.x; asm volatile("" : "+s"(bx), "+s"(G)); const int vcu = (G % 8 == 0) ? (bx % 8) * (G / 8) + bx / 8 : bx; \
    const int wave = wv; (void)vcu; (void)wave
    const int wv = __builtin_amdgcn_readfirstlane((int)threadIdx.x >> 6);
    for (int u = threadIdx.x; u < (LDS_BYTES - LDSCTL_OFF) / 4; u += NWAVES * 64) ((LAS unsigned*)(L + LDSCTL_OFF))[u] = 0u;
    __syncthreads();
    const int lo = args.ph_lo, hi = args.ph_hi;
#define BAROBJ XcdBarrier bar; bar.wv = wv; ARGSL; bar.bar = (unsigned*)((gu32*)(A.ws + WS_CTL) + CW_BAR); bar.x = xb_xcc_id(); bar.st = MISC + 8
    if (hi - lo > 1) { BAROBJ; (void)xcd_barrier_post(bar.bar, MISC + 8, wv); }
#ifndef PHMASK
#define PHMASK 0x1ffff
#endif
#define IN(k) ((((PHMASK) >> (k)) & 1) && lo <= (k) && (k) < hi)
#ifndef PROBE_MASK
#define PROBE_MASK 0
#endif
#define PR_WORDS ((volatile LAS unsigned long long*)(L + MISC_OFF + 64))
    if (PROBE_MASK && blockIdx.x == 0 && wv == 0 && lane_id() == 0) { PR_WORDS[0] = __builtin_amdgcn_s_memrealtime(); PR_WORDS[1] = 0ull; }
#define SEAM(k) do { if (IN(k) && IN((k) + 1)) { BAROBJ; xcd_barrier(bar); } \
    if (PROBE_MASK && blockIdx.x == 0 && wv == 0 && lane_id() == 0) { const unsigned long long t_ = __builtin_amdgcn_s_memrealtime(); if ((PROBE_MASK >> (k)) & 1) PR_WORDS[1] += t_ - PR_WORDS[0]; PR_WORDS[0] = t_; } } while (0)
#define PTRS ARGSL; unsigned char* ws = A.ws; float* out = A.out; asm volatile("" : "+s"(ws), "+s"(out)); gu32* ctl = (gu32*)(ws + WS_CTL); (void)ctl; (void)out; \
    float* sm = (float*)(ws + WS_SMALL); float* ss1 = (float*)(ctl + CW_SS1); float* ss2 = (float*)(ctl + CW_SS2); float* ss3 = (float*)(ctl + CW_SS3); (void)sm; (void)ss1; (void)ss2; (void)ss3; \
    bf16* XB = (bf16*)(ws + WS_XB); bf16* HA = (bf16*)(ws + WS_HA); float* X1 = (float*)(ws + WS_X1); bf16* GU = (bf16*)(ws + WS_GU); bf16* ACT = (bf16*)(ws + WS_ACT); (void)XB; (void)HA; (void)X1; (void)GU; (void)ACT

    if (IN(0)) { TIDS; ENV; ARGSL; p0_prologue(A, L, vcu, G, wave, lane); }
    SEAM(0);
    if (IN(1)) {
        PTRS; ENV;
        const bool spare = (G == 256);
        if (spare && bx >= G1_CUS) {
            TIDS; tr_run(A, 1, (bx - G1_CUS) * NWAVES + wave, (256 - G1_CUS) * NWAVES, 1 << 30, (LAS unsigned*)(L + RING_OFF + wave * 16384), lane);
        } else {
            const int Gg = spare ? G1_CUS : G, vcg = spare ? (bx % 8) * (G1_CUS / 8) + bx / 8 : vcu;
            pg8::Gemm g{XB, (const bf16*)(ws + WS_W_HIN), MR, NHG, DM}; pg8::SplitOrder S; S.init(MR, NHG, g.K, Gg, bx, vcg, (float*)(ws + WS_SLAB), (unsigned*)(ctl + CW_SKF + 0 * 4096), SPLIT_0, wv);
            EpiHgrnIn E{ws};
            pg8::gemm_phase<EpiHgrnIn, pg8::SplitOrder, true, true>(L + RING_OFF, g, S, E);
        }
    }
    SEAM(1);
    if (IN(2)) { TIDS; ENV; ARGSL; scan_run_phase<false>(A, L, vcu, G, tid, wave, lane); }
    SEAM(2);
    if (IN(3)) { TIDS; ENV; ARGSL; scan_runcarry_phase(A, vcu, G, tid); }
    SEAM(3);
    if (IN(4)) { TIDS; ENV; ARGSL; scan_run_phase<true>(A, L, vcu, G, tid, wave, lane); }
    SEAM(4);
    if (IN(5)) {
        PTRS; ENV;
        pg8::Gemm g{HA, (const bf16*)(ws + WS_W_HOUT), MR, DM, DM}; pg8::SplitOrder S; S.init(MR, DM, g.K, G, bx, vcu, (float*)(ws + WS_SLAB), (unsigned*)(ctl + CW_SKF + 1 * 4096), SPLIT_1, wv);
        EpiResid<true> E{A.in[0], A.in[1] - (size_t)MP * DM, X1, XB, ss1};
        pg8::gemm_phase<EpiResid<true>, pg8::SplitOrder, true, true>(L + RING_OFF, g, S, E);
    }
    SEAM(5);
    if (IN(6)) {
        PTRS; ENV;
        pg8::Gemm g{XB, (const bf16*)(ws + WS_W_UP0), MR, NUP, DM}; pg8::SplitOrder S; S.init(MR, NUP, g.K, G, bx, vcu, (float*)(ws + WS_SLAB), (unsigned*)(ctl + CW_SKF + 2 * 4096), SPLIT_2, wv);
        EpiUp E{ws, ss1, out + O_CP, out + O_CS, A.in[22], A.in[23]};
        pg8::gemm_phase<EpiUp, pg8::SplitOrder, true, true>(L + RING_OFF, g, S, E);
    }
    SEAM(6);
    if (IN(7)) { TIDS; ENV; ARGSL; conv_fix_phase(A, 0, vcu, G, tid); }
    SEAM(7);
    if (IN(8)) {
        PTRS; ENV;
        pg8::Gemm g{ACT, (const bf16*)(ws + WS_W_DN0), MR, DM, DFF}; pg8::SplitOrder S; S.init(MR, DM, g.K, G, bx, vcu, (float*)(ws + WS_SLAB), (unsigned*)(ctl + CW_SKF + 3 * 4096), SPLIT_3, wv);
        EpiResid<true> E{X1, X1, X1, XB, ss2};
        pg8::gemm_phase<EpiResid<true>, pg8::SplitOrder, true, true>(L + RING_OFF, g, S, E);
    }
    SEAM(8);
    if (IN(9)) {
        PTRS; ENV;
        pg8::Gemm g{XB, (const bf16*)(ws + WS_W_DIN), MR, NDI, DM}; pg8::SplitOrder S; S.init(MR, NDI, g.K, G, bx, vcu, (float*)(ws + WS_SLAB), (unsigned*)(ctl + CW_SKF + 4 * 4096), SPLIT_4, wv);
        EpiDiffIn E{ws, out, A.in[14], A.in[15], (LAS float*)(L + SCR_OFF)};
        pg8::gemm_phase<EpiDiffIn, pg8::SplitOrder, true, true>(L + RING_OFF, g, S, E);
    }
    SEAM(9);
    if (IN(11)) { PTRS; attention_phase(A, (char*)lds, ctl + CW_ATTQ, wv); }
    SEAM(11);
    if (IN(12)) { TIDS; ENV; ARGSL; diff_combine_phase(A, vcu, G, wave, lane); }
    SEAM(12);
    if (IN(13)) {
        PTRS; ENV;
        pg8::Gemm g{HA, (const bf16*)(ws + WS_W_DOUT), MR, DM, DM}; pg8::SplitOrder S; S.init(MR, DM, g.K, G, bx, vcu, (float*)(ws + WS_SLAB), (unsigned*)(ctl + CW_SKF + 5 * 4096), SPLIT_5, wv);
        EpiResid<true> E{X1, X1, X1, XB, ss3};
        pg8::gemm_phase<EpiResid<true>, pg8::SplitOrder, true, true>(L + RING_OFF, g, S, E);
    }
    SEAM(13);
    if (IN(14)) {
        PTRS; ENV;
        pg8::Gemm g{XB, (const bf16*)(ws + WS_W_UP1), MR, NUP, DM}; pg8::SplitOrder S; S.init(MR, NUP, g.K, G, bx, vcu, (float*)(ws + WS_SLAB), (unsigned*)(ctl + CW_SKF + 6 * 4096), SPLIT_6, wv);
        EpiUp E{ws, ss3, out + O_CP + 2 * DFF, out + O_CS + (size_t)16 * 2 * DFF, A.in[22] + 3 * DFF, A.in[23] + DFF};
        pg8::gemm_phase<EpiUp, pg8::SplitOrder, true, true>(L + RING_OFF, g, S, E);
    }
    SEAM(14);
    if (IN(15)) { TIDS; ENV; ARGSL; conv_fix_phase(A, 1, vcu, G, tid); }
    SEAM(15);
    if (IN(16)) {
        PTRS; ENV;
        pg8::Gemm g{ACT, (const bf16*)(ws + WS_W_DN1), MR, DM, DFF}; pg8::SplitOrder S; S.init(MR, DM, g.K, G, bx, vcu, (float*)(ws + WS_SLAB), (unsigned*)(ctl + CW_SKF + 7 * 4096), SPLIT_7, wv);
        EpiResid<false> E{X1, X1, out + O_Y, nullptr, nullptr};
        pg8::gemm_phase<EpiResid<false>, pg8::SplitOrder, true, true>(L + RING_OFF, g, S, E);
    }
#if defined(XPROBE)
    {
        { BAROBJ; xcd_barrier(bar); }
        unsigned long long tx0 = __builtin_amdgcn_s_memrealtime();
        { PTRS; ENV;
          const att::bf16* QN = (const att::bf16*)(ws + WS_QH); const att::bf16* KN = (const att::bf16*)(ws + WS_KH); const att::bf16* VBn = (const att::bf16*)(ws + WS_VH);
          float* OA0 = (float*)(ws + WS_OA); float* OA1 = OA0 + (size_t)MR * DM;
#if XPROBE_VAR >= 9
          {
            constexpr int K_ = XPROBE_VAR >= 20 ? 0 : XPROBE_VAR - 10; constexpr int SV_ = XPROBE_VAR >= 20 ? XPROBE_VAR - 20 : 0;     const int li = (int)(blockIdx.x >> 3), x = (int)(blockIdx.x & 7);
            if (XPROBE_VAR == 13) { const int u = li & 15; att::attn_sample_unit(QN, KN, VBn, A.in[3], A.in[4], OA0, OA1, 2 * x + (u >> 3), u & 7, (char*)lds, wv); }
            else if (XPROBE_VAR >= 10 && li < (16 >> K_)) {
#pragma unroll 1
              for (int r = 0; r < (1 << K_); ++r) { const int u = li + r * (16 >> K_); att::attn_sample_unit<SV_>(QN, KN, VBn, A.in[3], A.in[4], OA0, OA1, 2 * x + (u >> 3), u & 7, (char*)lds, wv); }
            }
          }
#else
          for (int p = vcu; p < 256; p += G) {
#pragma unroll 1
            for (int half = 0; half < 2; ++half) { const int hc = p >> 4, pr = p & 15, h = hc >> 1, c = hc & 1, qb = half ? 31 - pr : pr; const size_t qoff = (size_t)qb * 256 * DM + h * 256;
              att::attn_wide_body<XPROBE_VAR>(QN + qoff + c * 128, KN + h * 256 + c * 128, VBn + h * 256, (c ? OA1 : OA0) + qoff, 4 * qb + 4, 4 * qb + (wv >> 1), (char*)lds, wv); } }
#endif
        }
        { BAROBJ; xcd_barrier(bar); }
        if (blockIdx.x == 0 && wv == 0 && lane_id() == 0) { const unsigned long long w_ = __builtin_amdgcn_s_memrealtime() - tx0, t0_ = __builtin_amdgcn_s_memrealtime(); while (__builtin_amdgcn_s_memrealtime() - t0_ < w_) __builtin_amdgcn_s_sleep(32); }
    }
#endif
    if (PROBE_MASK && blockIdx.x == 0 && wv == 0 && lane_id() == 0) { if ((PROBE_MASK >> 16) & 1) PR_WORDS[1] += __builtin_amdgcn_s_memrealtime() - PR_WORDS[0];
        const unsigned long long t0_ = __builtin_amdgcn_s_memrealtime(), w_ = PR_WORDS[1]; while (__builtin_amdgcn_s_memrealtime() - t0_ < w_) __builtin_amdgcn_s_sleep(32); }
#undef IN
#undef SEAM
}

#ifndef MK_PER_PHASE
#define MK_PER_PHASE 0
#endif
extern "C" void kernel_launch(void* const* d_in, const int* in_sizes, int n_in, void* d_out, int out_size, void* d_ws, size_t ws_size, hipStream_t stream) {
    static int grid = 0;
    if (grid == 0) {
        if (n_in != 25 || out_size != (int)O_END || ws_size < WS_END) { fprintf(stderr, "kernel_launch: built for 25 inputs, %zu outputs, >= %zu bytes of workspace; got n_in %d, out %d, ws %zu; nothing launched\n", (size_t)O_END, (size_t)WS_END, n_in, out_size, ws_size); grid = -1; return; }
        int dev = 0, cus = 0, per_cu = 0;
        if (hipGetDevice(&dev) != hipSuccess || hipDeviceGetAttribute(&cus, hipDeviceAttributeMultiprocessorCount, dev) != hipSuccess) { fprintf(stderr, "kernel_launch: device query failed\n"); grid = -1; return; }
        if (hipFuncSetAttribute((const void*)fwd_kernel, hipFuncAttributeMaxDynamicSharedMemorySize, LDS_BYTES) != hipSuccess) { fprintf(stderr, "kernel_launch: hipFuncSetAttribute failed\n"); grid = -1; return; }
        if (hipOccupancyMaxActiveBlocksPerMultiprocessor(&per_cu, (const void*)fwd_kernel, NWAVES * 64, LDS_BYTES) != hipSuccess || per_cu < 1)
            fprintf(stderr, "kernel_launch: note: occupancy query reports %d workgroups per CU\n", per_cu);
        (void)hipGetLastError();
        grid = cus;
    }
    if (grid < 0) return;
    if (hipMemsetAsync((char*)d_ws + WS_CTL, 0, CTL_ZERO_BYTES, stream) != hipSuccess) { fprintf(stderr, "kernel_launch: memset failed\n"); return; }
    Args a{};
    for (int i = 0; i < 25; ++i) a.in[i] = (const float*)d_in[i];
    a.out = (float*)d_out; a.ws = (unsigned char*)d_ws;
#if MK_PER_PHASE
    for (int ph = 0; ph < NPH; ++ph) { a.ph_lo = ph; a.ph_hi = ph + 1; hipLaunchKernelGGL(fwd_kernel, dim3(grid), dim3(NWAVES * 64), LDS_BYTES, stream, a); }
#else
    a.ph_lo = 0; a.ph_hi = NPH; hipLaunchKernelGGL(fwd_kernel, dim3(grid), dim3(NWAVES * 64), LDS_BYTES, stream, a);
#endif
    const hipError_t le = hipPeekAtLastError();
    if (le != hipSuccess) fprintf(stderr, "kernel_launch: launch failed: %s\n", hipGetErrorName(le));
}
```
